# Optimizing an MI355X kernel written in HIP

```python
import math, functools
import jax, jax.numpy as jnp
from jax import lax
import numpy as np

D_MODEL = 1024
BATCH = 8
SEQ = 4096
DEPTH = 1
DEC_BATCH = 32
DEC_SEQ = 8
PAST_LEN = 16384
PAGE_SIZE = 128

NSA_HEADS = 8
NSA_KV_HEADS = 2
HEAD_DIM = 64
NSA_Q_W = NSA_HEADS * HEAD_DIM
NSA_KV_W = NSA_KV_HEADS * HEAD_DIM
CMP_BLOCK = 64
SEL_BLOCK = 64
N_SEL = 16
WINDOW = 512
CMP_HIDDEN = 128
Q_BLOCK = 64
RWKV_HEADS = 8
RWKV_HEAD_DIM = 64
RWKV_W = RWKV_HEADS * RWKV_HEAD_DIM
DECAY_LORA = 64
ICLR_LORA = 64
GATE_LORA = 128
NSA_COLS = NSA_Q_W + 6 * NSA_KV_W + 3 * NSA_HEADS
RWKV_COLS = 3 * RWKV_W + DECAY_LORA + ICLR_LORA + GATE_LORA
IN_COLS = NSA_COLS + RWKV_COLS
MIX_W = NSA_Q_W + RWKV_W
N_MEM = 256
X_HEADS = 4
X_HEAD_DIM = 128
D_FF = 2816
RMS_EPS = 1e-6
LNX_EPS = 64e-5
FORCED_SCORE = 1e9

kernel_name = 'hymba_nsa_rwkv7_macaron_step'


def rms_norm(x, g):
    xf = x.astype(jnp.float32)
    y = xf * lax.rsqrt(jnp.mean(xf * xf, axis=-1, keepdims=True) + RMS_EPS)
    return (y * g.astype(jnp.float32)).astype(x.dtype)


def masked_softmax(s, mask):
    s = jnp.where(mask, s, -jnp.inf)
    m = jnp.max(s, axis=-1, keepdims=True)
    p = jnp.exp(s - jnp.where(jnp.isfinite(m), m, 0.0))
    return p / jnp.maximum(jnp.sum(p, axis=-1, keepdims=True), 1e-30)


def alibi_slopes():
    h = jnp.arange(NSA_HEADS, dtype=jnp.float32)
    return jnp.exp2(-8.0 * (h + 1.0) / NSA_HEADS).reshape(NSA_KV_HEADS, NSA_HEADS // NSA_KV_HEADS)


def swiglu_half(x, g, w_gu, w_down):
    gate, up = jnp.split(rms_norm(x, g) @ w_gu, 2, axis=-1)
    return 0.5 * ((jax.nn.silu(gate) * up) @ w_down)


def nsa_project(p, q_g, ks_g, kw_g, gate_b):
    n, t, _ = p.shape
    G, R = NSA_KV_HEADS, NSA_HEADS // NSA_KV_HEADS
    offs = [NSA_Q_W + i * NSA_KV_W for i in range(7)]
    q, kc, vc, ks, vs, kw, vw, gl = jnp.split(p, offs, axis=-1)
    kv = lambda a: a.reshape(n, t, G, HEAD_DIM)
    q = rms_norm(q.reshape(n, t, G, R, HEAD_DIM), q_g)
    gates = jax.nn.sigmoid((gl + gate_b).astype(jnp.float32)).astype(p.dtype).reshape(n, t, G, R, 3)
    return (q, kv(kc), kv(vc), rms_norm(kv(ks), ks_g), kv(vs), rms_norm(kv(kw), kw_g), kv(vw), gates)


def nsa_compress(rows, pe, w1, w2):
    n, l, g, d = rows.shape
    blk = rows.reshape(n, l // CMP_BLOCK, CMP_BLOCK, g, d) + pe[:, None, :]
    h = jax.nn.gelu(jnp.einsum('nbjgd,jdh->nbgh', blk, w1))
    return h @ w2


def nsa_cmp_branch(q, t, kc, vc):
    nb = kc.shape[1]
    end = (jnp.arange(nb, dtype=jnp.int32) + 1) * CMP_BLOCK - 1
    dist = (t[:, None] - end[None, :]).astype(jnp.float32)
    s = jnp.einsum('ntgrd,nbgd->ngrtb', q, kc).astype(jnp.float32) * HEAD_DIM ** -0.5
    s = s - alibi_slopes()[:, :, None, None] * dist
    p = masked_softmax(s, dist >= 0)
    o = jnp.einsum('ngrtb,nbgd->ntgrd', p.astype(vc.dtype), vc)
    return o, jnp.sum(p, axis=2)


def nsa_select(imp, t):
    nb = imp.shape[-1]
    b = jnp.arange(nb, dtype=jnp.int32)
    cur = (t // SEL_BLOCK)[:, None]
    forced = (b == 0) | (b == cur) | (b == cur - 1)
    score = jnp.where(forced, FORCED_SCORE, jnp.where(b <= cur, imp, -FORCED_SCORE))
    _, idx = lax.top_k(score, min(N_SEL, nb))
    return idx


def nsa_sel_branch(q, t, idx, k_sel, v_sel):
    pos = idx[..., None] * SEL_BLOCK + jnp.arange(SEL_BLOCK, dtype=jnp.int32)
    dist = (t[:, None, None] - pos).astype(jnp.float32)
    s = jnp.einsum('ntgrd,ngtksd->ngrtks', q, k_sel).astype(jnp.float32) * HEAD_DIM ** -0.5
    s = s - alibi_slopes()[:, :, None, None, None] * dist[:, :, None]
    n, g, r, tq, k, sb = s.shape
    p = masked_softmax(s.reshape(n, g, r, tq, k * sb), (dist >= 0).reshape(n, g, 1, tq, k * sb))
    return jnp.einsum('ngrtks,ngtksd->ntgrd', p.reshape(s.shape).astype(v_sel.dtype), v_sel)


def nsa_win_branch(q, t, kw, vw, pos):
    dist = (t[:, None] - pos[None, :]).astype(jnp.float32)
    mask = (dist >= 0) & (dist < WINDOW) & (pos[None, :] >= 0)
    s = jnp.einsum('ntgrd,nlgd->ngrtl', q, kw).astype(jnp.float32) * HEAD_DIM ** -0.5
    s = s - alibi_slopes()[:, :, None, None] * dist
    p = masked_softmax(s, mask)
    return jnp.einsum('ngrtl,nlgd->ntgrd', p.astype(vw.dtype), vw)


def nsa_gate(g, o_c, o_s, o_w):
    return g[..., 0:1] * o_c + g[..., 1:2] * o_s + g[..., 2:3] * o_w


def nsa_prompt(parts, cmp_w):
    q, kc_rows, vc_rows, ks, vs, kw, vw, gates = parts
    pe_k, pe_v, wk1, wk2, wv1, wv2, kc_g = cmp_w
    n, s = q.shape[:2]
    G = NSA_KV_HEADS
    kc = rms_norm(nsa_compress(kc_rows, pe_k, wk1, wk2), kc_g)
    vc = nsa_compress(vc_rows, pe_v, wv1, wv2)
    nb = s // SEL_BLOCK
    to_blocks = lambda a: a.reshape(n, nb, SEL_BLOCK, G, HEAD_DIM).transpose(0, 3, 1, 2, 4)
    ks_blk, vs_blk = to_blocks(ks), to_blocks(vs)
    pad = ((0, 0), (WINDOW, 0), (0, 0), (0, 0))
    kw_pad, vw_pad = jnp.pad(kw, pad), jnp.pad(vw, pad)
    nq = s // Q_BLOCK
    qblk = lambda a: jnp.moveaxis(a.reshape(n, nq, Q_BLOCK, *a.shape[2:]), 1, 0)
    b_ix = jnp.arange(n)[:, None, None, None]
    g_ix = jnp.arange(G)[None, :, None, None]

    def one_block(args):
        qb, gb, i = args
        start = i * Q_BLOCK
        t = start + jnp.arange(Q_BLOCK, dtype=jnp.int32)
        o_c, imp = nsa_cmp_branch(qb, t, kc, vc)
        idx = nsa_select(imp, t)
        o_s = nsa_sel_branch(qb, t, idx, ks_blk[b_ix, g_ix, idx], vs_blk[b_ix, g_ix, idx])
        pos = start - WINDOW + jnp.arange(WINDOW + Q_BLOCK, dtype=jnp.int32)
        o_w = nsa_win_branch(qb, t,
                             lax.dynamic_slice_in_dim(kw_pad, start, WINDOW + Q_BLOCK, axis=1),
                             lax.dynamic_slice_in_dim(vw_pad, start, WINDOW + Q_BLOCK, axis=1), pos)
        return nsa_gate(gb, o_c, o_s, o_w)

    o = lax.map(one_block, (qblk(q), qblk(gates), jnp.arange(nq, dtype=jnp.int32)))
    o = jnp.moveaxis(o, 0, 1).reshape(n, s, NSA_Q_W)
    w = min(WINDOW, s)
    return (o, jnp.stack([kc_rows, vc_rows, ks, vs], axis=2),
            jnp.stack([kw[:, s - w:], vw[:, s - w:]], axis=2))


def nsa_sample(parts, cmp_w, cache_kv, layer, page_table, cache_win):
    q, kc_new, vc_new, ks_new, vs_new, kw_new, vw_new, gates = parts
    pe_k, pe_v, wk1, wk2, wv1, wv2, kc_g = cmp_w
    n, tn = q.shape[:2]
    G = NSA_KV_HEADS
    past = page_table.shape[1] * PAGE_SIZE
    t = past + jnp.arange(tn, dtype=jnp.int32)
    n_new = -(-tn // SEL_BLOCK)
    pad = ((0, 0), (0, n_new * SEL_BLOCK - tn), (0, 0), (0, 0))
    page_rows = jnp.arange(PAGE_SIZE, dtype=jnp.int32)[None, None, :]
    past_rows = lambda c: cache_kv[layer, page_table[:, :, None], page_rows, c].reshape(n, past, G, HEAD_DIM)
    kc = rms_norm(jnp.concatenate([nsa_compress(past_rows(0), pe_k, wk1, wk2),
                                   nsa_compress(jnp.pad(kc_new, pad), pe_k, wk1, wk2)], axis=1), kc_g)
    vc = jnp.concatenate([nsa_compress(past_rows(1), pe_v, wv1, wv2),
                          nsa_compress(jnp.pad(vc_new, pad), pe_v, wv1, wv2)], axis=1)
    o_c, imp = nsa_cmp_branch(q, t, kc, vc)
    idx = nsa_select(imp, t)
    nb_past = past // SEL_BLOCK
    blk_per_page = PAGE_SIZE // SEL_BLOCK
    b_ix = jnp.arange(n)[:, None, None, None]
    g_ix = jnp.arange(G)[None, :, None, None]
    blk_p = jnp.minimum(idx, nb_past - 1)
    phys = page_table[b_ix, blk_p // blk_per_page]
    prow = (blk_p % blk_per_page)[..., None] * SEL_BLOCK + jnp.arange(SEL_BLOCK, dtype=jnp.int32)
    blk_n = jnp.clip(idx - nb_past, 0, n_new - 1)
    is_new = (idx >= nb_past)[..., None, None]

    def gather_sel(c, rows_new):
        from_pool = cache_kv[layer, phys[..., None], prow, c, g_ix[..., None]]
        new_blk = jnp.pad(rows_new, pad).reshape(n, n_new, SEL_BLOCK, G, HEAD_DIM).transpose(0, 3, 1, 2, 4)
        return jnp.where(is_new, new_blk[b_ix, g_ix, blk_n], from_pool)

    o_s = nsa_sel_branch(q, t, idx, gather_sel(2, ks_new), gather_sel(3, vs_new))
    w_buf = cache_win.shape[2]
    win_all = jnp.concatenate([cache_win[layer], jnp.stack([kw_new, vw_new], axis=2)], axis=1)
    pos = past - w_buf + jnp.arange(w_buf + tn, dtype=jnp.int32)
    o_w = nsa_win_branch(q, t, win_all[:, :, 0], win_all[:, :, 1], pos)
    o = nsa_gate(gates, o_c, o_s, o_w).reshape(n, tn, NSA_Q_W)
    return (o, jnp.stack([kc_new, vc_new, ks_new, vs_new], axis=2), win_all[:, tn:])


def rwkv_mix(p, shift_prev, s0, mu, w0, w_decay2, a0, w_iclr2, w_gate2, k_k, k_a, r_k, lnx_g, lnx_b):
    f32 = jnp.float32
    n, tn, _ = p.shape
    prev = jnp.concatenate([shift_prev[:, None, :], p[:, :-1]], axis=1)
    xs = p + (prev - p) * mu
    offs = [RWKV_W, 2 * RWKV_W, 3 * RWKV_W, 3 * RWKV_W + DECAY_LORA, 3 * RWKV_W + DECAY_LORA + ICLR_LORA]
    r, k, v, xw, xa, xg = jnp.split(xs, offs, axis=-1)
    wlog = -jax.nn.softplus(-(w0 + jnp.tanh(xw) @ w_decay2).astype(f32)) - 0.5
    decay = jnp.exp(-jnp.exp(wlog))
    a = jax.nn.sigmoid((a0 + xa @ w_iclr2).astype(f32))
    g = jax.nn.sigmoid(xg) @ w_gate2
    heads = lambda z: z.reshape(n, tn, RWKV_HEADS, RWKV_HEAD_DIM).astype(f32)
    r_h, v_h, a_h, d_h = heads(r), heads(v), heads(a), heads(decay)
    kk = heads(k * k_k)
    kk = kk * lax.rsqrt(jnp.maximum(jnp.sum(kk * kk, axis=-1, keepdims=True), 1e-24))
    k_h = heads(k) * (1.0 + (a_h - 1.0) * k_a.reshape(RWKV_HEADS, RWKV_HEAD_DIM).astype(f32))

    def step(S, inp):
        rt, dt, kt, vt, kkt, at = inp
        sa = jnp.einsum('nhij,nhj->nhi', S, -kkt)
        S = S * dt[:, :, None, :] + sa[..., None] * (kkt * at)[:, :, None, :] + vt[..., None] * kt[:, :, None, :]
        return S, jnp.einsum('nhij,nhj->nhi', S, rt)

    tm = lambda z: jnp.moveaxis(z, 1, 0)
    S, out = lax.scan(step, s0.astype(f32), (tm(r_h), tm(d_h), tm(k_h), tm(v_h), tm(kk), tm(a_h)))
    out = jnp.moveaxis(out, 0, 1)
    mean = jnp.mean(out, axis=-1, keepdims=True)
    var = jnp.mean(jnp.square(out - mean), axis=-1, keepdims=True)
    out = ((out - mean) * lax.rsqrt(var + LNX_EPS)).reshape(n, tn, RWKV_W) * lnx_g + lnx_b
    bonus = jnp.sum(r_h * k_h * r_k.astype(f32), axis=-1, keepdims=True) * v_h
    o = (out + bonus.reshape(n, tn, RWKV_W)) * g
    return o.astype(p.dtype), S.astype(s0.dtype), p[:, -1]


def mem_kv(mem, norm_mem_g, w_xkv, xk_g):
    n, m, _ = mem.shape
    kv = (rms_norm(mem, norm_mem_g) @ w_xkv).reshape(n, m, 2, X_HEADS, X_HEAD_DIM)
    return jnp.stack([rms_norm(kv[:, :, 0], xk_g), kv[:, :, 1]], axis=2)


def cross_attn(x, mkv, norm_x_g, w_xq, xq_g, w_xo):
    n, tn, _ = x.shape
    q = rms_norm((rms_norm(x, norm_x_g) @ w_xq).reshape(n, tn, X_HEADS, X_HEAD_DIM), xq_g)
    s = jnp.einsum('nthd,nmhd->nhtm', q, mkv[:, :, 0]).astype(jnp.float32) * X_HEAD_DIM ** -0.5
    p = jax.nn.softmax(s, axis=-1)
    o = jnp.einsum('nhtm,nmhd->nthd', p.astype(x.dtype), mkv[:, :, 1]).reshape(n, tn, X_HEADS * X_HEAD_DIM)
    return o @ w_xo


def layer_forward(x, mkv, shift0, s0, nsa_attend, lw):
    (norm_ffn1_g, w_ffn1_gu, w_ffn1_down, norm_mix_g, w_in, w_out, q_norm_g, kc_norm_g, ks_norm_g,
     kw_norm_g, gate_b, cmp_pe_k, cmp_pe_v, w_cmp_k1, w_cmp_k2, w_cmp_v1, w_cmp_v2, rwkv_mu, rwkv_w0,
     w_decay2, rwkv_a0, w_iclr2, w_gate2, rwkv_k_k, rwkv_k_a, rwkv_r_k, lnx_g, lnx_b, norm_x_g, w_xq,
     xq_norm_g, w_xo, norm_ffn2_g, w_ffn2_gu, w_ffn2_down, norm_out_g) = lw
    x = x + swiglu_half(x, norm_ffn1_g, w_ffn1_gu, w_ffn1_down)
    p = rms_norm(x, norm_mix_g) @ w_in
    parts = nsa_project(p[..., :NSA_COLS], q_norm_g, ks_norm_g, kw_norm_g, gate_b)
    o_nsa, kv_rows, win_state = nsa_attend(parts, (cmp_pe_k, cmp_pe_v, w_cmp_k1, w_cmp_k2, w_cmp_v1, w_cmp_v2, kc_norm_g))
    o_rwkv, s_new, shift_new = rwkv_mix(p[..., NSA_COLS:], shift0, s0, rwkv_mu, rwkv_w0, w_decay2, rwkv_a0,
                                        w_iclr2, w_gate2, rwkv_k_k, rwkv_k_a, rwkv_r_k, lnx_g, lnx_b)
    x = x + jnp.concatenate([o_nsa, o_rwkv], axis=-1) @ w_out
    x = x + cross_attn(x, mkv, norm_x_g, w_xq, xq_norm_g, w_xo)
    x = x + swiglu_half(x, norm_ffn2_g, w_ffn2_gu, w_ffn2_down)
    return rms_norm(x, norm_out_g), kv_rows, win_state, s_new, shift_new


def setup_inputs(seed: int = 0) -> dict:
    key = jax.random.key(seed)
    ks = iter(jax.random.split(key, 64))
    f32 = jnp.float32
    nrm = lambda shape, scale: jax.random.normal(next(ks), shape, f32) * scale
    gain = lambda d: 1.0 + nrm((DEPTH, d), 0.02)
    uni = lambda shape, lo, hi: jax.random.uniform(next(ks), shape, f32, lo, hi)
    G = NSA_KV_HEADS
    n_pages = PAST_LEN // PAGE_SIZE
    n_used = DEC_BATCH * n_pages
    n_phys = n_used + n_used // 4
    w_buf = min(WINDOW, PAST_LEN)
    page_table = jax.random.permutation(next(ks), n_phys)[:n_used].reshape(DEC_BATCH, n_pages).astype(jnp.int32)
    return {
        'x_prompt': nrm((BATCH, SEQ, D_MODEL), 1.0),
        'x_sample': nrm((DEC_BATCH, DEC_SEQ, D_MODEL), 1.0),
        'cache_nsa_kv': nrm((DEPTH, n_phys, PAGE_SIZE, 4, G, HEAD_DIM), 1.0),
        'cache_nsa_win': nrm((DEPTH, DEC_BATCH, w_buf, 2, G, HEAD_DIM), 1.0),
        'state_rwkv_s': nrm((DEPTH, DEC_BATCH, RWKV_HEADS, RWKV_HEAD_DIM, RWKV_HEAD_DIM), 0.5),
        'state_rwkv_shift': nrm((DEPTH, DEC_BATCH, RWKV_COLS), 1.0),
        'cache_mem_kv': nrm((DEPTH, DEC_BATCH, N_MEM, 2, X_HEADS, X_HEAD_DIM), 1.0),
        'page_table': page_table,
        'mem_prompt': nrm((BATCH, N_MEM, D_MODEL), 1.0),
        'norm_ffn1_g': gain(D_MODEL),
        'w_ffn1_gu': nrm((DEPTH, D_MODEL, 2 * D_FF), D_MODEL ** -0.5),
        'w_ffn1_down': nrm((DEPTH, D_FF, D_MODEL), D_FF ** -0.5),
        'norm_mix_g': gain(D_MODEL),
        'w_in': nrm((DEPTH, D_MODEL, IN_COLS), D_MODEL ** -0.5),
        'w_out': nrm((DEPTH, MIX_W, D_MODEL), MIX_W ** -0.5),
        'q_norm_g': gain(HEAD_DIM),
        'kc_norm_g': gain(HEAD_DIM),
        'ks_norm_g': gain(HEAD_DIM),
        'kw_norm_g': gain(HEAD_DIM),
        'gate_b': nrm((DEPTH, 3 * NSA_HEADS), 0.1),
        'cmp_pe_k': nrm((DEPTH, CMP_BLOCK, HEAD_DIM), 0.1),
        'cmp_pe_v': nrm((DEPTH, CMP_BLOCK, HEAD_DIM), 0.1),
        'w_cmp_k1': nrm((DEPTH, CMP_BLOCK, HEAD_DIM, CMP_HIDDEN), (CMP_BLOCK * HEAD_DIM) ** -0.5),
        'w_cmp_k2': nrm((DEPTH, CMP_HIDDEN, HEAD_DIM), CMP_HIDDEN ** -0.5),
        'w_cmp_v1': nrm((DEPTH, CMP_BLOCK, HEAD_DIM, CMP_HIDDEN), (CMP_BLOCK * HEAD_DIM) ** -0.5),
        'w_cmp_v2': nrm((DEPTH, CMP_HIDDEN, HEAD_DIM), CMP_HIDDEN ** -0.5),
        'rwkv_mu': uni((DEPTH, RWKV_COLS), 0.0, 1.0),
        'rwkv_w0': uni((DEPTH, RWKV_W), -6.0, -1.0),
        'w_decay2': nrm((DEPTH, DECAY_LORA, RWKV_W), 0.5 * DECAY_LORA ** -0.5),
        'rwkv_a0': nrm((DEPTH, RWKV_W), 0.1),
        'w_iclr2': nrm((DEPTH, ICLR_LORA, RWKV_W), 0.5 * ICLR_LORA ** -0.5),
        'w_gate2': nrm((DEPTH, GATE_LORA, RWKV_W), GATE_LORA ** -0.5),
        'rwkv_k_k': 0.85 + nrm((DEPTH, RWKV_W), 0.02),
        'rwkv_k_a': 1.0 + nrm((DEPTH, RWKV_W), 0.02),
        'rwkv_r_k': nrm((DEPTH, RWKV_HEADS, RWKV_HEAD_DIM), 0.1),
        'lnx_g': gain(RWKV_W),
        'lnx_b': nrm((DEPTH, RWKV_W), 0.02),
        'norm_x_g': gain(D_MODEL),
        'norm_mem_g': gain(D_MODEL),
        'w_xq': nrm((DEPTH, D_MODEL, X_HEADS * X_HEAD_DIM), D_MODEL ** -0.5),
        'w_xkv': nrm((DEPTH, D_MODEL, 2 * X_HEADS * X_HEAD_DIM), D_MODEL ** -0.5),
        'xq_norm_g': gain(X_HEAD_DIM),
        'xk_norm_g': gain(X_HEAD_DIM),
        'w_xo': nrm((DEPTH, X_HEADS * X_HEAD_DIM, D_MODEL), (X_HEADS * X_HEAD_DIM) ** -0.5),
        'norm_ffn2_g': gain(D_MODEL),
        'w_ffn2_gu': nrm((DEPTH, D_MODEL, 2 * D_FF), D_MODEL ** -0.5),
        'w_ffn2_down': nrm((DEPTH, D_FF, D_MODEL), D_FF ** -0.5),
        'norm_out_g': gain(D_MODEL),
    }


def reference(x_prompt, x_sample, cache_nsa_kv, cache_nsa_win, state_rwkv_s, state_rwkv_shift, cache_mem_kv,
              page_table, mem_prompt, norm_ffn1_g, w_ffn1_gu, w_ffn1_down, norm_mix_g, w_in, w_out, q_norm_g,
              kc_norm_g, ks_norm_g, kw_norm_g, gate_b, cmp_pe_k, cmp_pe_v, w_cmp_k1, w_cmp_k2, w_cmp_v1,
              w_cmp_v2, rwkv_mu, rwkv_w0, w_decay2, rwkv_a0, w_iclr2, w_gate2, rwkv_k_k, rwkv_k_a, rwkv_r_k,
              lnx_g, lnx_b, norm_x_g, norm_mem_g, w_xq, w_xkv, xq_norm_g, xk_norm_g, w_xo, norm_ffn2_g,
              w_ffn2_gu, w_ffn2_down, norm_out_g):
    n_p = x_prompt.shape[0]
    y_p, y_s = x_prompt, x_sample
    kv_p, kv_s, win_p, win_s, rs_p, rs_s, sh_p, sh_s, mkv_p = [], [], [], [], [], [], [], [], []
    for l in range(DEPTH):
        lw = (norm_ffn1_g[l], w_ffn1_gu[l], w_ffn1_down[l], norm_mix_g[l], w_in[l], w_out[l], q_norm_g[l],
              kc_norm_g[l], ks_norm_g[l], kw_norm_g[l], gate_b[l], cmp_pe_k[l], cmp_pe_v[l], w_cmp_k1[l],
              w_cmp_k2[l], w_cmp_v1[l], w_cmp_v2[l], rwkv_mu[l], rwkv_w0[l], w_decay2[l], rwkv_a0[l],
              w_iclr2[l], w_gate2[l], rwkv_k_k[l], rwkv_k_a[l], rwkv_r_k[l], lnx_g[l], lnx_b[l], norm_x_g[l],
              w_xq[l], xq_norm_g[l], w_xo[l], norm_ffn2_g[l], w_ffn2_gu[l], w_ffn2_down[l], norm_out_g[l])
        mkv = mem_kv(mem_prompt, norm_mem_g[l], w_xkv[l], xk_norm_g[l])
        y_p, a_kv, a_win, a_s, a_sh = layer_forward(
            y_p, mkv, jnp.zeros((n_p, RWKV_COLS), x_prompt.dtype),
            jnp.zeros((n_p, RWKV_HEADS, RWKV_HEAD_DIM, RWKV_HEAD_DIM), x_prompt.dtype), nsa_prompt, lw)
        kv_p.append(a_kv); win_p.append(a_win); rs_p.append(a_s); sh_p.append(a_sh); mkv_p.append(mkv)
        attend = functools.partial(nsa_sample, cache_kv=cache_nsa_kv, layer=l, page_table=page_table,
                                   cache_win=cache_nsa_win)
        y_s, b_kv, b_win, b_s, b_sh = layer_forward(y_s, cache_mem_kv[l], state_rwkv_shift[l], state_rwkv_s[l],
                                                     attend, lw)
        kv_s.append(b_kv); win_s.append(b_win); rs_s.append(b_s); sh_s.append(b_sh)
    return (y_p, y_s, jnp.stack(kv_p), jnp.stack(kv_s), jnp.stack(win_p), jnp.stack(win_s),
            jnp.stack(rs_p), jnp.stack(rs_s), jnp.stack(sh_p), jnp.stack(sh_s), jnp.stack(mkv_p))
```

```cpp
#ifndef HOST_TEST
#include <hip/hip_runtime.h>
#define HD __host__ __device__ __forceinline__
#else
#include <cmath>
#include <cstdio>
#include <cstdlib>
#define HD inline
#endif
#include <stdint.h>
#include <string.h>

#ifndef D_MODEL
#define D_MODEL 1024
#endif
#ifndef BATCH
#define BATCH 8
#endif
#ifndef SEQ
#define SEQ 4096
#endif
#ifndef DEC_BATCH
#define DEC_BATCH 32
#endif
#ifndef DEC_SEQ
#define DEC_SEQ 8
#endif
#ifndef PAST_LEN
#define PAST_LEN 16384
#endif
#ifndef PAGE_SIZE
#define PAGE_SIZE 128
#endif
#ifndef N_SEL
#define N_SEL 16
#endif
#ifndef WINDOW
#define WINDOW 512
#endif
#ifndef N_MEM
#define N_MEM 256
#endif
#ifndef D_FF
#define D_FF 2816
#endif
#define NSA_COLS 1304
#define RWKV_COLS 1792
#define IN_COLS 3096
#define MIX_W 1024
#define XW 512
#define MP (BATCH * SEQ)
#define MS (DEC_BATCH * DEC_SEQ)
#define M_TOK (MP + MS)
#define NBP (SEQ / 64)
#define NBS (PAST_LEN / 64)
#define NBMAX ((NBP > NBS + 1) ? NBP : (NBS + 1))
#define WBUF ((WINDOW < PAST_LEN) ? WINDOW : PAST_LEN)
#define WP ((WINDOW < SEQ) ? WINDOW : SEQ)
#define NPAGES (PAST_LEN / PAGE_SIZE)
#define BPP (PAGE_SIZE / 64)
#define MEMROWS (BATCH * N_MEM)
#define RC 256
#define NCH (SEQ / RC)
#define RMS_EPS 1e-6f
#define LNX_EPS 64e-5f

#define O_Y_P 0L
#define O_Y_S (O_Y_P + (long)MP * D_MODEL)
#define O_KV_P (O_Y_S + (long)MS * D_MODEL)
#define O_KV_S (O_KV_P + (long)MP * 512)
#define O_WIN_P (O_KV_S + (long)MS * 512)
#define O_WIN_S (O_WIN_P + (long)BATCH * WP * 256)
#define O_RS_P (O_WIN_S + (long)DEC_BATCH * WBUF * 256)
#define O_RS_S (O_RS_P + (long)BATCH * 8 * 4096)
#define O_SH_P (O_RS_S + (long)DEC_BATCH * 8 * 4096)
#define O_SH_S (O_SH_P + (long)BATCH * RWKV_COLS)
#define O_MKV (O_SH_S + (long)DEC_BATCH * RWKV_COLS)
#define O_TOTAL (O_MKV + (long)MEMROWS * 1024)

enum {
    I_X_PROMPT = 0, I_X_SAMPLE, I_CACHE_KV, I_CACHE_WIN, I_STATE_S, I_STATE_SHIFT, I_CACHE_MEM, I_PAGE_TABLE, I_MEM_PROMPT,
    I_G_FFN1, I_W_FFN1_GU, I_W_FFN1_DOWN, I_G_MIX, I_W_IN, I_W_OUT, I_Q_G, I_KC_G, I_KS_G, I_KW_G, I_GATE_B, I_PE_K, I_PE_V,
    I_W_CK1, I_W_CK2, I_W_CV1, I_W_CV2, I_MU, I_W0, I_W_DECAY2, I_A0, I_W_ICLR2, I_W_GATE2, I_K_K, I_K_A, I_R_K, I_LNX_G, I_LNX_B,
    I_G_X, I_G_MEM, I_W_XQ, I_W_XKV, I_XQ_G, I_XK_G, I_W_XO, I_G_FFN2, I_W_FFN2_GU, I_W_FFN2_DOWN, I_G_OUT, N_INPUTS
};

struct Params {
    const float* in[N_INPUTS];
    float* out;
    float *X0, *X1, *X2, *X3, *X4, *H, *P, *QN, *KVW, *GT, *KCP, *VCP, *KCS, *VCS, *CH, *PC, *OC, *SC, *RWB, *GG, *RO, *MIX, *XQ,
        *OX, *LIN, *RS0, *RS1, *RS2, *RS3, *RS4, *RSM;
    int* IDX;
    unsigned* bar;
    unsigned short *X0b, *Hb, *X1b, *X2b, *X3b, *MIXb, *OXb, *MEMb;
    unsigned short *Wgu1, *Wd1, *Wgu2, *Wd2, *Win, *Wout, *Wxq, *Wxo, *Wxkv;
    unsigned short *QNb, *KSb, *KWb, *VSt, *VWt, *KCb, *VCt, *VSb, *VWb;
    unsigned short* RWH;
    unsigned short *XQb, *DWb, *GGb; float* BON;
    float* KC32; unsigned short* PRb;
    float *RPC, *RLC, *RSS, *RHO;
    unsigned short *XKb, *XVb, *XKSb, *XVSb;
    unsigned short *ACK, *ACV, *WC1; float* PEB;
    float* DWAG; unsigned short *LINb, *Wlora;
};
HD unsigned short f2bf(float f) {
    unsigned u;
#ifndef HOST_TEST
    u = __float_as_uint(f);
#else
    memcpy(&u, &f, 4);
#endif
    u += 0x7FFFu + ((u >> 16) & 1u);
    return (unsigned short)(u >> 16);
}
HD float rs_of(float ss, int K) { return 1.f / sqrtf(ss / (float)K + RMS_EPS); }

struct f4 { float x, y, z, w; };
HD f4 ld4(const float* p) {
#ifndef HOST_TEST
    float4 v = *(const float4*)p; f4 r; r.x = v.x; r.y = v.y; r.z = v.z; r.w = v.w; return r;
#else
    f4 r; r.x = p[0]; r.y = p[1]; r.z = p[2]; r.w = p[3]; return r;
#endif
}
HD void st4(float* p, f4 v) {
#ifndef HOST_TEST
    *(float4*)p = make_float4(v.x, v.y, v.z, v.w);
#else
    p[0] = v.x; p[1] = v.y; p[2] = v.z; p[3] = v.w;
#endif
}
HD float sigmoidf_(float x) { return 1.f / (1.f + expf(-x)); }
HD float siluf_(float x) { return x / (1.f + expf(-x)); }
HD float geluf_(float x) { return 0.5f * x * (1.f + tanhf(0.7978845608028654f * (x + 0.044715f * x * x * x))); }
HD float softplusf_(float x) { return (x > 20.f) ? x : log1pf(expf(x)); }

HD bool tok_sample(long m) { return m >= MP; }
HD int tok_seq(long m) { return m < MP ? (int)(m / SEQ) : (int)((m - MP) / DEC_SEQ); }
HD int tok_i(long m) { return m < MP ? (int)(m % SEQ) : (int)((m - MP) % DEC_SEQ); }
HD int tok_pos(long m) { return m < MP ? (int)(m % SEQ) : PAST_LEN + (int)((m - MP) % DEC_SEQ); }

HD void u_copyx(const Params& p, long u) {
    long m = u / (D_MODEL / 4); int k = (int)(u % (D_MODEL / 4)) * 4;
    const float* src = m < MP ? p.in[I_X_PROMPT] + m * D_MODEL : p.in[I_X_SAMPLE] + (m - MP) * D_MODEL;
    f4 v = ld4(src + k);
    st4(p.X0 + m * D_MODEL + k, v);
    unsigned short* b = p.X0b + m * D_MODEL + k;
    b[0] = f2bf(v.x); b[1] = f2bf(v.y); b[2] = f2bf(v.z); b[3] = f2bf(v.w);
}
HD void u_rowstat(const float* x, int K, float* ss_out, long m) {
    const float* r = x + m * K; float ss = 0.f;
    for (int k = 0; k < K; k += 4) { f4 v = ld4(r + k); ss += v.x * v.x + v.y * v.y + v.z * v.z + v.w * v.w; }
    ss_out[m] = ss;
}
HD void u_wconv(const float* W, int ldw, const float* g, unsigned short* Bt, int K, int nrows, bool gu, long u, int nvalid = 1 << 30) {
    int n = (int)(u % nrows); int k = (int)(u / nrows) * 2;
    int sc = n;
    if (gu) { int pn = n / 256, bj = (n % 256) / 128, r = n % 128; sc = bj * D_FF + pn * 128 + r; }
    float a = 0.f, b = 0.f;
    if (sc < nvalid) { a = W[(long)k * ldw + sc]; b = W[(long)(k + 1) * ldw + sc]; }
    if (g) { a *= g[k]; b *= g[k + 1]; }
    Bt[(long)n * K + k] = f2bf(a); Bt[(long)n * K + k + 1] = f2bf(b);
}
HD void u_cvt4(const float* src, unsigned short* dst, long u) {
    f4 v = ld4(src + u * 4); unsigned short* b = dst + u * 4;
    b[0] = f2bf(v.x); b[1] = f2bf(v.y); b[2] = f2bf(v.z); b[3] = f2bf(v.w);
}

template <class Epi>
HD void gemm_unit(const float* A, int lda, const float* gk, const float* W, int ldw, int K, int Nc, long u, Epi epi, long row_base = 0,
                  int col_base = 0) {
    int ncg = Nc / 4; long rg = u / ncg; int cg = (int)(u % ncg);
    long m0 = row_base + rg * 4; int n0 = col_base + cg * 4;
    float acc[4][4];
#pragma unroll
    for (int i = 0; i < 4; ++i)
#pragma unroll
        for (int j = 0; j < 4; ++j) acc[i][j] = 0.f;
    for (int k = 0; k < K; k += 4) {
        f4 a[4];
#pragma unroll
        for (int i = 0; i < 4; ++i) a[i] = ld4(A + (m0 + i) * lda + k);
        if (gk) {
            f4 g = ld4(gk + k);
#pragma unroll
            for (int i = 0; i < 4; ++i) { a[i].x *= g.x; a[i].y *= g.y; a[i].z *= g.z; a[i].w *= g.w; }
        }
        f4 w0 = ld4(W + (long)(k + 0) * ldw + n0), w1 = ld4(W + (long)(k + 1) * ldw + n0), w2 = ld4(W + (long)(k + 2) * ldw + n0),
           w3 = ld4(W + (long)(k + 3) * ldw + n0);
#pragma unroll
        for (int i = 0; i < 4; ++i) {
            acc[i][0] += a[i].x * w0.x + a[i].y * w1.x + a[i].z * w2.x + a[i].w * w3.x;
            acc[i][1] += a[i].x * w0.y + a[i].y * w1.y + a[i].z * w2.y + a[i].w * w3.y;
            acc[i][2] += a[i].x * w0.z + a[i].y * w1.z + a[i].z * w2.z + a[i].w * w3.z;
            acc[i][3] += a[i].x * w0.w + a[i].y * w1.w + a[i].z * w2.w + a[i].w * w3.w;
        }
    }
#pragma unroll
    for (int i = 0; i < 4; ++i) epi(m0 + i, n0, acc[i]);
}
struct EpiScaleStore {
    float* C; int ldc; const float* ss; int K;
    HD void operator()(long m, int n0, const float* a) const {
        float s = rs_of(ss[m], K); f4 v; v.x = a[0] * s; v.y = a[1] * s; v.z = a[2] * s; v.w = a[3] * s; st4(C + m * ldc + n0, v);
    }
};
struct EpiResidual {
    float* C; const float* R; int ldc; float alpha; unsigned short* Cb;
    HD void operator()(long m, int n0, const float* a) const {
        f4 r = ld4(R + m * ldc + n0); r.x += alpha * a[0]; r.y += alpha * a[1]; r.z += alpha * a[2]; r.w += alpha * a[3];
        st4(C + m * ldc + n0, r);
        unsigned short* b = Cb + m * ldc + n0; b[0] = f2bf(r.x); b[1] = f2bf(r.y); b[2] = f2bf(r.z); b[3] = f2bf(r.w);
    }
};
HD void u_gu(const float* A, const float* gk, const float* W, const float* ssq, float* H, long u, long row_base = 0) {
    int ncg = D_FF / 4; long rg = u / ncg; int cg = (int)(u % ncg);
    long m0 = row_base + rg * 4; int n0 = cg * 4;
    float ag[4][4], au[4][4];
#pragma unroll
    for (int i = 0; i < 4; ++i)
#pragma unroll
        for (int j = 0; j < 4; ++j) { ag[i][j] = 0.f; au[i][j] = 0.f; }
    for (int k = 0; k < D_MODEL; ++k) {
        float g = gk[k];
        f4 wg = ld4(W + (long)k * (2 * D_FF) + n0), wu = ld4(W + (long)k * (2 * D_FF) + D_FF + n0);
#pragma unroll
        for (int i = 0; i < 4; ++i) {
            float a = A[(m0 + i) * D_MODEL + k] * g;
            ag[i][0] += a * wg.x; ag[i][1] += a * wg.y; ag[i][2] += a * wg.z; ag[i][3] += a * wg.w;
            au[i][0] += a * wu.x; au[i][1] += a * wu.y; au[i][2] += a * wu.z; au[i][3] += a * wu.w;
        }
    }
#pragma unroll
    for (int i = 0; i < 4; ++i) {
        float s = rs_of(ssq[m0 + i], D_MODEL); f4 v;
        v.x = siluf_(ag[i][0] * s) * (au[i][0] * s); v.y = siluf_(ag[i][1] * s) * (au[i][1] * s);
        v.z = siluf_(ag[i][2] * s) * (au[i][2] * s); v.w = siluf_(ag[i][3] * s) * (au[i][3] * s);
        st4(H + (m0 + i) * D_FF + n0, v);
    }
}

HD void u_nsa_post(const Params& p, long m) {
    const float* row = p.P + m * IN_COLS;
    const float* qg = p.in[I_Q_G]; const float* ksg = p.in[I_KS_G]; const float* kwg = p.in[I_KW_G];
    for (int h = 0; h < 8; ++h) {
        float ss = 0.f;
        for (int d = 0; d < 64; ++d) { float v = row[h * 64 + d]; ss += v * v; }
        float r = 1.f / sqrtf(ss / 64.f + RMS_EPS);
        for (int d = 0; d < 64; ++d) p.QN[m * 512 + h * 64 + d] = row[h * 64 + d] * r * qg[d];
    }
    float* kv = p.KVW + m * 768;
    for (int c = 0; c < 6; ++c)
        for (int g = 0; g < 2; ++g) {
            const float* s = row + 512 + c * 128 + g * 64;
            if (c == 2 || c == 4) {
                const float* gg = (c == 2) ? ksg : kwg;
                float ss = 0.f;
                for (int d = 0; d < 64; ++d) ss += s[d] * s[d];
                float r = 1.f / sqrtf(ss / 64.f + RMS_EPS);
                for (int d = 0; d < 64; ++d) kv[c * 128 + g * 64 + d] = s[d] * r * gg[d];
            } else {
                for (int d = 0; d < 64; ++d) kv[c * 128 + g * 64 + d] = s[d];
            }
        }
    for (int j = 0; j < 24; ++j) p.GT[m * 24 + j] = sigmoidf_(row[1280 + j] + p.in[I_GATE_B][j]);
    int n = tok_seq(m), i = tok_i(m);
    if (!tok_sample(m)) {
        for (int c = 0; c < 512; ++c) p.QNb[m * 512 + c] = f2bf(p.QN[m * 512 + c] * 0.125f);
        for (int g = 0; g < 2; ++g)
            for (int d = 0; d < 64; ++d) {
                long kr = (((long)n * 2 + g) * SEQ + i) * 64 + d, vt = (((long)n * 2 + g) * 64 + d) * SEQ + i;
                p.KSb[kr] = f2bf(kv[256 + g * 64 + d]); p.VSt[vt] = f2bf(kv[384 + g * 64 + d]);
                p.KWb[kr] = f2bf(kv[512 + g * 64 + d]); p.VWt[vt] = f2bf(kv[640 + g * 64 + d]);
            }
        for (int c = 0; c < 512; ++c) p.out[O_KV_P + m * 512 + c] = kv[c];
        if (i >= SEQ - WP) {
            long j = i - (SEQ - WP);
            for (int c = 0; c < 256; ++c) p.out[O_WIN_P + ((long)n * WP + j) * 256 + c] = kv[512 + c];
        }
        if (i == SEQ - 1)
            for (int c = 0; c < RWKV_COLS; ++c) p.out[O_SH_P + (long)n * RWKV_COLS + c] = row[NSA_COLS + c];
    } else {
        for (int c = 0; c < 512; ++c) p.out[O_KV_S + (m - MP) * 512 + c] = kv[c];
        long j = WBUF - DEC_SEQ + i;
        for (int c = 0; c < 256; ++c) p.out[O_WIN_S + ((long)n * WBUF + j) * 256 + c] = kv[512 + c];
        if (i == DEC_SEQ - 1)
            for (int c = 0; c < RWKV_COLS; ++c) p.out[O_SH_S + (long)n * RWKV_COLS + c] = row[NSA_COLS + c];
    }
}
HD void u_wincopy(const Params& p, long u) {
    long n = u / ((WBUF - DEC_SEQ) * 64L); long r = u % ((WBUF - DEC_SEQ) * 64L);
    long j = r / 64; int c4 = (int)(r % 64) * 4;
    st4(p.out + O_WIN_S + (n * WBUF + j) * 256 + c4, ld4(p.in[I_CACHE_WIN] + (n * WBUF + j + DEC_SEQ) * 256 + c4));
}

#define N_CBLK (BATCH * NBP + DEC_BATCH * NBS)
#define N_CROWS (((N_CBLK * 2 + 255) / 256) * 256)
HD const float* cmp_row(const Params& p, long bu, int j, int c, int g) {
    if (bu < (long)BATCH * NBP) {
        long n = bu / NBP, b = bu % NBP;
        return p.KVW + (n * SEQ + b * 64 + j) * 768 + c * 128 + g * 64;
    }
    bu -= (long)BATCH * NBP;
    long n = bu / NBS, b = bu % NBS;
    long phys = ((const int*)p.in[I_PAGE_TABLE])[n * NPAGES + b / BPP];
    long prow = (b % BPP) * 64 + j;
    return p.in[I_CACHE_KV] + (((phys * PAGE_SIZE + prow) * 4 + c) * 2 + g) * 64;
}
HD void u_cmp_hidden(const Params& p, long u) {
    int hc = (int)(u % 128); long r = u / 128;
    int c = (int)(r % 2); r /= 2; int g = (int)(r % 2); long bu = r / 2;
    const float* pe = c == 0 ? p.in[I_PE_K] : p.in[I_PE_V];
    const float* w1 = c == 0 ? p.in[I_W_CK1] : p.in[I_W_CV1];
    float acc = 0.f;
    for (int j = 0; j < 64; ++j) {
        const float* row = cmp_row(p, bu, j, c, g);
        for (int d = 0; d < 64; ++d) acc += (row[d] + pe[j * 64 + d]) * w1[(long)(j * 64 + d) * 128 + hc];
    }
    p.CH[((bu * 2 + g) * 2 + c) * 128 + hc] = geluf_(acc);
}

HD float bf2f(unsigned short b) {
    unsigned u = ((unsigned)b) << 16; float f;
#ifndef HOST_TEST
    f = __uint_as_float(u);
#else
    memcpy(&f, &u, 4);
#endif
    return f;
}
HD void u_cmp_gather(const Params& p, long u) {
    int q = (int)(u % 16); long r = u / 16; int j = (int)(r % 64); r /= 64; int c = (int)(r % 2); long R = r / 2;
    unsigned short* dst = (c == 0 ? p.ACK : p.ACV) + R * 4096 + j * 64 + q * 4;
    if (R >= (long)N_CBLK * 2) { dst[0] = 0; dst[1] = 0; dst[2] = 0; dst[3] = 0; return; }
    const float* row = cmp_row(p, R / 2, j, c, (int)(R % 2));
    f4 v = ld4(row + q * 4);
    dst[0] = f2bf(v.x); dst[1] = f2bf(v.y); dst[2] = f2bf(v.z); dst[3] = f2bf(v.w);
}
HD void u_pebias(const Params& p, long u) {
    int c = (int)(u / 128), h = (int)(u % 128);
    const float* pe = c == 0 ? p.in[I_PE_K] : p.in[I_PE_V];
    const float* w1 = c == 0 ? p.in[I_W_CK1] : p.in[I_W_CV1];
    float acc = 0.f;
    for (int k = 0; k < 4096; ++k) acc += pe[k] * w1[(long)k * 128 + h];
    p.PEB[u] = acc;
}
HD void u_cmp_hidden2(const Params& p, long u) {
    int hc = (int)(u % 128); long r = u / 128; int c = (int)(r % 2); long R = r / 2;
    const unsigned short* a = (c == 0 ? p.ACK : p.ACV) + R * 4096;
    const float* w1 = c == 0 ? p.in[I_W_CK1] : p.in[I_W_CV1];
    float acc = p.PEB[c * 128 + hc];
    for (int k = 0; k < 4096; ++k) acc += bf2f(a[k]) * w1[(long)k * 128 + hc];
    p.CH[(R * 2 + c) * 128 + hc] = geluf_(acc);
}
HD void u_cmp_out(const Params& p, long u) {
    int c = (int)(u % 2); long r = u / 2; int g = (int)(r % 2); long bu = r / 2;
    const float* w2 = c == 0 ? p.in[I_W_CK2] : p.in[I_W_CV2];
    const float* h = p.CH + ((bu * 2 + g) * 2 + c) * 128;
    float o[64];
#pragma unroll
    for (int d = 0; d < 64; ++d) o[d] = 0.f;
    for (int k = 0; k < 128; ++k) {
        float hv = h[k];
#pragma unroll
        for (int d = 0; d < 64; ++d) o[d] += hv * w2[k * 64 + d];
    }
    float* dst;
    if (bu < (long)BATCH * NBP) dst = (c == 0 ? p.KCP : p.VCP) + (bu * 2 + g) * 64;
    else dst = (c == 0 ? p.KCS : p.VCS) + ((bu - (long)BATCH * NBP) * 2 + g) * 64;
    bool prm = bu < (long)BATCH * NBP; long nn = bu / NBP, bb = bu % NBP;
    if (c == 0) {
        float ss = 0.f;
#pragma unroll
        for (int d = 0; d < 64; ++d) ss += o[d] * o[d];
        float rr = 1.f / sqrtf(ss / 64.f + RMS_EPS);
#pragma unroll
        for (int d = 0; d < 64; ++d) {
            float v = o[d] * rr * p.in[I_KC_G][d]; dst[d] = v;
            if (prm) p.KCb[((nn * 2 + g) * NBP + bb) * 64 + d] = f2bf(v);
        }
    } else {
#pragma unroll
        for (int d = 0; d < 64; ++d) {
            dst[d] = o[d];
            if (prm) p.VCt[((nn * 2 + g) * 64 + d) * NBP + bb] = f2bf(o[d]);
        }
    }
}
HD void u_cmp_attn(const Params& p, long u) {
    long m = u / 8; int h = (int)(u % 8); int g = h / 4;
    int n = tok_seq(m), t = tok_pos(m);
    bool smp = tok_sample(m);
    int nbtot = smp ? NBS + 1 : NBP;
    int nvalid = smp ? NBS : (t + 1) / 64;
    const float* kc = smp ? p.KCS + (long)n * NBS * 128 : p.KCP + (long)n * NBP * 128;
    const float* vc = smp ? p.VCS + (long)n * NBS * 128 : p.VCP + (long)n * NBP * 128;
    float slope = exp2f(-(float)(h + 1));
    float q[64];
#pragma unroll
    for (int d = 0; d < 64; ++d) q[d] = p.QN[m * 512 + h * 64 + d];
    float* pc = p.PC + (m * 8 + h) * NBMAX;
    float mx = -INFINITY;
    for (int b = 0; b < nvalid; ++b) {
        const float* k = kc + (b * 2 + g) * 64;
        float s = 0.f;
#pragma unroll
        for (int d = 0; d < 64; ++d) s += q[d] * k[d];
        s = s * 0.125f - slope * (float)(t - ((b + 1) * 64 - 1));
        pc[b] = s; mx = fmaxf(mx, s);
    }
    float acc[64];
#pragma unroll
    for (int d = 0; d < 64; ++d) acc[d] = 0.f;
    float l = 0.f;
    for (int b = 0; b < nvalid; ++b) {
        float e = expf(pc[b] - mx); l += e; pc[b] = e;
        const float* v = vc + (b * 2 + g) * 64;
#pragma unroll
        for (int d = 0; d < 64; ++d) acc[d] += e * v[d];
    }
    float inv = nvalid > 0 ? 1.f / l : 0.f;
    for (int b = 0; b < nvalid; ++b) pc[b] *= inv;
    for (int b = nvalid; b < nbtot; ++b) pc[b] = 0.f;
#pragma unroll
    for (int d = 0; d < 64; ++d) p.OC[m * 512 + h * 64 + d] = acc[d] * inv;
}
HD void u_select(const Params& p, long u) {
    long m = u / 2; int g = (int)(u % 2);
    int t = tok_pos(m); bool smp = tok_sample(m);
    int nb = smp ? NBS + 1 : NBP;
    int cur = t / 64;
    float* sc = p.SC + (m * 2 + g) * NBMAX;
    for (int b = 0; b < nb; ++b) {
        bool forced = (b == 0) || (b == cur) || (b == cur - 1);
        float v;
        if (forced) v = 1e9f;
        else if (b <= cur) { v = 0.f; for (int r = 0; r < 4; ++r) v += p.PC[(m * 8 + g * 4 + r) * NBMAX + b]; }
        else v = -1e9f;
        sc[b] = v;
    }
    int K = N_SEL < nb ? N_SEL : nb;
    for (int k = 0; k < K; ++k) {
        int best = 0; float bv = sc[0];
        for (int b = 1; b < nb; ++b) { float v = sc[b]; if (v > bv) { bv = v; best = b; } }
        p.IDX[(m * 2 + g) * N_SEL + k] = best; sc[best] = -3e38f;
    }
    for (int k = K; k < N_SEL; ++k) p.IDX[(m * 2 + g) * N_SEL + k] = -1;
}
#define ONLINE_STEP(sval, vptr)                                                            \
    {                                                                                      \
        float s_ = (sval);                                                                 \
        if (s_ > mx) {                                                                     \
            float sc_ = expf(mx - s_); l = l * sc_ + 1.f; mx = s_;                         \
            _Pragma("unroll") for (int d = 0; d < 64; ++d) acc[d] = acc[d] * sc_ + (vptr)[d]; \
        } else {                                                                           \
            float e_ = expf(s_ - mx); l += e_;                                             \
            _Pragma("unroll") for (int d = 0; d < 64; ++d) acc[d] += e_ * (vptr)[d];       \
        }                                                                                  \
    }
HD void u_selwin(const Params& p, long u) {
    long m = u / 8; int h = (int)(u % 8); int g = h / 4;
    int n = tok_seq(m), t = tok_pos(m); bool smp = tok_sample(m);
    float slope = exp2f(-(float)(h + 1));
    float q[64], acc[64];
#pragma unroll
    for (int d = 0; d < 64; ++d) { q[d] = p.QN[m * 512 + h * 64 + d]; acc[d] = 0.f; }
    float g0 = p.GT[m * 24 + h * 3 + 0], g1 = p.GT[m * 24 + h * 3 + 1], g2 = p.GT[m * 24 + h * 3 + 2];
    float mx = -INFINITY, l = 0.f;
    const int* pt = (const int*)p.in[I_PAGE_TABLE];
    for (int k = 0; k < N_SEL; ++k) {
        int blk = p.IDX[(m * 2 + g) * N_SEL + k];
        if (blk < 0) continue;
        for (int s = 0; s < 64; ++s) {
            int pos = blk * 64 + s;
            if (pos > t) break;
            const float *kp, *vp;
            if (!smp) {
                const float* r = p.KVW + ((long)n * SEQ + pos) * 768; kp = r + 256 + g * 64; vp = r + 384 + g * 64;
            } else if (blk >= NBS) {
                const float* r = p.KVW + ((long)MP + (long)n * DEC_SEQ + (pos - PAST_LEN)) * 768; kp = r + 256 + g * 64; vp = r + 384 + g * 64;
            } else {
                long phys = pt[n * NPAGES + blk / BPP]; long prow = (blk % BPP) * 64 + s;
                const float* r = p.in[I_CACHE_KV] + (phys * PAGE_SIZE + prow) * 512; kp = r + (2 * 2 + g) * 64; vp = r + (3 * 2 + g) * 64;
            }
            float sv = 0.f;
#pragma unroll
            for (int d = 0; d < 64; ++d) sv += q[d] * kp[d];
            sv = sv * 0.125f - slope * (float)(t - pos);
            ONLINE_STEP(sv, vp)
        }
    }
    {
        float inv = l > 0.f ? 1.f / l : 0.f;
#pragma unroll
        for (int d = 0; d < 64; ++d) { p.MIX[m * MIX_W + h * 64 + d] = g0 * p.OC[m * 512 + h * 64 + d] + g1 * acc[d] * inv; acc[d] = 0.f; }
    }
    mx = -INFINITY; l = 0.f;
    int lo = t - WINDOW + 1;
    if (!smp) { if (lo < 0) lo = 0; } else { if (lo < PAST_LEN - WBUF) lo = PAST_LEN - WBUF; }
    for (int pos = lo; pos <= t; ++pos) {
        const float *kp, *vp;
        if (!smp) {
            const float* r = p.KVW + ((long)n * SEQ + pos) * 768; kp = r + 512 + g * 64; vp = r + 640 + g * 64;
        } else if (pos >= PAST_LEN) {
            const float* r = p.KVW + ((long)MP + (long)n * DEC_SEQ + (pos - PAST_LEN)) * 768; kp = r + 512 + g * 64; vp = r + 640 + g * 64;
        } else {
            const float* r = p.in[I_CACHE_WIN] + ((long)n * WBUF + (pos - (PAST_LEN - WBUF))) * 256; kp = r + g * 64; vp = r + 128 + g * 64;
        }
        float sv = 0.f;
#pragma unroll
        for (int d = 0; d < 64; ++d) sv += q[d] * kp[d];
        sv = sv * 0.125f - slope * (float)(t - pos);
        ONLINE_STEP(sv, vp)
    }
    float inv = l > 0.f ? 1.f / l : 0.f;
#pragma unroll
    for (int d = 0; d < 64; ++d) {
        float o = p.MIX[m * MIX_W + h * 64 + d] + g2 * acc[d] * inv;
        p.MIX[m * MIX_W + h * 64 + d] = o; p.MIXb[m * MIX_W + h * 64 + d] = f2bf(o);
    }
}

HD float rwkv_xs(const Params& p, long m, int c) {
    float cur = p.P[m * IN_COLS + NSA_COLS + c];
    int i = tok_i(m); float prev;
    if (i > 0) prev = p.P[(m - 1) * IN_COLS + NSA_COLS + c];
    else prev = tok_sample(m) ? p.in[I_STATE_SHIFT][(long)tok_seq(m) * RWKV_COLS + c] : 0.f;
    return cur + (prev - cur) * p.in[I_MU][c];
}
HD void u_lora_in(const Params& p, long u) {
    long m = u / 256; int j = (int)(u % 256);
    float x = rwkv_xs(p, m, 1536 + j);
    float v = (j < 64) ? tanhf(x) : (j < 128 ? x : sigmoidf_(x));
    p.LIN[m * 256 + j] = v; p.LINb[m * 256 + j] = f2bf(v);
}
HD void u_rwkv_prep(const Params& p, long u) {
    long m = u / 8; int h = (int)(u % 8);
    const float* lin = p.LIN + m * 256;
    float* rb = p.RWB + m * 6 * 512;
    float ss = 0.f;
    for (int d = 0; d < 64; ++d) {
        int c = h * 64 + d;
        float dw = p.in[I_W0][c], da = p.in[I_A0][c], dg = 0.f;
        for (int j = 0; j < 64; ++j) { dw += lin[j] * p.in[I_W_DECAY2][j * 512 + c]; da += lin[64 + j] * p.in[I_W_ICLR2][j * 512 + c]; }
        for (int j = 0; j < 128; ++j) dg += lin[128 + j] * p.in[I_W_GATE2][j * 512 + c];
        float wlog = -softplusf_(-dw) - 0.5f;
        float decay = expf(-expf(wlog));
        float a = sigmoidf_(da);
        float r = rwkv_xs(p, m, c), k = rwkv_xs(p, m, 512 + c), v = rwkv_xs(p, m, 1024 + c);
        float kkr = k * p.in[I_K_K][c];
        float kh = k * (1.f + (a - 1.f) * p.in[I_K_A][c]);
        ss += kkr * kkr;
        rb[0 * 512 + c] = r; rb[1 * 512 + c] = kh; rb[2 * 512 + c] = v; rb[3 * 512 + c] = kkr; rb[4 * 512 + c] = a; rb[5 * 512 + c] = decay;
        p.GG[m * 512 + c] = dg;
    }
    float inv = 1.f / sqrtf(fmaxf(ss, 1e-24f));
    for (int d = 0; d < 64; ++d) {
        int c = h * 64 + d;
        float kk = rb[3 * 512 + c] * inv; float a = rb[4 * 512 + c];
        rb[3 * 512 + c] = kk; rb[4 * 512 + c] = kk * a;
    }
}

HD void u_wconv_lora(const Params& p, long u) {
    int n = (int)(u % 1536); int k = (int)(u / 1536) * 2;
    float a = 0.f, b = 0.f;
    if (n < 512) { if (k < 64) { a = p.in[I_W_DECAY2][k * 512 + n]; b = p.in[I_W_DECAY2][(k + 1) * 512 + n]; } }
    else if (n < 1024) { if (k >= 64 && k < 128) { a = p.in[I_W_ICLR2][(k - 64) * 512 + n - 512]; b = p.in[I_W_ICLR2][(k - 63) * 512 + n - 512]; } }
    else { if (k >= 128) { a = p.in[I_W_GATE2][(k - 128) * 512 + n - 1024]; b = p.in[I_W_GATE2][(k - 127) * 512 + n - 1024]; } }
    p.Wlora[(long)n * 256 + k] = f2bf(a); p.Wlora[(long)n * 256 + k + 1] = f2bf(b);
}
struct EpiStoreOff {
    float* C; int ldc; int coff;
    HD void operator()(long m, int n0, const float* a) const { f4 v; v.x = a[0]; v.y = a[1]; v.z = a[2]; v.w = a[3]; st4(C + m * ldc + coff + n0, v); }
};
HD void u_rwkv_prep2(const Params& p, long u) {
    long m = u / 8; int h = (int)(u % 8);
    const float* dq = p.DWAG + m * 1536;
    float* rb = p.RWB + m * 6 * 512;
    float ss = 0.f;
    for (int d = 0; d < 64; ++d) {
        int c = h * 64 + d;
        float dw = p.in[I_W0][c] + dq[c], da = p.in[I_A0][c] + dq[512 + c], dg = dq[1024 + c];
        float wlog = -softplusf_(-dw) - 0.5f;
        float decay = expf(-expf(wlog));
        float a = sigmoidf_(da);
        float r = rwkv_xs(p, m, c), k = rwkv_xs(p, m, 512 + c), v = rwkv_xs(p, m, 1024 + c);
        float kkr = k * p.in[I_K_K][c];
        float kh = k * (1.f + (a - 1.f) * p.in[I_K_A][c]);
        ss += kkr * kkr;
        rb[0 * 512 + c] = r; rb[1 * 512 + c] = kh; rb[2 * 512 + c] = v; rb[3 * 512 + c] = kkr; rb[4 * 512 + c] = a; rb[5 * 512 + c] = decay;
        p.GG[m * 512 + c] = dg;
    }
    float inv = 1.f / sqrtf(fmaxf(ss, 1e-24f));
    for (int d = 0; d < 64; ++d) {
        int c = h * 64 + d;
        float kk = rb[3 * 512 + c] * inv; float a = rb[4 * 512 + c];
        rb[3 * 512 + c] = kk; rb[4 * 512 + c] = kk * a;
    }
}
HD void u_rwkv_scan(const Params& p, long u) {
    int i = (int)(u % 64); long r = u / 64; int h = (int)(r % 8); int sq = (int)(r / 8);
    bool smp = sq >= BATCH; int n = smp ? sq - BATCH : sq;
    int T = smp ? DEC_SEQ : SEQ;
    long m0 = smp ? (long)MP + (long)n * DEC_SEQ : (long)n * SEQ;
    float S[64];
    if (smp) {
        const float* s0 = p.in[I_STATE_S] + (((long)n * 8 + h) * 64 + i) * 64;
#pragma unroll
        for (int j = 0; j < 64; ++j) S[j] = s0[j];
    } else {
#pragma unroll
        for (int j = 0; j < 64; ++j) S[j] = 0.f;
    }
    for (int t = 0; t < T; ++t) {
        const float* rb = p.RWB + (m0 + t) * 6 * 512 + h * 64;
        float v = rb[2 * 512 + i];
        float sa = 0.f;
#pragma unroll
        for (int j = 0; j < 64; ++j) sa -= S[j] * rb[3 * 512 + j];
        float o = 0.f;
#pragma unroll
        for (int j = 0; j < 64; ++j) {
            S[j] = S[j] * rb[5 * 512 + j] + sa * rb[4 * 512 + j] + v * rb[1 * 512 + j];
            o += S[j] * rb[0 * 512 + j];
        }
        p.RO[(m0 + t) * 512 + h * 64 + i] = o;
    }
    float* dst = p.out + (smp ? O_RS_S : O_RS_P) + (((long)n * 8 + h) * 64 + i) * 64;
#pragma unroll
    for (int j = 0; j < 64; ++j) dst[j] = S[j];
}

HD void u_rwkv_r1(const Params& p, long u) {
    int i = (int)(u % 64); long r = u / 64; int kind = (int)(r % 2); long ct = r / 2;
    int c = (int)(ct % NCH); long sh = ct / NCH; int h = (int)(sh % 8); int sq = (int)(sh / 8);
    long m0 = (long)sq * SEQ + (long)c * RC;
    float S[64];
#pragma unroll
    for (int j = 0; j < 64; ++j) S[j] = (kind == 1 && j == i) ? 1.f : 0.f;
    for (int t = 0; t < RC; ++t) {
        const float* rb = p.RWB + (m0 + t) * 6 * 512 + h * 64;
        float v = kind == 0 ? rb[2 * 512 + i] : 0.f;
        float sa = 0.f;
#pragma unroll
        for (int j = 0; j < 64; ++j) sa -= S[j] * rb[3 * 512 + j];
        float o = 0.f;
#pragma unroll
        for (int j = 0; j < 64; ++j) { S[j] = S[j] * rb[5 * 512 + j] + sa * rb[4 * 512 + j] + v * rb[1 * 512 + j]; o += S[j] * rb[0 * 512 + j]; }
        (kind == 0 ? p.RO : p.RHO)[(m0 + t) * 512 + h * 64 + i] = o;
    }
    float* dst = (kind == 0 ? p.RLC : p.RPC) + (ct * 64 + i) * 64;
#pragma unroll
    for (int j = 0; j < 64; ++j) dst[j] = S[j];
}
HD void u_rwkv_r2(const Params& p, long u) {
    int i = (int)(u % 64); long sh = u / 64;
    float S[64], T[64];
#pragma unroll
    for (int j = 0; j < 64; ++j) S[j] = 0.f;
    for (int c = 0; c < NCH; ++c) {
        long ct = sh * NCH + c;
        float* ss = p.RSS + (ct * 64 + i) * 64;
#pragma unroll
        for (int j = 0; j < 64; ++j) ss[j] = S[j];
        const float* P = p.RPC + ct * 4096; const float* L = p.RLC + (ct * 64 + i) * 64;
#pragma unroll
        for (int j = 0; j < 64; ++j) T[j] = L[j];
        for (int k = 0; k < 64; ++k) {
            float s = S[k];
#pragma unroll
            for (int j = 0; j < 64; ++j) T[j] += s * P[k * 64 + j];
        }
#pragma unroll
        for (int j = 0; j < 64; ++j) S[j] = T[j];
    }
    float* dst = p.out + O_RS_P + (sh * 64 + i) * 64;
#pragma unroll
    for (int j = 0; j < 64; ++j) dst[j] = S[j];
}
HD void u_rwkv_r3(const Params& p, long u) {
    int i = (int)(u % 64); long ct = u / 64;
    int c = (int)(ct % NCH); long sh = ct / NCH; int h = (int)(sh % 8); int sq = (int)(sh / 8);
    long m0 = (long)sq * SEQ + (long)c * RC;
    const float* ss = p.RSS + (ct * 64 + i) * 64;
    for (int t = 0; t < RC; ++t) {
        const float* rho = p.RHO + (m0 + t) * 512 + h * 64;
        float o = p.RO[(m0 + t) * 512 + h * 64 + i];
        for (int k = 0; k < 64; ++k) o += ss[k] * rho[k];
        p.RO[(m0 + t) * 512 + h * 64 + i] = o;
    }
}
HD void u_rwkv_post(const Params& p, long u) {
    long m = u / 8; int h = (int)(u % 8);
    const float* ro = p.RO + m * 512 + h * 64;
    const float* rb = p.RWB + m * 6 * 512 + h * 64;
    float mean = 0.f;
    for (int i = 0; i < 64; ++i) mean += ro[i];
    mean *= (1.f / 64.f);
    float var = 0.f;
    for (int i = 0; i < 64; ++i) { float d = ro[i] - mean; var += d * d; }
    var *= (1.f / 64.f);
    float rstd = 1.f / sqrtf(var + LNX_EPS);
    float bonus = 0.f;
    for (int j = 0; j < 64; ++j) bonus += rb[0 * 512 + j] * rb[1 * 512 + j] * p.in[I_R_K][h * 64 + j];
    for (int i = 0; i < 64; ++i) {
        int c = h * 64 + i;
        float o = (ro[i] - mean) * rstd * p.in[I_LNX_G][c] + p.in[I_LNX_B][c] + bonus * rb[2 * 512 + i];
        o *= p.GG[m * 512 + c];
        p.MIX[m * MIX_W + 512 + c] = o; p.MIXb[m * MIX_W + 512 + c] = f2bf(o);
    }
}
HD void u_headnorm128(float* base, long rowstride, const float* g, long u) {
    long m = u / 4; int h = (int)(u % 4);
    float* x = base + m * rowstride + h * 128;
    float ss = 0.f;
    for (int d = 0; d < 128; ++d) ss += x[d] * x[d];
    float r = 1.f / sqrtf(ss / 128.f + RMS_EPS);
    for (int d = 0; d < 128; ++d) x[d] = x[d] * r * g[d];
}
HD void u_xattn(const Params& p, long u) {
    int half = (int)(u % 4); long r = u / 4; int h = (int)(r % 4); long m = r / 4;
    int n = tok_seq(m);
    const float* kvb = tok_sample(m) ? p.in[I_CACHE_MEM] + (long)n * N_MEM * 1024 : p.out + O_MKV + (long)n * N_MEM * 1024;
    float acc[32];
    const float* q = p.XQ + m * XW + h * 128;
#pragma unroll
    for (int d = 0; d < 32; ++d) acc[d] = 0.f;
    float mx = -INFINITY, l = 0.f;
    for (int j = 0; j < N_MEM; ++j) {
        const float* kp = kvb + (long)j * 1024 + h * 128;
        const float* vp = kvb + (long)j * 1024 + 512 + h * 128 + half * 32;
        float sv = 0.f;
#pragma unroll
        for (int d = 0; d < 128; ++d) sv += q[d] * kp[d];
        sv *= 0.08838834764831845f;
        if (sv > mx) {
            float sc_ = expf(mx - sv); l = l * sc_ + 1.f; mx = sv;
#pragma unroll
            for (int d = 0; d < 32; ++d) acc[d] = acc[d] * sc_ + vp[d];
        } else {
            float e_ = expf(sv - mx); l += e_;
#pragma unroll
            for (int d = 0; d < 32; ++d) acc[d] += e_ * vp[d];
        }
    }
    float inv = 1.f / l;
#pragma unroll
    for (int d = 0; d < 32; ++d) {
        float o = acc[d] * inv; p.OX[m * XW + h * 128 + half * 32 + d] = o; p.OXb[m * XW + h * 128 + half * 32 + d] = f2bf(o);
    }
}
HD void u_final(const Params& p, long u) {
    long m = u / (D_MODEL / 4); int k = (int)(u % (D_MODEL / 4)) * 4;
    f4 v = ld4(p.X4 + m * D_MODEL + k); f4 g = ld4(p.in[I_G_OUT] + k); float s = rs_of(p.RS4[m], D_MODEL);
    v.x *= s * g.x; v.y *= s * g.y; v.z *= s * g.z; v.w *= s * g.w;
    st4(p.out + (m < MP ? O_Y_P + m * D_MODEL : O_Y_S + (m - MP) * D_MODEL) + k, v);
}

#ifdef HOST_CMP2
#define HOST_CMP_HIDDEN u_cmp_hidden2(p, u)
#else
#define HOST_CMP_HIDDEN u_cmp_hidden(p, u)
#endif
#define GEMM_UNITS(rows, cols) ((long)(rows) / 4 * ((cols) / 4))
#define PHASES(X)                                                                                                              \
    X(copyx, (long)M_TOK * (D_MODEL / 4), u_copyx(p, u))                                                                       \
    X(rs0, (long)M_TOK, u_rowstat(p.X0, D_MODEL, p.RS0, u))                                                                    \
    X(gu1, GEMM_UNITS(M_TOK, D_FF), u_gu(p.X0, p.in[I_G_FFN1], p.in[I_W_FFN1_GU], p.RS0, p.H, u))                               \
    X(down1, GEMM_UNITS(M_TOK, D_MODEL),                                                                                       \
      gemm_unit(p.H, D_FF, (const float*)0, p.in[I_W_FFN1_DOWN], D_MODEL, D_FF, D_MODEL, u, EpiResidual{p.X1, p.X0, D_MODEL, 0.5f, p.X1b})) \
    X(rs1, (long)M_TOK, u_rowstat(p.X1, D_MODEL, p.RS1, u))                                                                    \
    X(win, GEMM_UNITS(M_TOK, IN_COLS),                                                                                         \
      gemm_unit(p.X1, D_MODEL, p.in[I_G_MIX], p.in[I_W_IN], IN_COLS, D_MODEL, IN_COLS, u, EpiScaleStore{p.P, IN_COLS, p.RS1, D_MODEL}))  \
    X(nsa_post, (long)M_TOK, u_nsa_post(p, u))                                                                                 \
    X(wincopy, (long)DEC_BATCH * (WBUF - DEC_SEQ) * 64, u_wincopy(p, u))                                                       \
    X(pebias, 256L, u_pebias(p, u))                                                                                            \
    X(cmp_gather, (long)N_CROWS * 2 * 64 * 16, u_cmp_gather(p, u))                                                             \
    X(cmp_hidden, (long)N_CBLK * 2 * 2 * 128, HOST_CMP_HIDDEN)                                                                 \
    X(cmp_out, (long)N_CBLK * 2 * 2, u_cmp_out(p, u))                                                                          \
    X(cmp_attn, (long)M_TOK * 8, u_cmp_attn(p, u))                                                                             \
    X(select, (long)M_TOK * 2, u_select(p, u))                                                                                 \
    X(selwin, (long)M_TOK * 8, u_selwin(p, u))                                                                                 \
    X(lora_in, (long)M_TOK * 256, u_lora_in(p, u))                                                                             \
    X(lora_d, GEMM_UNITS(M_TOK, 512), gemm_unit(p.LIN, 256, (const float*)0, p.in[I_W_DECAY2], 512, 64, 512, u, EpiStoreOff{p.DWAG, 1536, 0}))  \
    X(lora_a, GEMM_UNITS(M_TOK, 512), gemm_unit(p.LIN + 64, 256, (const float*)0, p.in[I_W_ICLR2], 512, 64, 512, u, EpiStoreOff{p.DWAG, 1536, 512}))  \
    X(lora_g, GEMM_UNITS(M_TOK, 512), gemm_unit(p.LIN + 128, 256, (const float*)0, p.in[I_W_GATE2], 512, 128, 512, u, EpiStoreOff{p.DWAG, 1536, 1024}))  \
    X(rwkv_prep2, (long)M_TOK * 8, u_rwkv_prep2(p, u))                                                                         \
    X(rwkv_r1, (long)BATCH * 8 * NCH * 2 * 64, u_rwkv_r1(p, u))                                                                \
    X(rwkv_r2, (long)BATCH * 8 * 64, u_rwkv_r2(p, u))                                                                          \
    X(rwkv_r3, (long)BATCH * 8 * NCH * 64, u_rwkv_r3(p, u))                                                                    \
    X(rwkv_scan_s, (long)DEC_BATCH * 8 * 64, u_rwkv_scan(p, (long)BATCH * 8 * 64 + u))                                         \
    X(rwkv_post, (long)M_TOK * 8, u_rwkv_post(p, u))                                                                           \
    X(wout, GEMM_UNITS(M_TOK, D_MODEL),                                                                                        \
      gemm_unit(p.MIX, MIX_W, (const float*)0, p.in[I_W_OUT], D_MODEL, MIX_W, D_MODEL, u, EpiResidual{p.X2, p.X1, D_MODEL, 1.0f, p.X2b})) \
    X(rs2, (long)M_TOK, u_rowstat(p.X2, D_MODEL, p.RS2, u))                                                                    \
    X(xq, GEMM_UNITS(M_TOK, XW),                                                                                               \
      gemm_unit(p.X2, D_MODEL, p.in[I_G_X], p.in[I_W_XQ], XW, D_MODEL, XW, u, EpiScaleStore{p.XQ, XW, p.RS2, D_MODEL}))                  \
    X(xq_norm, (long)M_TOK * 4, u_headnorm128(p.XQ, XW, p.in[I_XQ_G], u))                                                      \
    X(rsm, (long)MEMROWS, u_rowstat(p.in[I_MEM_PROMPT], D_MODEL, p.RSM, u))                                                    \
    X(memkv, GEMM_UNITS(MEMROWS, 1024),                                                                                        \
      gemm_unit(p.in[I_MEM_PROMPT], D_MODEL, p.in[I_G_MEM], p.in[I_W_XKV], 1024, D_MODEL, 1024, u,                             \
                EpiScaleStore{p.out + O_MKV, 1024, p.RSM, D_MODEL}))                                                                    \
    X(memk_norm, (long)MEMROWS * 4, u_headnorm128(p.out + O_MKV, 1024, p.in[I_XK_G], u))                                       \
    X(xattn, (long)M_TOK * 4 * 4, u_xattn(p, u))                                                                               \
    X(xo, GEMM_UNITS(M_TOK, D_MODEL),                                                                                          \
      gemm_unit(p.OX, XW, (const float*)0, p.in[I_W_XO], D_MODEL, XW, D_MODEL, u, EpiResidual{p.X3, p.X2, D_MODEL, 1.0f, p.X3b}))      \
    X(rs3, (long)M_TOK, u_rowstat(p.X3, D_MODEL, p.RS3, u))                                                                    \
    X(gu2, GEMM_UNITS(M_TOK, D_FF), u_gu(p.X3, p.in[I_G_FFN2], p.in[I_W_FFN2_GU], p.RS3, p.H, u))                               \
    X(down2, GEMM_UNITS(M_TOK, D_MODEL),                                                                                       \
      gemm_unit(p.H, D_FF, (const float*)0, p.in[I_W_FFN2_DOWN], D_MODEL, D_FF, D_MODEL, u, EpiResidual{p.X4, p.X3, D_MODEL, 0.5f, p.X1b})) \
    X(rs4, (long)M_TOK, u_rowstat(p.X4, D_MODEL, p.RS4, u))                                                                    \
    X(final, (long)M_TOK * (D_MODEL / 4), u_final(p, u))

struct WsAlloc {
    char* base; size_t off;
    float* take(size_t nfloats) { float* r = (float*)(base + off); off += ((nfloats * 4 + 255) / 256) * 256; return r; }
};
static size_t carve(Params& p, void* ws) {
    WsAlloc a{(char*)ws, 0};
    p.bar = (unsigned*)a.take(4096);
    p.X0 = a.take((size_t)M_TOK * D_MODEL); p.X1 = a.take((size_t)M_TOK * D_MODEL); p.X2 = a.take((size_t)M_TOK * D_MODEL);
    p.X3 = a.take((size_t)M_TOK * D_MODEL); p.X4 = a.take((size_t)M_TOK * D_MODEL);
    p.H = a.take((size_t)M_TOK * D_FF); p.P = a.take((size_t)M_TOK * IN_COLS);
    p.QN = a.take((size_t)M_TOK * 512); p.KVW = a.take((size_t)M_TOK * 768); p.GT = a.take((size_t)M_TOK * 24);
    p.KCP = a.take((size_t)BATCH * NBP * 128); p.VCP = a.take((size_t)BATCH * NBP * 128);
    p.KCS = a.take((size_t)DEC_BATCH * NBS * 128); p.VCS = a.take((size_t)DEC_BATCH * NBS * 128);
    p.CH = a.take((size_t)N_CBLK * 4 * 128);
    p.PC = a.take((size_t)M_TOK * 8 * NBMAX); p.OC = a.take((size_t)M_TOK * 512); p.SC = a.take((size_t)M_TOK * 2 * NBMAX);
    p.IDX = (int*)a.take((size_t)M_TOK * 2 * N_SEL);
    p.RWB = a.take((size_t)M_TOK * 6 * 512); p.GG = a.take((size_t)M_TOK * 512); p.RO = a.take((size_t)M_TOK * 512);
    p.MIX = a.take((size_t)M_TOK * MIX_W); p.XQ = a.take((size_t)M_TOK * XW); p.OX = a.take((size_t)M_TOK * XW);
    p.LIN = a.take((size_t)M_TOK * 256);
    p.RS0 = a.take(M_TOK); p.RS1 = a.take(M_TOK); p.RS2 = a.take(M_TOK); p.RS3 = a.take(M_TOK); p.RS4 = a.take(M_TOK);
    p.RSM = a.take(MEMROWS);
    p.X0b = (unsigned short*)a.take((size_t)M_TOK * D_MODEL / 2); p.X1b = (unsigned short*)a.take((size_t)M_TOK * D_MODEL / 2);
    p.X2b = (unsigned short*)a.take((size_t)M_TOK * D_MODEL / 2); p.X3b = (unsigned short*)a.take((size_t)M_TOK * D_MODEL / 2);
    p.Hb = (unsigned short*)a.take((size_t)M_TOK * D_FF / 2); p.MIXb = (unsigned short*)a.take((size_t)M_TOK * MIX_W / 2);
    p.OXb = (unsigned short*)a.take((size_t)M_TOK * XW / 2); p.MEMb = (unsigned short*)a.take((size_t)MEMROWS * D_MODEL / 2);
    p.Wgu1 = (unsigned short*)a.take((size_t)D_MODEL * D_FF); p.Wgu2 = (unsigned short*)a.take((size_t)D_MODEL * D_FF);
    p.Wd1 = (unsigned short*)a.take((size_t)D_MODEL * D_FF / 2); p.Wd2 = (unsigned short*)a.take((size_t)D_MODEL * D_FF / 2);
    p.Win = (unsigned short*)a.take((size_t)D_MODEL * 3104 / 2); p.Wout = (unsigned short*)a.take((size_t)MIX_W * D_MODEL / 2);
    p.Wxq = (unsigned short*)a.take((size_t)D_MODEL * XW / 2); p.Wxo = (unsigned short*)a.take((size_t)XW * D_MODEL / 2);
    p.Wxkv = (unsigned short*)a.take((size_t)D_MODEL * 1024 / 2);
    p.QNb = (unsigned short*)a.take((size_t)M_TOK * 512 / 2);
    p.KSb = (unsigned short*)a.take((size_t)MP * 128 / 2); p.KWb = (unsigned short*)a.take((size_t)MP * 128 / 2);
    p.VSt = (unsigned short*)a.take((size_t)MP * 128 / 2); p.VWt = (unsigned short*)a.take((size_t)MP * 128 / 2);
    p.VSb = (unsigned short*)a.take((size_t)MP * 128 / 2); p.VWb = (unsigned short*)a.take((size_t)MP * 128 / 2);
    p.KCb = (unsigned short*)a.take((size_t)BATCH * NBP * 128 / 2); p.VCt = (unsigned short*)a.take((size_t)BATCH * NBP * 128 / 2);
    p.XKb = (unsigned short*)a.take((size_t)BATCH * N_MEM * 512 / 2); p.XVb = (unsigned short*)a.take((size_t)BATCH * N_MEM * 512 / 2);
    p.XKSb = (unsigned short*)a.take((size_t)DEC_BATCH * N_MEM * 512 / 2); p.XVSb = (unsigned short*)a.take((size_t)DEC_BATCH * N_MEM * 512 / 2);
    p.ACK = (unsigned short*)a.take((size_t)N_CROWS * 4096 / 2); p.ACV = (unsigned short*)a.take((size_t)N_CROWS * 4096 / 2);
    p.WC1 = (unsigned short*)a.take((size_t)256 * 4096 / 2); p.PEB = a.take(256);
    p.DWAG = a.take((size_t)M_TOK * 1536); p.LINb = (unsigned short*)a.take((size_t)M_TOK * 256 / 2); p.Wlora = (unsigned short*)a.take((size_t)1536 * 256 / 2);
    p.RWH = (unsigned short*)a.take((size_t)M_TOK * 3 * 512 / 2);
    p.XQb = (unsigned short*)a.take((size_t)M_TOK * XW / 2); p.DWb = (unsigned short*)a.take((size_t)M_TOK * 1536 / 2); p.GGb = (unsigned short*)a.take((size_t)M_TOK * 512 / 2); p.BON = a.take((size_t)M_TOK * 8);
    p.KC32 = a.take((size_t)MP * 256); p.PRb = (unsigned short*)a.take((size_t)M_TOK * 1792 / 2);
    p.RHO = a.take((size_t)MP * 512);
    p.RPC = a.take((size_t)BATCH * 8 * NCH * 4096); p.RLC = a.take((size_t)BATCH * 8 * NCH * 4096); p.RSS = a.take((size_t)BATCH * 8 * NCH * 4096);
    return a.off;
}

#ifndef HOST_TEST
#define XB_TMO      128
#define XB_XCNT(j)  (256  + 64 * (j))
#define XB_XSUB(j)  (1280 + 64 * (j))
#define XB_XGEN(j)  (2304 + 64 * (j))
#define XB_TOP      3328
#define XB_TOPGEN   3392
#define XCD_BAR_WORDS 3456
#define XB_SPIN_CAP (1u << 28)
#define LAS __attribute__((address_space(3)))
__device__ __forceinline__ unsigned xb_ld(unsigned* p)              { return __hip_atomic_load(p, __ATOMIC_RELAXED, __HIP_MEMORY_SCOPE_AGENT); }
__device__ __forceinline__ unsigned xb_add(unsigned* p, unsigned v) { return __hip_atomic_fetch_add(p, v, __ATOMIC_RELAXED, __HIP_MEMORY_SCOPE_AGENT); }
__device__ __forceinline__ unsigned xb_xcc_id() { return (unsigned)__builtin_amdgcn_s_getreg((3 << 11) | 20) & 0xFu; }
#define XB_SPIN(cond, bar) do { unsigned _sp = 0; while (cond) { __builtin_amdgcn_s_sleep(1); \
    if ((++_sp & 255u) == 0u) { if (xb_ld(&(bar)[XB_TMO])) break; if (_sp > XB_SPIN_CAP) { atomicAdd(&(bar)[XB_TMO], 1u); break; } } } } while (0)
struct XcdBarrier { unsigned* bar; unsigned x; volatile LAS unsigned* st; };
__device__ __forceinline__ XcdBarrier xcd_barrier_post(unsigned* bar, volatile LAS unsigned* st) {
    XcdBarrier b; b.bar = bar; b.x = xb_xcc_id(); b.st = st;
    if (threadIdx.x == 0) (void)xb_add(&bar[XB_XCNT(b.x)], 1u);
    return b;
}
__device__ __forceinline__ void xcd_barrier_complete(unsigned* bar, unsigned x, unsigned& nloc, unsigned& nx) {
    const unsigned G = gridDim.x * gridDim.y * gridDim.z;
    unsigned sum, cnt, mine, sp = 0u;
    for (;;) {
        sum = 0u; cnt = 0u; mine = 0u;
#pragma unroll
        for (unsigned j = 0; j < 16; ++j) { const unsigned c = xb_ld(&bar[XB_XCNT(j)]); sum += c; cnt += (c > 0u) ? 1u : 0u; mine = (j == x) ? c : mine; }
        if (sum == G) break;
        __builtin_amdgcn_s_sleep(1);
        if ((++sp & 255u) == 0u) { if (xb_ld(&bar[XB_TMO])) break; if (sp > XB_SPIN_CAP) { atomicAdd(&bar[XB_TMO], 1u); break; } }
    }
    nloc = mine > 0u ? mine : 1u; nx = cnt > 0u ? cnt : 1u;
}
__device__ __forceinline__ void xcd_barrier(const XcdBarrier& b) {
    asm volatile("s_waitcnt vmcnt(0)" ::: "memory");
    __syncthreads();
    if (threadIdx.x == 0) {
        unsigned* bar = b.bar;
        __builtin_amdgcn_s_waitcnt(0);
        unsigned nloc = b.st[0], nx = b.st[1];
        if (nloc == 0u) { xcd_barrier_complete(bar, b.x, nloc, nx); b.st[0] = nloc; b.st[1] = nx; }
        const unsigned old = xb_add(&bar[XB_XSUB(b.x)], 1u);
        const unsigned gen = old / nloc;
        if (old + 1u == (gen + 1u) * nloc) {
            __builtin_amdgcn_fence(__ATOMIC_RELEASE, "agent");
            asm volatile("s_waitcnt vmcnt(0)" ::: "memory");
            const unsigned og = xb_add(&bar[XB_TOP], 1u);
            const unsigned tg = og / nx;
            if (og + 1u == (tg + 1u) * nx) xb_add(&bar[XB_TOPGEN], 1u);
            else XB_SPIN(xb_ld(&bar[XB_TOPGEN]) == tg, bar);
            __builtin_amdgcn_fence(__ATOMIC_ACQUIRE, "agent");
            xb_add(&bar[XB_XGEN(b.x)], 1u);
            asm volatile("s_waitcnt vmcnt(0)" ::: "memory");
        } else {
            XB_SPIN(xb_ld(&bar[XB_XGEN(b.x)]) == gen, bar);
            __builtin_amdgcn_fence(__ATOMIC_ACQUIRE, "agent");
            asm volatile("s_waitcnt vmcnt(0)" ::: "memory");
        }
    }
    __syncthreads();
}

__device__ __forceinline__ float xhalf_sum(float x) { const unsigned u = __float_as_uint(x); const auto r = __builtin_amdgcn_permlane32_swap(u, u, false, false); return __uint_as_float(r[0]) + __uint_as_float(r[1]); }
__device__ __forceinline__ float xhalf_max(float x) { const unsigned u = __float_as_uint(x); const auto r = __builtin_amdgcn_permlane32_swap(u, u, false, false); return fmaxf(__uint_as_float(r[0]), __uint_as_float(r[1])); }
__device__ __forceinline__ int hp_src(int n) { const int pn = n >> 8, t = n & 255; return (pn << 8) + 64 * ((t & 127) >> 5) + 32 * (t >> 7) + (t & 31); }
__device__ __forceinline__ float fast_sigmoid(float x) { return __builtin_amdgcn_rcpf(1.f + __expf(-x)); }
__device__ __forceinline__ float fast_tanh(float x) { return 1.f - 2.f * __builtin_amdgcn_rcpf(1.f + __expf(2.f * x)); }
__device__ __forceinline__ int opaque_tid() { int t = threadIdx.x; asm volatile("" : "+v"(t)); return t; }
namespace pg8 {
#define PG8_LAS __attribute__((address_space(3)))
typedef unsigned short bf16_t;
typedef short bf16x8 __attribute__((ext_vector_type(8)));
typedef float f32x4 __attribute__((ext_vector_type(4)));
typedef unsigned u32x4 __attribute__((ext_vector_type(4)));
typedef unsigned u32x2 __attribute__((ext_vector_type(2)));
constexpr int BM = 256, BK = 64, HALF = 128, HTB = HALF * BK * 2, STAGE_BYTES = 8 * HTB, NXCD = 8, WGM = 8;
__host__ __device__ __forceinline__ int lds_byte(int r, int c) { const int st = (r >> 4) * 2 + (c >> 5), rr = r & 15, cc = c & 31, ob = rr * 64 + cc * 2; return st * 1024 + (ob ^ (((ob >> 9) & 1) << 5)); }
__host__ __device__ __forceinline__ void stage_rc(int b, int& R, int& C) { const int st = b / 1024, sb = b % 1024, swz = sb ^ (((sb >> 9) & 1) << 5); R = (st >> 1) * 16 + swz / 64; C = (st & 1) * 32 + (swz % 64) / 2; }
__host__ __device__ __forceinline__ int perm32(int rho) { const int n = rho >> 4, i = rho & 15; return 8 * (i >> 2) + 4 * n + (i & 3); }
struct Unit { int pm, pn; };
struct Gemm { const bf16_t* A; const bf16_t* Bt; int M, N, K; };
struct StaticOrder {
    int nM, nN, nwg, G, c;
    __host__ __device__ void init(int M, int N, int G_, int c_) { nM = M / BM; nN = N / BM; nwg = nM * nN; G = G_; c = c_; }
    __host__ __device__ bool next(int i, Unit& u) const {
        const long L = (long)i * G + c; if (L >= nwg) return false;
        int wgid = (int)L; { const int q = nwg / NXCD, r = nwg % NXCD, xcd = wgid % NXCD, off = wgid / NXCD; wgid = (xcd < r ? xcd * (q + 1) : r * (q + 1) + (xcd - r) * q) + off; }
        const int nig = WGM * nN, gid = wgid / nig, fm = gid * WGM, gsz = (nM - fm) < WGM ? (nM - fm) : WGM;
        u.pm = fm + ((wgid % nig) % gsz); u.pn = (wgid % nig) / gsz; return true;
    }
    __device__ __forceinline__ void a_ready(const Unit&) const {}
    __device__ __forceinline__ void done(const Unit&) const {}
};
__device__ __forceinline__ unsigned cvt_pk_bf16(float lo, float hi) { unsigned r; asm volatile("v_cvt_pk_bf16_f32 %0, %1, %2" : "=v"(r) : "v"(lo), "v"(hi)); return r; }

__device__ __forceinline__ float silu_fast(float x) { return x * __builtin_amdgcn_rcpf(1.f + __expf(-x)); }
struct EpiGU {
    static constexpr bool PERM = true, AFTER_DRAIN = false;
    bf16_t* H; int ldh; const float* ss;
    __device__ __forceinline__ void operator()(const f32x4 (&acc)[2][2][4][2], const Unit& u, int wr, int wc, int fr, int fq) const {
        const int row0 = u.pm * BM + wr * 64 + fr, col0 = u.pn * HALF + wc * 32 + 8 * fq;
#pragma unroll
        for (int ai = 0; ai < 2; ++ai)
#pragma unroll
            for (int m = 0; m < 4; ++m) {
                const int row = row0 + ai * HALF + m * 16;
                const float rs = rs_of(ss[row], D_MODEL);
                u32x4 o;
#pragma unroll
                for (int n = 0; n < 2; ++n) {
                    const f32x4 g = acc[ai][0][m][n] * rs, up = acc[ai][1][m][n] * rs;
                    o[2 * n] = cvt_pk_bf16(silu_fast(g[0]) * up[0], silu_fast(g[1]) * up[1]);
                    o[2 * n + 1] = cvt_pk_bf16(silu_fast(g[2]) * up[2], silu_fast(g[3]) * up[3]);
                }
                *(u32x4*)(H + (size_t)row * ldh + col0) = o;
            }
    }
};
struct EpiRes {
    static constexpr bool PERM = false, AFTER_DRAIN = false;
    float* C; const float* R; bf16_t* Cb; int ldc; float alpha; float* ss;
    __device__ __forceinline__ void operator()(const f32x4 (&acc)[2][2][4][2], const Unit& u, int wr, int wc, int fr, int fq) const {
        const int row0 = u.pm * BM + wr * 64 + fr, col0 = u.pn * BM + wc * 32 + 4 * fq;
#pragma unroll
        for (int ai = 0; ai < 2; ++ai)
#pragma unroll
            for (int m = 0; m < 4; ++m) {
                const int row = row0 + ai * HALF + m * 16;
                const size_t ro = (size_t)row * ldc + col0;
                float sq = 0.f;
#pragma unroll
                for (int bj = 0; bj < 2; ++bj)
#pragma unroll
                    for (int n = 0; n < 2; ++n) {
                        const size_t o = ro + bj * HALF + n * 16;
                        f32x4 v = *(const f32x4*)(R + o) + acc[ai][bj][m][n] * alpha;
                        *(f32x4*)(C + o) = v;
                        u32x2 b; b[0] = cvt_pk_bf16(v[0], v[1]); b[1] = cvt_pk_bf16(v[2], v[3]);
                        *(u32x2*)(Cb + o) = b;
                        sq += v[0] * v[0] + v[1] * v[1] + v[2] * v[2] + v[3] * v[3];
                    }
                sq += __shfl_xor(sq, 16); sq += __shfl_xor(sq, 32);
                if (fq == 0) atomicAdd(ss + row, sq);
            }
    }
};
struct EpiRes2 {
    static constexpr bool PERM = true, AFTER_DRAIN = false;
    const float* R32; const bf16_t* Rb; float* C32; bf16_t* Cb; int ldc; float alpha; float* ss;
    __device__ __forceinline__ void operator()(const f32x4 (&acc)[2][2][4][2], const Unit& u, int wr, int wc, int fr, int fq) const {
        const int row0 = u.pm * BM + wr * 64 + fr, col0 = u.pn * BM + wc * 32 + 8 * fq;
#pragma unroll
        for (int ai = 0; ai < 2; ++ai)
#pragma unroll
            for (int m = 0; m < 4; ++m) {
                const int row = row0 + ai * HALF + m * 16;
                const size_t ro = (size_t)row * ldc + col0;
                float sq = 0.f;
#pragma unroll
                for (int bj = 0; bj < 2; ++bj) {
                    const size_t o = ro + bj * HALF;
                    f32x4 r0, r1;
                    if (R32) { r0 = *(const f32x4*)(R32 + o); r1 = *(const f32x4*)(R32 + o + 4); }
                    else {
                        const u32x4 rb = *(const u32x4*)(Rb + o);
                        r0[0] = __uint_as_float(rb[0] << 16); r0[1] = __uint_as_float(rb[0] & 0xffff0000u); r0[2] = __uint_as_float(rb[1] << 16); r0[3] = __uint_as_float(rb[1] & 0xffff0000u);
                        r1[0] = __uint_as_float(rb[2] << 16); r1[1] = __uint_as_float(rb[2] & 0xffff0000u); r1[2] = __uint_as_float(rb[3] << 16); r1[3] = __uint_as_float(rb[3] & 0xffff0000u);
                    }
                    const f32x4 v0 = r0 + acc[ai][bj][m][0] * alpha, v1 = r1 + acc[ai][bj][m][1] * alpha;
                    if (C32) { *(f32x4*)(C32 + o) = v0; *(f32x4*)(C32 + o + 4) = v1; }
                    u32x4 b; b[0] = cvt_pk_bf16(v0[0], v0[1]); b[1] = cvt_pk_bf16(v0[2], v0[3]); b[2] = cvt_pk_bf16(v1[0], v1[1]); b[3] = cvt_pk_bf16(v1[2], v1[3]);
                    *(u32x4*)(Cb + o) = b;
                    sq += v0[0] * v0[0] + v0[1] * v0[1] + v0[2] * v0[2] + v0[3] * v0[3] + v1[0] * v1[0] + v1[1] * v1[1] + v1[2] * v1[2] + v1[3] * v1[3];
                }
                sq += __shfl_xor(sq, 16); sq += __shfl_xor(sq, 32);
                if (fq == 0) atomicAdd(ss + row, sq);
            }
    }
};
struct EpiScaleB {
    static constexpr bool PERM = true, AFTER_DRAIN = false;
    bf16_t* O; int ldc; const float* ss;
    __device__ __forceinline__ void operator()(const f32x4 (&acc)[2][2][4][2], const Unit& u, int wr, int wc, int fr, int fq) const {
        const int row0 = u.pm * BM + wr * 64 + fr, col0 = u.pn * BM + wc * 32 + 8 * fq;
#pragma unroll
        for (int ai = 0; ai < 2; ++ai)
#pragma unroll
            for (int m = 0; m < 4; ++m) {
                const int row = row0 + ai * HALF + m * 16;
                const float rs = ss ? rs_of(ss[row], D_MODEL) : 1.f;
#pragma unroll
                for (int bj = 0; bj < 2; ++bj) {
                    const f32x4 v0 = acc[ai][bj][m][0] * rs, v1 = acc[ai][bj][m][1] * rs;
                    u32x4 b; b[0] = cvt_pk_bf16(v0[0], v0[1]); b[1] = cvt_pk_bf16(v0[2], v0[3]); b[2] = cvt_pk_bf16(v1[0], v1[1]); b[3] = cvt_pk_bf16(v1[2], v1[3]);
                    *(u32x4*)(O + (size_t)row * ldc + col0 + bj * HALF) = b;
                }
            }
    }
};
struct EpiCmp {
    static constexpr bool PERM = false, AFTER_DRAIN = false;
    float* CH; const float* bias; int c; int nrows;
    __device__ __forceinline__ void operator()(const f32x4 (&acc)[2][2][4][2], const Unit& u, int wr, int wc, int fr, int fq) const {
        const int row0 = u.pm * BM + wr * 64 + fr, col0 = wc * 32 + 4 * fq;
#pragma unroll
        for (int ai = 0; ai < 2; ++ai)
#pragma unroll
            for (int m = 0; m < 4; ++m) {
                const int row = row0 + ai * HALF + m * 16;
                if (row < nrows) {
#pragma unroll
                    for (int n = 0; n < 2; ++n) {
                        const f32x4 b = *(const f32x4*)(bias + c * 128 + col0 + n * 16);
                        const f32x4 x = (c == 0 ? acc[ai][0][m][n] : acc[ai][1][m][n]) + b;
                        f32x4 o; o[0] = geluf_(x[0]); o[1] = geluf_(x[1]); o[2] = geluf_(x[2]); o[3] = geluf_(x[3]);
                        *(f32x4*)(CH + ((size_t)row * 2 + c) * 128 + col0 + n * 16) = o;
                    }
                }
            }
    }
};
struct EpiIn {
    static constexpr bool PERM = true, AFTER_DRAIN = false;
    const float* RS1; const float* q_g; const float* ks_g; const float* kw_g; const float* gate_b; float* out; bf16_t* QNb; float* KC32;
    bf16_t *KSb, *VSb, *KWb, *VWb; float* GT; bf16_t* PRb;
    __device__ __forceinline__ void operator()(const f32x4 (&acc)[2][2][4][2], const Unit& u, int wr, int wc, int fr, int fq) const {
        const int G = 4 * u.pn + wc;
        const int row0 = u.pm * BM + wr * 64 + fr;
        const bool nrm = (G < 8) || G == 12 || G == 13 || G == 16 || G == 17;
        f32x4 gn[2][2];
        if (nrm) {
#pragma unroll
            for (int bj = 0; bj < 2; ++bj)
#pragma unroll
                for (int n = 0; n < 2; ++n) {
                    const int go = 32 * bj + 8 * fq + 4 * n;
                    if (G < 8) gn[bj][n] = *(const f32x4*)(q_g + go) * 0.125f; else if (G < 14) gn[bj][n] = *(const f32x4*)(ks_g + go); else gn[bj][n] = *(const f32x4*)(kw_g + go);
                }
        }
#pragma unroll
        for (int ai = 0; ai < 2; ++ai)
#pragma unroll
            for (int m = 0; m < 4; ++m) {
                const int row = row0 + ai * HALF + m * 16;
                const float rs = __builtin_amdgcn_rsqf(RS1[row] * (1.f / D_MODEL) + RMS_EPS);
                const int nb = row / SEQ, ti = row % SEQ;
                f32x4 v[2][2];
#pragma unroll
                for (int bj = 0; bj < 2; ++bj)
#pragma unroll
                    for (int n = 0; n < 2; ++n) v[bj][n] = acc[ai][bj][m][n] * rs;
                if (nrm) {
                    float sq = 0.f;
#pragma unroll
                    for (int bj = 0; bj < 2; ++bj)
#pragma unroll
                        for (int n = 0; n < 2; ++n) sq += v[bj][n][0] * v[bj][n][0] + v[bj][n][1] * v[bj][n][1] + v[bj][n][2] * v[bj][n][2] + v[bj][n][3] * v[bj][n][3];
                    sq += __shfl_xor(sq, 16); sq += __shfl_xor(sq, 32);
                    const float rr = __builtin_amdgcn_rsqf(sq * (1.f / 64.f) + RMS_EPS);
#pragma unroll
                    for (int bj = 0; bj < 2; ++bj)
#pragma unroll
                        for (int n = 0; n < 2; ++n) v[bj][n] = v[bj][n] * rr * gn[bj][n];
                }
#pragma unroll
                for (int bj = 0; bj < 2; ++bj) {
                    const int d = 32 * bj + 8 * fq;
                    const f32x4 x0 = v[bj][0], x1 = v[bj][1];
                    u32x4 b; b[0] = cvt_pk_bf16(x0[0], x0[1]); b[1] = cvt_pk_bf16(x0[2], x0[3]); b[2] = cvt_pk_bf16(x1[0], x1[1]); b[3] = cvt_pk_bf16(x1[2], x1[3]);
                    if (G < 8) {
                        *(u32x4*)(QNb + (size_t)row * 512 + 64 * G + d) = b;
                    } else if (G < 20) {
                        const int c6 = (G - 8) >> 1, g = G & 1, cc = c6 * 128 + g * 64 + d;
                        if (c6 < 2) { float* q = KC32 + (size_t)row * 256 + cc; *(f32x4*)q = x0; *(f32x4*)(q + 4) = x1; }
                        if (c6 < 4) { float* q = out + O_KV_P + (size_t)row * 512 + cc; *(f32x4*)q = x0; *(f32x4*)(q + 4) = x1; }
                        else if (ti >= SEQ - WP) { float* q = out + O_WIN_P + ((size_t)nb * WP + (ti - (SEQ - WP))) * 256 + cc - 512; *(f32x4*)q = x0; *(f32x4*)(q + 4) = x1; }
                        if (c6 >= 2) {
                            const size_t o = (((size_t)nb * 2 + g) * SEQ + ti) * 64 + d;
                            if (c6 == 2) *(u32x4*)(KSb + o) = b; else if (c6 == 3) *(u32x4*)(VSb + o) = b; else if (c6 == 4) *(u32x4*)(KWb + o) = b; else *(u32x4*)(VWb + o) = b;
                        }
                    } else {
                        const int c = 64 * G + d - NSA_COLS;
                        if (c < 0) {
                            const f32x4 g0 = *(const f32x4*)(gate_b + d), g1 = *(const f32x4*)(gate_b + d + 4);
                            f32x4 a0, a1;
#pragma unroll
                            for (int e = 0; e < 4; ++e) { a0[e] = fast_sigmoid(x0[e] + g0[e]); a1[e] = fast_sigmoid(x1[e] + g1[e]); }
                            *(f32x4*)(GT + (size_t)row * 24 + d) = a0; *(f32x4*)(GT + (size_t)row * 24 + d + 4) = a1;
                        } else {
                            *(u32x4*)(PRb + (size_t)row * RWKV_COLS + c) = b;
                            if (ti == SEQ - 1) { float* q = out + O_SH_P + (size_t)nb * RWKV_COLS + c; *(f32x4*)q = x0; *(f32x4*)(q + 4) = x1; }
                        }
                    }
                }
            }
    }
};
struct EpiScale {
    static constexpr bool PERM = false, AFTER_DRAIN = false;
    float* C; int ldc; const float* ss;
    __device__ __forceinline__ void operator()(const f32x4 (&acc)[2][2][4][2], const Unit& u, int wr, int wc, int fr, int fq) const {
        const int row0 = u.pm * BM + wr * 64 + fr, col0 = u.pn * BM + wc * 32 + 4 * fq;
#pragma unroll
        for (int ai = 0; ai < 2; ++ai)
#pragma unroll
            for (int m = 0; m < 4; ++m) {
                const int row = row0 + ai * HALF + m * 16;
                const float rs = ss ? rs_of(ss[row], D_MODEL) : 1.f;
                float* rowp = C + (size_t)row * ldc + col0;
#pragma unroll
                for (int bj = 0; bj < 2; ++bj)
#pragma unroll
                    for (int n = 0; n < 2; ++n) *(f32x4*)(rowp + bj * HALF + n * 16) = acc[ai][bj][m][n] * rs;
            }
    }
};

template <class Epi, class Sched>
__device__ __forceinline__ void gemm_phase(PG8_LAS unsigned char* lds, const Gemm g, const Sched& S, const Epi& E) {
    const int tid = opaque_tid(), wid = __builtin_amdgcn_readfirstlane(tid >> 6), lane = tid & 63, wr = wid >> 2, wc = wid & 3, fr = lane & 15, fq = lane >> 4;
    const int K = g.K, nt = K / BK;
    unsigned voffA[2], voffB[2];
#pragma unroll
    for (int i = 0; i < 2; ++i) { int R, C; stage_rc(tid * 16 + i * 8192, R, C); const int Rb = Epi::PERM ? ((R & ~31) + perm32(R & 31)) : R;
        voffA[i] = (unsigned)(R * K + C) * 2u; voffB[i] = (unsigned)(Rb * K + C) * 2u; }
    const size_t kstep = (size_t)(BK * 2);
    const size_t hstep = (size_t)HALF * K * 2;
    const size_t tstep = 2 * hstep;
    const unsigned ldsw = (unsigned)wid * 1024u;
    const int aoff = lds_byte(wr * 64 + fr, fq * 8), boff = lds_byte(wc * 32 + fr, fq * 8);
#define PG8_SA(b, h) (((b) * 2 + (h)) * HTB)
#define PG8_SB(b, h) ((4 + (b) * 2 + (h)) * HTB)
#define PG8_STAGE(bufoff, gbase, voff) do { _Pragma("unroll") for (int _i = 0; _i < 2; ++_i) \
        __builtin_amdgcn_global_load_lds((const unsigned*)((const char*)(gbase) + (voff)[_i]), (PG8_LAS unsigned*)(lds + (bufoff) + ldsw + _i * 8192), 16, 0, 0); } while (0)
#define PG8_LDA(dst, b, h) do { _Pragma("unroll") for (int m = 0; m < 4; ++m) _Pragma("unroll") for (int k = 0; k < 2; ++k) dst[m][k] = *(const PG8_LAS bf16x8*)(lds + PG8_SA(b, h) + aoff + m * 2048 + k * 1024); } while (0)
#define PG8_LDB(dst, b, h) do { _Pragma("unroll") for (int n = 0; n < 2; ++n) _Pragma("unroll") for (int k = 0; k < 2; ++k) dst[n][k] = *(const PG8_LAS bf16x8*)(lds + PG8_SB(b, h) + boff + n * 2048 + k * 1024); } while (0)
#define PG8_MMA(ai, bj, At, Bt) do { __builtin_amdgcn_s_setprio(1); _Pragma("unroll") for (int m = 0; m < 4; ++m) _Pragma("unroll") for (int n = 0; n < 2; ++n) _Pragma("unroll") for (int k = 0; k < 2; ++k) \
        acc[ai][bj][m][n] = __builtin_amdgcn_mfma_f32_16x16x32_bf16(Bt[n][k], At[m][k], acc[ai][bj][m][n], 0, 0, 0); __builtin_amdgcn_s_setprio(0); } while (0)
#define PG8_WAIT_V(n) asm volatile("s_waitcnt vmcnt(" #n ")" ::: "memory")
#define PG8_WAIT_L(n) asm volatile("s_waitcnt lgkmcnt(" #n ")" ::: "memory")
#define PG8_BAR __builtin_amdgcn_s_barrier()
#define PG8_SCHED __builtin_amdgcn_sched_barrier(0)
    Unit cur, nxt; int ui = 0;
    if (!S.next(0, cur)) return;
    f32x4 acc[2][2][4][2];
#pragma unroll
    for (int a = 0; a < 2; ++a)
#pragma unroll
        for (int b = 0; b < 2; ++b)
#pragma unroll
            for (int m = 0; m < 4; ++m)
#pragma unroll
                for (int n = 0; n < 2; ++n) acc[a][b][m][n] = (f32x4){0.f, 0.f, 0.f, 0.f};
    bf16x8 At[4][2], B0[2][2], B1[2][2];
    const char* cA = (const char*)g.A + (size_t)cur.pm * tstep; const char* cB = (const char*)g.Bt + (size_t)cur.pn * tstep;
    S.a_ready(cur);
    PG8_STAGE(PG8_SB(0, 0), cB, voffB); PG8_STAGE(PG8_SA(0, 0), cA, voffA); PG8_STAGE(PG8_SB(0, 1), cB + hstep, voffB); PG8_STAGE(PG8_SA(0, 1), cA + hstep, voffA);
    if (wr == 1) PG8_BAR;
    PG8_WAIT_V(4); PG8_BAR;
    PG8_STAGE(PG8_SB(1, 0), cB + kstep, voffB); PG8_STAGE(PG8_SA(1, 0), cA + kstep, voffA); PG8_STAGE(PG8_SB(1, 1), cB + hstep + kstep, voffB);
    PG8_WAIT_V(6); PG8_BAR;
    for (;;) {
        const bool has_next = S.next(ui + 1, nxt);
        const char* nA = has_next ? (const char*)g.A + (size_t)nxt.pm * tstep : cA; const char* nB = has_next ? (const char*)g.Bt + (size_t)nxt.pn * tstep : cB;
        for (int t = 0; t < nt; t += 2) {
            const bool last = (t == nt - 2);
            const char* a1 = cA + (size_t)(t + 1) * kstep;
            const char* a2 = last ? nA : cA + (size_t)(t + 2) * kstep; const char* b2 = last ? nB : cB + (size_t)(t + 2) * kstep;
            const char* a3 = a2 + kstep; const char* b3 = b2 + kstep;
            if (last && has_next) S.a_ready(nxt);
            PG8_LDB(B0, 0, 0); PG8_SCHED; PG8_LDA(At, 0, 0); PG8_STAGE(PG8_SA(1, 1), a1 + hstep, voffA);
            PG8_WAIT_L(8); PG8_BAR; PG8_WAIT_L(0); PG8_MMA(0, 0, At, B0); PG8_BAR; PG8_SCHED;
            PG8_LDB(B1, 0, 1); PG8_STAGE(PG8_SB(0, 0), b2, voffB);
            PG8_BAR; PG8_WAIT_L(0); PG8_MMA(0, 1, At, B1); PG8_BAR;
            PG8_LDA(At, 0, 1); PG8_STAGE(PG8_SA(0, 0), a2, voffA);
            PG8_BAR; PG8_WAIT_L(0); PG8_MMA(1, 0, At, B0); PG8_BAR; PG8_SCHED;
            PG8_STAGE(PG8_SB(0, 1), b2 + hstep, voffB);
            PG8_WAIT_V(6); PG8_BAR; PG8_MMA(1, 1, At, B1); PG8_BAR;
            PG8_LDB(B0, 1, 0); PG8_SCHED; PG8_LDA(At, 1, 0); PG8_STAGE(PG8_SA(0, 1), a2 + hstep, voffA);
            PG8_WAIT_L(8); PG8_BAR; PG8_WAIT_L(0); PG8_MMA(0, 0, At, B0); PG8_BAR; PG8_SCHED;
            PG8_LDB(B1, 1, 1); PG8_STAGE(PG8_SB(1, 0), b3, voffB);
            PG8_BAR; PG8_WAIT_L(0); PG8_MMA(0, 1, At, B1); PG8_BAR;
            PG8_LDA(At, 1, 1); PG8_STAGE(PG8_SA(1, 0), a3, voffA);
            PG8_BAR; PG8_WAIT_L(0); PG8_MMA(1, 0, At, B0); PG8_BAR; PG8_SCHED;
            PG8_STAGE(PG8_SB(1, 1), b3 + hstep, voffB);
            PG8_WAIT_V(6); PG8_BAR; PG8_MMA(1, 1, At, B1); PG8_BAR;
        }
        E(acc, cur, wr, wc, fr, fq); S.done(cur);
        if (!has_next) break;
#pragma unroll
        for (int a = 0; a < 2; ++a)
#pragma unroll
            for (int b = 0; b < 2; ++b)
#pragma unroll
                for (int m = 0; m < 4; ++m)
#pragma unroll
                    for (int n = 0; n < 2; ++n) acc[a][b][m][n] = (f32x4){0.f, 0.f, 0.f, 0.f};
        cur = nxt; cA = nA; cB = nB; ++ui;
    }
    PG8_WAIT_V(0);
    if (wr == 0) PG8_BAR;
    PG8_BAR;
#undef PG8_SA
#undef PG8_SB
#undef PG8_STAGE
#undef PG8_LDA
#undef PG8_LDB
#undef PG8_MMA
#undef PG8_WAIT_V
#undef PG8_WAIT_L
#undef PG8_BAR
#undef PG8_SCHED
}
}

namespace nsa {
typedef short bf16x8 __attribute__((ext_vector_type(8)));
typedef short s16x4 __attribute__((ext_vector_type(4)));
typedef float f32x16 __attribute__((ext_vector_type(16)));
typedef unsigned u32x4 __attribute__((ext_vector_type(4)));
typedef unsigned u32x2 __attribute__((ext_vector_type(2)));
#define NSA_MFMA(a, b, c) __builtin_amdgcn_mfma_f32_32x32x16_bf16((a), (b), (c), 0, 0, 0)
constexpr int KROW = 144, TILE_B = 64 * KROW;
constexpr int L_K = 0, L_V = 2 * TILE_B, L_IMP = 4 * TILE_B, L_UN = L_IMP + 8 * 2048, L_END = L_UN + 128;
constexpr float LOG2E = 1.4426950408889634f;
#define NSA_NEG (-__builtin_inff())
__device__ __forceinline__ bf16x8 pack8(const f32x16& x, int s) {
    u32x4 p;
    asm volatile("v_cvt_pk_bf16_f32 %0, %4, %5\n\tv_cvt_pk_bf16_f32 %1, %6, %7\n\tv_cvt_pk_bf16_f32 %2, %8, %9\n\tv_cvt_pk_bf16_f32 %3, %10, %11\n\ts_nop 1"
                 : "=&v"(p[0]), "=&v"(p[1]), "=&v"(p[2]), "=&v"(p[3])
                 : "v"(x[8 * s]), "v"(x[8 * s + 1]), "v"(x[8 * s + 2]), "v"(x[8 * s + 3]), "v"(x[8 * s + 4]), "v"(x[8 * s + 5]), "v"(x[8 * s + 6]), "v"(x[8 * s + 7]));
    return __builtin_bit_cast(bf16x8, p);
}
template <int DS, int NDB, int KSTR, int VSTR, bool HASB>
__device__ __forceinline__ void tile_step_g(const LAS unsigned char* Kb, const LAS unsigned char* Vb, const bf16x8 (&qf)[DS], f32x16 (&o)[NDB], f32x16 (&st)[2],
                                            float& m_run, float& l_run, float SC, const bf16x8 (&kext)[2], const bf16x8& qext, int lim_lo, int lim_hi, int ql, int h) {
#pragma unroll
    for (int sub = 0; sub < 2; ++sub) {
#pragma unroll
        for (int i = 0; i < 16; ++i) st[sub][i] = 0.f;
#pragma unroll
        for (int s = 0; s < DS; ++s) {
            const bf16x8 a = *(const LAS bf16x8*)(Kb + (32 * sub + ql) * KSTR + 32 * s + 16 * h);
            st[sub] = NSA_MFMA(a, qf[s], st[sub]);
        }
        if (HASB) st[sub] = NSA_MFMA(kext[sub], qext, st[sub]);
    }
    __builtin_amdgcn_sched_barrier(0);
    float mloc = NSA_NEG;
    const bool rowfull = (lim_lo <= 0 && lim_hi >= 59), rownone = (lim_hi < 0) || (lim_lo > 63);
    bool dead = false;
    if (__all(rowfull || rownone)) {
#pragma unroll
        for (int sub = 0; sub < 2; ++sub)
#pragma unroll
            for (int i = 0; i < 16; ++i) mloc = fmaxf(mloc, st[sub][i]);
        dead = rownone;
        if (dead) mloc = NSA_NEG;
    } else {
#pragma unroll
        for (int sub = 0; sub < 2; ++sub)
#pragma unroll
            for (int i = 0; i < 16; ++i) {
                const int c = 32 * sub + (i & 3) + 8 * (i >> 2);
                const float sv = ((c >= lim_lo) && (c <= lim_hi)) ? st[sub][i] : NSA_NEG;
                st[sub][i] = sv; mloc = fmaxf(mloc, sv);
            }
    }
    mloc = xhalf_max(mloc);
    const float mnew = fmaxf(m_run, mloc);
    const float msafe = (mnew == NSA_NEG) ? 0.f : mnew;
    const float alpha = __builtin_amdgcn_exp2f((m_run - msafe) * SC);
    const float nm = dead ? NSA_NEG : -msafe * SC;
    m_run = mnew;
    float ls = 0.f;
#pragma unroll
    for (int sub = 0; sub < 2; ++sub)
#pragma unroll
        for (int i = 0; i < 16; ++i) { const float pv = __builtin_amdgcn_exp2f(fmaf(st[sub][i], SC, nm)); st[sub][i] = pv; ls += pv; }
    l_run = l_run * alpha + ls;
    if (!__all(alpha == 1.f)) {
#pragma unroll
        for (int db = 0; db < NDB; ++db)
#pragma unroll
            for (int i = 0; i < 16; ++i) o[db][i] *= alpha;
    }
    __builtin_amdgcn_sched_barrier(0);
#pragma unroll
    for (int sub = 0; sub < 2; ++sub)
#pragma unroll
        for (int s2 = 0; s2 < 2; ++s2) {
            __builtin_amdgcn_sched_barrier(0);
            const bf16x8 pf = pack8(st[sub], s2);
#pragma unroll
            for (int db = 0; db < NDB; ++db) {
                const LAS unsigned char* vr = Vb + (32 * db + ql) * VSTR + (32 * sub + 16 * s2 + 4 * h) * 2;
                const s16x4 lo = *(const LAS s16x4*)(vr), hi = *(const LAS s16x4*)(vr + 16);
                const bf16x8 vf = __builtin_shufflevector(lo, hi, 0, 1, 2, 3, 4, 5, 6, 7);
                o[db] = NSA_MFMA(vf, pf, o[db]);
            }
        }
}
__device__ __forceinline__ bf16x8 bias_kext(int c64, int c65, int h) {
    bf16x8 v = {0, 0, 0, 0, 0, 0, 0, 0};
    if (h == 0) { v[0] = (short)f2bf((float)c64); v[1] = (short)f2bf((float)c65); }
    return v;
}
__device__ __forceinline__ bf16x8 bias_qext(float slope, int h) {
    bf16x8 v = {0, 0, 0, 0, 0, 0, 0, 0};
    if (h == 0) { v[0] = (short)f2bf(64.f * slope); v[1] = (short)f2bf(slope); }
    return v;
}
struct TileSrc { const unsigned short* k; const unsigned short* v; long vstride; };
__device__ __forceinline__ void tile_issue(const TileSrc& t, int tid, u32x4& kr, u32x4& vr) {
    const int row = tid >> 3, seg = tid & 7;
    kr = *(const u32x4*)(t.k + row * 64 + seg * 8);
    vr = *(const u32x4*)(t.v + (t.vstride > 0 ? (long)row * t.vstride : (long)row * 64) + seg * 8);
}
template <bool VT>
__device__ __forceinline__ void tile_commit(LAS unsigned char* lds, int buf, int tid, const u32x4& kr, const u32x4& vr) {
    const int row = tid >> 3, seg = tid & 7;
    *(LAS u32x4*)(lds + L_K + buf * TILE_B + row * KROW + seg * 16) = kr;
    if (VT) *(LAS u32x4*)(lds + L_V + buf * TILE_B + row * KROW + seg * 16) = vr;
    else {
        LAS unsigned char* vb = lds + L_V + buf * TILE_B + (seg * 8) * KROW + row * 2;
#pragma unroll
        for (int e = 0; e < 8; ++e) *(LAS unsigned short*)(vb + e * KROW) = (unsigned short)(vr[e >> 1] >> (16 * (e & 1)));
    }
}

__device__ __forceinline__ void prompt_unit(const Params& p, LAS unsigned char* lds, int n, int g, int qb) {
    const int tid = opaque_tid(), lane = tid & 63, w = __builtin_amdgcn_readfirstlane(tid >> 6), ql = lane & 31, h = lane >> 5;
    const int tloc = ql >> 2, r = ql & 3, tl = 8 * w + tloc, head = g * 4 + r;
    const int t0 = qb * 64, tq = t0 + tl;
    const long m = (long)n * SEQ + tq;
    const bf16x8 qext = bias_qext(exp2f(-(float)(head + 1)), h);
    bf16x8 qf[4];
#pragma unroll
    for (int s = 0; s < 4; ++s) qf[s] = *(const bf16x8*)(p.QNb + m * 512 + head * 64 + 16 * s + 8 * h);
    const float gc = p.GT[m * 24 + head * 3 + 0], gs = p.GT[m * 24 + head * 3 + 1], gw = p.GT[m * 24 + head * 3 + 2];
    f32x16 outacc[2], o[2], st[2];
#pragma unroll
    for (int db = 0; db < 2; ++db)
#pragma unroll
        for (int i = 0; i < 16; ++i) { outacc[db][i] = 0.f; o[db][i] = 0.f; }
    u32x4 kr, vr;
    const long ng = (long)n * 2 + g;
    {
        TileSrc ts{p.KCb + ng * NBP * 64, p.VCt + ng * 64 * NBP, NBP};
        tile_issue(ts, tid, kr, vr); tile_commit<true>(lds, 0, tid, kr, vr);
        __syncthreads();
        float m_run = NSA_NEG, l_run = 0.f;
        const bf16x8 kext[2] = {bias_kext(ql - qb, 63, h), bias_kext(32 + ql - qb, 63, h)};
        tile_step_g<4, 2, KROW, KROW, true>(lds + L_K, lds + L_V, qf, o, st, m_run, l_run, LOG2E, kext, qext, -1000, ((tq + 1) >> 6) - 1 - 4 * h, ql, h);
        const float ltot = xhalf_sum(l_run);
        const float inv = ltot > 0.f ? 1.f / ltot : 0.f;
#pragma unroll
        for (int db = 0; db < 2; ++db)
#pragma unroll
            for (int i = 0; i < 16; ++i) { outacc[db][i] += gc * inv * o[db][i]; o[db][i] = 0.f; }
        LAS float* impw = (LAS float*)(lds + L_IMP + w * 2048);
#pragma unroll
        for (int sub = 0; sub < 2; ++sub)
#pragma unroll
            for (int i = 0; i < 16; ++i) {
                float v = st[sub][i] * inv;
                v += __shfl_xor(v, 1); v += __shfl_xor(v, 2);
                const int kk = 32 * sub + (i & 3) + 8 * (i >> 2) + 4 * h;
                if (r == 0) impw[tloc * 64 + kk] = v;
            }
    }
    __syncthreads();
    unsigned long long mymask = 0ull, un = 0ull;
    {
        const LAS float* impw = (const LAS float*)(lds + L_IMP + w * 2048);
        for (int tt = 0; tt < 8; ++tt) {
            const int b = lane;
            const bool forced = (b == 0) || (b == qb) || (b == qb - 1);
            float sc = forced ? 1e9f : ((b <= qb) ? impw[tt * 64 + b] : -1e9f);
            int rank = 0;
#pragma unroll
            for (int j = 0; j < 64; ++j) {
                const float sj = __int_as_float(__builtin_amdgcn_readlane(__float_as_int(sc), j));
                rank += (sj > sc || (sj == sc && j < b)) ? 1 : 0;
            }
            const unsigned long long mk = __ballot(rank < N_SEL);
            if (tloc == tt) mymask = mk;
            un |= mk;
        }
        if (lane == 0) *(LAS unsigned long long*)(lds + L_UN + w * 8) = un;
    }
    __syncthreads();
    {
        unsigned long long u2 = 0ull;
#pragma unroll
        for (int k = 0; k < 8; ++k) u2 |= *(const LAS unsigned long long*)(lds + L_UN + k * 8);
        un = u2;
        const unsigned lo32 = __builtin_amdgcn_readfirstlane((unsigned)un), hi32 = __builtin_amdgcn_readfirstlane((unsigned)(un >> 32));
        un = ((unsigned long long)hi32 << 32) | lo32;
        if (qb < 63) un &= ((1ull << (qb + 1)) - 1ull);
    }
    {
        float m_run = NSA_NEG, l_run = 0.f;
        unsigned long long rem = un;
        auto nextb = [&]() { if (rem == 0ull) return -1; const int x = 63 - (int)__builtin_clzll(rem); rem &= ~(1ull << x); return x; };
        u32x4 kr2, vr2;
        int b = nextb(), b1 = nextb();
        { TileSrc ts{p.KSb + (ng * SEQ + (long)b * 64) * 64, p.VSb + (ng * SEQ + (long)b * 64) * 64, 0}; tile_issue(ts, tid, kr, vr); tile_commit<false>(lds, 0, tid, kr, vr); }
        if (b1 >= 0) { TileSrc ts{p.KSb + (ng * SEQ + (long)b1 * 64) * 64, p.VSb + (ng * SEQ + (long)b1 * 64) * 64, 0}; tile_issue(ts, tid, kr, vr); }
        __syncthreads();
        int buf = 0;
        for (;;) {
            const int b2 = (b1 >= 0) ? nextb() : -1;
            if (b2 >= 0) { TileSrc tn{p.KSb + (ng * SEQ + (long)b2 * 64) * 64, p.VSb + (ng * SEQ + (long)b2 * 64) * 64, 0}; tile_issue(tn, tid, kr2, vr2); }
            const int kb0 = b * 64;
            const bool selb = (mymask >> b) & 1ull;
            const bf16x8 kext[2] = {bias_kext(b - qb, ql, h), bias_kext(b - qb, 32 + ql, h)};
            tile_step_g<4, 2, KROW, KROW, true>(lds + L_K + buf * TILE_B, lds + L_V + buf * TILE_B, qf, o, st, m_run, l_run, LOG2E, kext, qext, -1000,
                                                selb ? (tq - kb0 - 4 * h) : -2000, ql, h);
            if (b1 >= 0) tile_commit<false>(lds, buf ^ 1, tid, kr, vr);
            __syncthreads();
            if (b1 < 0) break;
            b = b1; b1 = b2; kr = kr2; vr = vr2; buf ^= 1;
        }
        const float ltot = xhalf_sum(l_run);
        const float inv = ltot > 0.f ? 1.f / ltot : 0.f;
#pragma unroll
        for (int db = 0; db < 2; ++db)
#pragma unroll
            for (int i = 0; i < 16; ++i) { outacc[db][i] += gs * inv * o[db][i]; o[db][i] = 0.f; }
    }
    {
        float m_run = NSA_NEG, l_run = 0.f;
        int b = qb; const int blo = (qb - WINDOW / 64) < 0 ? 0 : (qb - WINDOW / 64);
        u32x4 kr2, vr2;
        { TileSrc ts{p.KWb + (ng * SEQ + (long)b * 64) * 64, p.VWb + (ng * SEQ + (long)b * 64) * 64, 0}; tile_issue(ts, tid, kr, vr); tile_commit<false>(lds, 0, tid, kr, vr); }
        if (b - 1 >= blo) { TileSrc ts{p.KWb + (ng * SEQ + (long)(b - 1) * 64) * 64, p.VWb + (ng * SEQ + (long)(b - 1) * 64) * 64, 0}; tile_issue(ts, tid, kr, vr); }
        __syncthreads();
        int buf = 0;
        for (;;) {
            const bool more = b - 1 >= blo;
            if (b - 2 >= blo) { TileSrc tn{p.KWb + (ng * SEQ + (long)(b - 2) * 64) * 64, p.VWb + (ng * SEQ + (long)(b - 2) * 64) * 64, 0}; tile_issue(tn, tid, kr2, vr2); }
            const int kb0 = b * 64;
            const bf16x8 kext[2] = {bias_kext(b - qb, ql, h), bias_kext(b - qb, 32 + ql, h)};
            tile_step_g<4, 2, KROW, KROW, true>(lds + L_K + buf * TILE_B, lds + L_V + buf * TILE_B, qf, o, st, m_run, l_run, LOG2E, kext, qext,
                                                tq - (WINDOW - 1) - kb0 - 4 * h, tq - kb0 - 4 * h, ql, h);
            if (more) tile_commit<false>(lds, buf ^ 1, tid, kr, vr);
            __syncthreads();
            if (!more) break;
            --b; kr = kr2; vr = vr2; buf ^= 1;
        }
        const float ltot = xhalf_sum(l_run);
        const float inv = ltot > 0.f ? 1.f / ltot : 0.f;
#pragma unroll
        for (int db = 0; db < 2; ++db)
#pragma unroll
            for (int i = 0; i < 16; ++i) outacc[db][i] += gw * inv * o[db][i];
    }
#pragma unroll
    for (int db = 0; db < 2; ++db)
#pragma unroll
        for (int g4 = 0; g4 < 4; ++g4) {
            u32x2 v; v[0] = pg8::cvt_pk_bf16(outacc[db][4 * g4 + 0], outacc[db][4 * g4 + 1]); v[1] = pg8::cvt_pk_bf16(outacc[db][4 * g4 + 2], outacc[db][4 * g4 + 3]);
            *(u32x2*)(p.MIXb + m * MIX_W + head * 64 + 32 * db + 8 * g4 + 4 * h) = v;
        }
}
__device__ __forceinline__ void prompt_phase(const Params& p, LAS unsigned char* lds) {
    const int nu = BATCH * 2 * NBP;
    for (int u = blockIdx.x; u < nu; u += gridDim.x) {
        const int per = BATCH * 2;
        const int rnd = u / 256, idx = u % 256;
        int qb, ngi;
        if (NBP == 64 && per == 16) {
            const int a = idx / 16; ngi = idx % 16;
            qb = rnd == 0 ? 63 - a : rnd == 1 ? 32 + a : rnd == 2 ? 31 - a : a;
        } else { qb = NBP - 1 - u / per; ngi = u % per; }
        prompt_unit(p, lds, ngi >> 1, (ngi & 1) ^ (rnd & 1), qb);
    }
}

constexpr int XK_ROW = 272, XK_TILE = 64 * XK_ROW, XV_TILE = 128 * KROW, XL_K = 0, XL_V = 2 * XK_TILE;
__device__ __forceinline__ void x_issue(const unsigned short* kb, const unsigned short* vb, int tid, u32x4 (&kr)[2], u32x4 (&vr)[2]) {
#pragma unroll
    for (int q = 0; q < 2; ++q) { const int idx = tid + 512 * q; kr[q] = *(const u32x4*)(kb + idx * 8); vr[q] = *(const u32x4*)(vb + idx * 8); }
}
__device__ __forceinline__ void x_commit(LAS unsigned char* lds, int buf, int tid, const u32x4 (&kr)[2], const u32x4 (&vr)[2]) {
#pragma unroll
    for (int q = 0; q < 2; ++q) {
        const int idx = tid + 512 * q, row = idx >> 4, seg = idx & 15;
        *(LAS u32x4*)(lds + XL_K + buf * XK_TILE + row * XK_ROW + seg * 16) = kr[q];
        LAS unsigned char* vt = lds + XL_V + buf * XV_TILE + (seg * 8) * KROW + row * 2;
#pragma unroll
        for (int e = 0; e < 8; ++e) *(LAS unsigned short*)(vt + e * KROW) = (unsigned short)(vr[q][e >> 1] >> (16 * (e & 1)));
    }
}
__device__ __forceinline__ void xattn_unit(const Params& p, LAS unsigned char* lds, const unsigned short* kb, const unsigned short* vb, long m0, int nv, int head) {
    const int tid = opaque_tid(), lane = tid & 63, w = __builtin_amdgcn_readfirstlane(tid >> 6), ql = lane & 31, h = lane >> 5;
    const int rowi = 32 * w + ql; const bool valid = rowi < nv;
    const long m = m0 + (valid ? rowi : 0);
    bf16x8 qf[8];
    {
        const unsigned short* qrow = p.XQb + m * XW + head * 128 + 8 * h;
        const float* gq = p.in[I_XQ_G] + 8 * h;
        float ss = 0.f;
#pragma unroll
        for (int s = 0; s < 8; ++s)
#pragma unroll
            for (int j = 0; j < 8; ++j) { const float v = bf2f(qrow[16 * s + j]); ss += v * v; }
        ss += __shfl_xor(ss, 32);
        const float r = valid ? (1.f / sqrtf(ss * (1.f / 128.f) + RMS_EPS)) * (LOG2E * 0.08838834764831845f) : 0.f;
#pragma unroll
        for (int s = 0; s < 8; ++s)
#pragma unroll
            for (int j = 0; j < 8; ++j) qf[s][j] = (short)f2bf(bf2f(qrow[16 * s + j]) * r * gq[16 * s + j]);
    }
    f32x16 o[4], st[2];
#pragma unroll
    for (int db = 0; db < 4; ++db)
#pragma unroll
        for (int i = 0; i < 16; ++i) o[db][i] = 0.f;
    u32x4 kr[2], vr[2];
    x_issue(kb, vb, tid, kr, vr); x_commit(lds, 0, tid, kr, vr);
    __syncthreads();
    float m_run = NSA_NEG, l_run = 0.f;
    const bf16x8 kext0[2] = {{0, 0, 0, 0, 0, 0, 0, 0}, {0, 0, 0, 0, 0, 0, 0, 0}};
    constexpr int NT = N_MEM / 64;
    for (int t = 0; t < NT; ++t) {
        const bool more = t + 1 < NT;
        if (more) x_issue(kb + (long)(t + 1) * 64 * 128, vb + (long)(t + 1) * 64 * 128, tid, kr, vr);
        tile_step_g<8, 4, XK_ROW, KROW, false>(lds + XL_K + (t & 1) * XK_TILE, lds + XL_V + (t & 1) * XV_TILE, qf, o, st, m_run, l_run, 1.f, kext0, kext0[0], -1000, 1000, ql, h);
        if (more) x_commit(lds, (t + 1) & 1, tid, kr, vr);
        __syncthreads();
    }
    const float ltot = xhalf_sum(l_run);
    const float inv = 1.f / ltot;
    if (valid) {
#pragma unroll
        for (int db = 0; db < 4; ++db)
#pragma unroll
            for (int g4 = 0; g4 < 4; ++g4) {
                u32x2 v; v[0] = pg8::cvt_pk_bf16(o[db][4 * g4 + 0] * inv, o[db][4 * g4 + 1] * inv); v[1] = pg8::cvt_pk_bf16(o[db][4 * g4 + 2] * inv, o[db][4 * g4 + 3] * inv);
                *(u32x2*)(p.OXb + m * XW + head * 128 + 32 * db + 8 * g4 + 4 * h) = v;
            }
    }
}
__device__ __forceinline__ void xattn_phase(const Params& p, LAS unsigned char* lds) {
    constexpr int QT = SEQ / 256, NPU = BATCH * 4 * QT, NSU = DEC_BATCH * 4;
    for (int u = blockIdx.x; u < NPU + NSU; u += gridDim.x) {
        if (u < NPU) {
            const int qt = u % QT, nh = u / QT, hd = nh % 4, n = nh / 4;
            xattn_unit(p, lds, p.XKb + (long)nh * N_MEM * 128, p.XVb + (long)nh * N_MEM * 128, (long)n * SEQ + qt * 256, 256, hd);
        } else {
            const int nh = u - NPU, hd = nh % 4, n = nh / 4;
            xattn_unit(p, lds, p.XKSb + (long)nh * N_MEM * 128, p.XVSb + (long)nh * N_MEM * 128, (long)MP + (long)n * DEC_SEQ, DEC_SEQ, hd);
        }
    }
}

constexpr int SW_BYTES = 16384, S_SH = 8 * SW_BYTES, S_ML = S_SH, S_OACC = S_ML + 3 * 2048, S_IMP = S_OACC + 8192, S_MASK = S_IMP + 8 * 320 * 4, S_END = S_MASK + 8 * 8 * 8;
__device__ __forceinline__ void stage_f32(LAS unsigned char* wk, LAS unsigned char* wv, const float* kp, const float* vp, long stride, int nvalid, int lane) {
#pragma unroll 4
    for (int it = 0; it < 16; ++it) {
        const int idx = it * 64 + lane, row = idx >> 4, q = idx & 15;
        pg8::f32x4 kv = {0.f, 0.f, 0.f, 0.f}, vv = {0.f, 0.f, 0.f, 0.f};
        if (row < nvalid) { kv = *(const pg8::f32x4*)(kp + (long)row * stride + q * 4); vv = *(const pg8::f32x4*)(vp + (long)row * stride + q * 4); }
        u32x2 pk; pk[0] = pg8::cvt_pk_bf16(kv[0], kv[1]); pk[1] = pg8::cvt_pk_bf16(kv[2], kv[3]);
        *(LAS u32x2*)(wk + row * 128 + q * 8) = pk;
#pragma unroll
        for (int e = 0; e < 4; ++e) *(LAS unsigned short*)(wv + (q * 4 + e) * 128 + row * 2) = f2bf(vv[e]);
    }
    asm volatile("s_waitcnt vmcnt(0) lgkmcnt(0)" ::: "memory");
}
__device__ __forceinline__ float combine_branch(LAS unsigned char* lds, int slot, int w, int ql, int h, float m_run, float l_run, const f32x16 (&o)[2], float gate) {
    LAS float* ml = (LAS float*)(lds + S_ML + slot * 2048);
    const float ltot = xhalf_sum(l_run);
    if (h == 0) { ml[(w * 32 + ql) * 2] = m_run; ml[(w * 32 + ql) * 2 + 1] = ltot; }
    __syncthreads();
    float M = NSA_NEG;
#pragma unroll
    for (int k = 0; k < 8; ++k) M = fmaxf(M, ml[(k * 32 + ql) * 2]);
    const float Ms = (M == NSA_NEG) ? 0.f : M;
    float L = 0.f;
#pragma unroll
    for (int k = 0; k < 8; ++k) L += ml[(k * 32 + ql) * 2 + 1] * __builtin_amdgcn_exp2f((ml[(k * 32 + ql) * 2] - Ms) * LOG2E);
    const float f = (L > 0.f) ? __builtin_amdgcn_exp2f((m_run - Ms) * LOG2E) / L : 0.f;
    const float gf = gate * f;
    if (gf != 0.f) {
        LAS float* oa = (LAS float*)(lds + S_OACC) + ql * 64;
#pragma unroll
        for (int db = 0; db < 2; ++db)
#pragma unroll
            for (int i = 0; i < 16; ++i)
                (void)__hip_atomic_fetch_add(oa + 32 * db + (i & 3) + 8 * (i >> 2) + 4 * h, gf * o[db][i], __ATOMIC_RELAXED, __HIP_MEMORY_SCOPE_WORKGROUP);
    }
    return f;
}
__device__ __forceinline__ void sample_unit(const Params& p, LAS unsigned char* lds, int n, int g) {
    static_assert(NBS % 64 == 0 && NBS / 64 <= 8 && WBUF == 512 && DEC_SEQ == 8 && NBS + 1 <= 320, "sample NSA unit geometry");
    const int tid = opaque_tid(), lane = tid & 63, w = __builtin_amdgcn_readfirstlane(tid >> 6), ql = lane & 31, h = lane >> 5;
    const int tloc = ql >> 2, r = ql & 3, head = g * 4 + r;
    const int tq = PAST_LEN + tloc, t0 = PAST_LEN;
    const long m = (long)MP + (long)n * DEC_SEQ + tloc;
    const bf16x8 qext = bias_qext(exp2f(-(float)(head + 1)), h);
    LAS unsigned char* wk = lds + w * SW_BYTES; LAS unsigned char* wv = wk + 8192;
    bf16x8 qf[4];
#pragma unroll
    for (int s = 0; s < 4; ++s) qf[s] = *(const bf16x8*)(p.QNb + m * 512 + head * 64 + 16 * s + 8 * h);
    const float gc = p.GT[m * 24 + head * 3 + 0], gs = p.GT[m * 24 + head * 3 + 1], gw = p.GT[m * 24 + head * 3 + 2];
    for (int i = tid; i < 2048; i += 512) ((LAS float*)(lds + S_OACC))[i] = 0.f;
    f32x16 o[2], st[2];
    const int* pt = (const int*)p.in[I_PAGE_TABLE] + n * NPAGES;
    const float* newrow = p.KVW + ((long)MP + (long)n * DEC_SEQ) * 768;
    {
#pragma unroll
        for (int db = 0; db < 2; ++db)
#pragma unroll
            for (int i = 0; i < 16; ++i) o[db][i] = 0.f;
        float m_run = NSA_NEG, l_run = 0.f;
        const bool mine = w < NBS / 64;
        if (mine) {
            const float* kp = p.KCS + (((long)n * NBS + w * 64) * 2 + g) * 64; const float* vp = p.VCS + (((long)n * NBS + w * 64) * 2 + g) * 64;
            stage_f32(wk, wv, kp, vp, 128, 64, lane);
            const bf16x8 kext[2] = {bias_kext(w * 64 + ql - NBS, 63, h), bias_kext(w * 64 + 32 + ql - NBS, 63, h)};
            tile_step_g<4, 2, 128, 128, true>(wk, wv, qf, o, st, m_run, l_run, LOG2E, kext, qext, -1000, 1000, ql, h);
        }
        const float f = combine_branch(lds, 0, w, ql, h, m_run, l_run, o, gc);
        if (mine) {
            LAS float* imp = (LAS float*)(lds + S_IMP) + tloc * 320;
#pragma unroll
            for (int sub = 0; sub < 2; ++sub)
#pragma unroll
                for (int i = 0; i < 16; ++i) {
                    float v = st[sub][i] * f;
                    v += __shfl_xor(v, 1); v += __shfl_xor(v, 2);
                    if (r == 0) imp[w * 64 + 32 * sub + (i & 3) + 8 * (i >> 2) + 4 * h] = v;
                }
        }
    }
    __syncthreads();
    {
        LAS float* sc = (LAS float*)(lds + S_IMP) + w * 320;
        float scq[5]; int rk[5];
#pragma unroll
        for (int q = 0; q < 5; ++q) {
            const int b = lane + 64 * q;
            const bool forced = (b == 0) || (b == NBS) || (b == NBS - 1);
            float v = -3e38f;
            if (b <= NBS) v = forced ? 1e9f : sc[b];
            scq[q] = v; rk[q] = 0;
        }
        asm volatile("s_waitcnt lgkmcnt(0)" ::: "memory");
#pragma unroll
        for (int q = 0; q < 5; ++q) sc[lane + 64 * q] = scq[q];
        asm volatile("s_waitcnt lgkmcnt(0)" ::: "memory");
        for (int j = 0; j <= NBS; ++j) {
            const float sj = sc[j];
#pragma unroll
            for (int q = 0; q < 5; ++q) rk[q] += (sj > scq[q] || (sj == scq[q] && j < lane + 64 * q)) ? 1 : 0;
        }
#pragma unroll
        for (int q = 0; q < 5; ++q) {
            const unsigned long long mk = __ballot(rk[q] < N_SEL && (lane + 64 * q) <= NBS);
            if (lane == 0) *(LAS unsigned long long*)(lds + S_MASK + (w * 8 + q) * 8) = mk;
        }
    }
    __syncthreads();
    {
#pragma unroll
        for (int db = 0; db < 2; ++db)
#pragma unroll
            for (int i = 0; i < 16; ++i) o[db][i] = 0.f;
        float m_run = NSA_NEG, l_run = 0.f;
        int k = 0;
        for (int q = 0; q < 5; ++q) {
            unsigned long long un = 0ull;
#pragma unroll
            for (int t = 0; t < 8; ++t) un |= *(const LAS unsigned long long*)(lds + S_MASK + (t * 8 + q) * 8);
            const unsigned lo32 = __builtin_amdgcn_readfirstlane((unsigned)un), hi32 = __builtin_amdgcn_readfirstlane((unsigned)(un >> 32));
            un = ((unsigned long long)hi32 << 32) | lo32;
            const unsigned long long mine_mask = *(const LAS unsigned long long*)(lds + S_MASK + (tloc * 8 + q) * 8);
            while (un) {
                const int bit = (int)__builtin_ctzll(un); un &= un - 1ull;
                const int b = 64 * q + bit;
                if ((k++ & 7) != w) continue;
                const float *kp, *vp; long stride; int nvalid;
                if (b < NBS) {
                    const long phys = pt[b / BPP];
                    kp = p.in[I_CACHE_KV] + (((phys * PAGE_SIZE + (long)(b % BPP) * 64) * 4 + 2) * 2 + g) * 64; vp = kp + 128; stride = 512; nvalid = 64;
                } else { kp = newrow + 256 + g * 64; vp = newrow + 384 + g * 64; stride = 768; nvalid = DEC_SEQ; }
                stage_f32(wk, wv, kp, vp, stride, nvalid, lane);
                const int kb0 = b * 64;
                const bool selb = (mine_mask >> bit) & 1ull;
                const bf16x8 kext[2] = {bias_kext(b - NBS, ql, h), bias_kext(b - NBS, 32 + ql, h)};
                tile_step_g<4, 2, 128, 128, true>(wk, wv, qf, o, st, m_run, l_run, LOG2E, kext, qext, -1000, selb ? (tq - kb0 - 4 * h) : -2000, ql, h);
            }
        }
        (void)combine_branch(lds, 1, w, ql, h, m_run, l_run, o, gs);
    }
    {
#pragma unroll
        for (int db = 0; db < 2; ++db)
#pragma unroll
            for (int i = 0; i < 16; ++i) o[db][i] = 0.f;
        float m_run = NSA_NEG, l_run = 0.f;
        for (int t = w; t < 9; t += 8) {
            const float *kp, *vp; long stride; int nvalid, kb0;
            if (t < 8) { kp = p.in[I_CACHE_WIN] + ((long)n * WBUF + 64 * t) * 256 + g * 64; vp = kp + 128; stride = 256; nvalid = 64; kb0 = PAST_LEN - WBUF + 64 * t; }
            else { kp = newrow + 512 + g * 64; vp = newrow + 640 + g * 64; stride = 768; nvalid = DEC_SEQ; kb0 = PAST_LEN; }
            stage_f32(wk, wv, kp, vp, stride, nvalid, lane);
            const bf16x8 kext[2] = {bias_kext((kb0 - t0) / 64, ql, h), bias_kext((kb0 - t0) / 64, 32 + ql, h)};
            tile_step_g<4, 2, 128, 128, true>(wk, wv, qf, o, st, m_run, l_run, LOG2E, kext, qext, tq - (WINDOW - 1) - kb0 - 4 * h, tq - kb0 - 4 * h, ql, h);
        }
        (void)combine_branch(lds, 2, w, ql, h, m_run, l_run, o, gw);
    }
    __syncthreads();
    for (int i = tid; i < 2048; i += 512) {
        const int row = i >> 6, d = i & 63, tl = row >> 2, rr = row & 3;
        const float v = ((const LAS float*)(lds + S_OACC))[i];
        const long mm = (long)MP + (long)n * DEC_SEQ + tl;
        p.MIXb[mm * MIX_W + (g * 4 + rr) * 64 + d] = f2bf(v);
    }
    __syncthreads();
}
static_assert(S_END <= 159744 - 256, "sample NSA LDS map");
__device__ __forceinline__ void sample_phase(const Params& p, LAS unsigned char* lds) {
    for (int u = blockIdx.x; u < DEC_BATCH * 2; u += gridDim.x) sample_unit(p, lds, u >> 1, u & 1);
}
}

namespace ew { __device__ __forceinline__ float wsum(float v); }
namespace rw {
typedef float f32x2 __attribute__((ext_vector_type(2)));
typedef float f32x4 __attribute__((ext_vector_type(4)));
constexpr int SB = 4, STEP_B = 6 * 64 * 4, SUB_B = SB * STEP_B, WAVE_B = 2 * SUB_B;
__device__ __forceinline__ void wave_sync() { asm volatile("s_waitcnt vmcnt(0) lgkmcnt(0)" ::: "memory"); }
__device__ __forceinline__ void lds_sync() { asm volatile("s_waitcnt lgkmcnt(0)" ::: "memory"); }
typedef unsigned u32x4_ __attribute__((ext_vector_type(4)));
struct StageRegs { f32x4 fr[3]; u32x4_ hr[2]; };
__device__ __forceinline__ void stage_issue(const Params& p, long m, int h, int lane, StageRegs& rg, bool skip_v = false) {
    const float* fb = p.RWB + m * 1536 + h * 64;
    const unsigned short* hb_ = p.RWH + m * 1536 + h * 64;
#pragma unroll
    for (int q = 0; q < 3; ++q) {
        const int idx = q * 64 + lane, seg = idx >> 4, f = idx & 15, st = seg / 3, vv = seg % 3;
        const int off = st * 1536 + vv * 512 + f * 4;
        rg.fr[q] = *(const f32x4*)(fb + off);
    }
#pragma unroll
    for (int q = 0; q < 2; ++q) {
        const int idx = q * 64 + lane, seg = idx >> 3, f8 = idx & 7, st = seg / 3, vv = seg % 3;
        const int off = st * 1536 + vv * 512 + f8 * 8;
        if (idx < 96) { if (skip_v && vv != 0) rg.hr[q] = (u32x4_){0u, 0u, 0u, 0u}; else rg.hr[q] = *(const u32x4_*)(hb_ + off); }
    }
}
__device__ __forceinline__ void stage_commit(LAS unsigned char* buf, int lane, const StageRegs& rg) {
#pragma unroll
    for (int q = 0; q < 3; ++q) {
        const int idx = q * 64 + lane, seg = idx >> 4, f = idx & 15, st = seg / 3, vv = seg % 3;
        *(LAS f32x4*)(buf + (st * 6 + 3 + vv) * 256 + f * 16) = rg.fr[q];
    }
#pragma unroll
    for (int q = 0; q < 2; ++q) {
        const int idx = q * 64 + lane, seg = idx >> 3, f8 = idx & 7, st = seg / 3, vv = seg % 3;
        if (idx < 96) {
            const u32x4_ r = rg.hr[q];
            LAS unsigned char* d = buf + (st * 6 + vv) * 256 + f8 * 32;
            *(LAS f32x4*)(d) = (f32x4){__uint_as_float(r[0] << 16), __uint_as_float(r[0] & 0xffff0000u), __uint_as_float(r[1] << 16), __uint_as_float(r[1] & 0xffff0000u)};
            *(LAS f32x4*)(d + 16) = (f32x4){__uint_as_float(r[2] << 16), __uint_as_float(r[2] & 0xffff0000u), __uint_as_float(r[3] << 16), __uint_as_float(r[3] & 0xffff0000u)};
        }
    }
}
template <int MODE>
__device__ __forceinline__ float step(const LAS unsigned char* sb, f32x2 (&S)[32], int lane, float vmul) {
    f32x2 a0 = {0.f, 0.f}, a1 = {0.f, 0.f};
#pragma unroll
    for (int jj = 0; jj < 16; ++jj) {
        const f32x4 k4 = *(const LAS f32x4*)(sb + 3 * 256 + jj * 16);
        a0 += S[2 * jj] * (f32x2){k4[0], k4[1]}; a1 += S[2 * jj + 1] * (f32x2){k4[2], k4[3]};
    }
    const float sa = -((a0[0] + a0[1]) + (a1[0] + a1[1]));
    const f32x2 sa2 = {sa, sa};
    float v = 0.f;
    if (MODE != 1) v = *(const LAS float*)(sb + 2 * 256 + lane * 4) * vmul;
    const f32x2 v2 = {v, v};
    f32x2 o0 = {0.f, 0.f}, o1 = {0.f, 0.f};
#pragma unroll
    for (int jj = 0; jj < 16; ++jj) {
        const f32x4 d4 = *(const LAS f32x4*)(sb + 5 * 256 + jj * 16), b4 = *(const LAS f32x4*)(sb + 4 * 256 + jj * 16);
        f32x2 t0 = sa2 * (f32x2){b4[0], b4[1]}, t1 = sa2 * (f32x2){b4[2], b4[3]};
        if (MODE != 1) {
            const f32x4 k4 = *(const LAS f32x4*)(sb + 1 * 256 + jj * 16);
            t0 += v2 * (f32x2){k4[0], k4[1]}; t1 += v2 * (f32x2){k4[2], k4[3]};
        }
        S[2 * jj] = S[2 * jj] * (f32x2){d4[0], d4[1]} + t0; S[2 * jj + 1] = S[2 * jj + 1] * (f32x2){d4[2], d4[3]} + t1;
        if (MODE == 2) {
            const f32x4 r4 = *(const LAS f32x4*)(sb + 0 * 256 + jj * 16);
            o0 += S[2 * jj] * (f32x2){r4[0], r4[1]}; o1 += S[2 * jj + 1] * (f32x2){r4[2], r4[3]};
        }
    }
    return (o0[0] + o0[1]) + (o1[0] + o1[1]);
}
template <int MODE>
__device__ __forceinline__ void run(const Params& p, LAS unsigned char* wl, long m0, int h, int T, f32x2 (&S)[32], int lane, float vmul, float* odst) {
    StageRegs rg;
    stage_issue(p, m0, h, lane, rg); stage_commit(wl, lane, rg); wave_sync();
    const int nsb = T / SB;
    for (int sbi = 0; sbi < nsb; ++sbi) {
        const bool more = sbi + 1 < nsb;
        if (more) stage_issue(p, m0 + (long)(sbi + 1) * SB, h, lane, rg);
        const LAS unsigned char* cur = wl + (sbi & 1) * SUB_B;
#pragma unroll 1
        for (int st = 0; st < SB; ++st) {
            __builtin_amdgcn_sched_barrier(0);
            const float o = step<MODE>(cur + st * STEP_B, S, lane, vmul);
            if (MODE == 2) odst[(m0 + (long)sbi * SB + st) * 512 + h * 64 + lane] = o;
        }
        if (more) stage_commit(wl + ((sbi + 1) & 1) * SUB_B, lane, rg);
        wave_sync();
    }
}
__device__ __forceinline__ void load_rows(const float* src, f32x2 (&S)[32]) {
#pragma unroll
    for (int q = 0; q < 16; ++q) { const f32x4 v = *(const f32x4*)(src + q * 4); S[2 * q] = (f32x2){v[0], v[1]}; S[2 * q + 1] = (f32x2){v[2], v[3]}; }
}
__device__ __forceinline__ void store_rows(float* dst, const f32x2 (&S)[32]) {
#pragma unroll
    for (int q = 0; q < 16; ++q) *(f32x4*)(dst + q * 4) = (f32x4){S[2 * q][0], S[2 * q][1], S[2 * q + 1][0], S[2 * q + 1][1]};
}
typedef float f32x16 __attribute__((ext_vector_type(16)));
#define RW_MFMA(a, b, c) __builtin_amdgcn_mfma_f32_32x32x2f32((a), (b), (c), 0, 0, 0)
#define RW_PAIR(v, q) ((f32x2){(v)[2 * (q)], (v)[2 * (q) + 1]})
template <int NCT>
__device__ __forceinline__ void step_t(const LAS unsigned char* sb, f32x16 (&T)[2][NCT], int lane, float (&outv)[NCT], float vmul) {
    const int h = lane >> 5, l31 = lane & 31;
    const LAS unsigned char* hb = sb + 16 * h;
    f32x4 kv[2][4], dv[2][4], rv[2][4]; float aop[2], vv[NCT];
#pragma unroll
    for (int rt = 0; rt < 2; ++rt)
#pragma unroll
        for (int gq = 0; gq < 4; ++gq) kv[rt][gq] = *(const LAS f32x4*)(hb + 3 * 256 + (32 * rt + 8 * gq) * 4);
#pragma unroll
    for (int ct = 0; ct < NCT; ++ct) vv[ct] = *(const LAS float*)(sb + 2 * 256 + (32 * (ct & 1) + l31) * 4);
#pragma unroll
    for (int rt = 0; rt < 2; ++rt) aop[rt] = *(const LAS float*)(sb + (h ? 1 * 256 : 4 * 256) + (32 * rt + l31) * 4);
    if (NCT <= 2) {
#pragma unroll
        for (int rt = 0; rt < 2; ++rt)
#pragma unroll
            for (int gq = 0; gq < 4; ++gq) { dv[rt][gq] = *(const LAS f32x4*)(hb + 5 * 256 + (32 * rt + 8 * gq) * 4); rv[rt][gq] = *(const LAS f32x4*)(hb + 0 * 256 + (32 * rt + 8 * gq) * 4); }
    }
    __builtin_amdgcn_sched_barrier(0);
    f32x2 pa[NCT], pb_[NCT];
#pragma unroll
    for (int ct = 0; ct < NCT; ++ct) { pa[ct] = (f32x2){0.f, 0.f}; pb_[ct] = (f32x2){0.f, 0.f}; }
#pragma unroll
    for (int rt = 0; rt < 2; ++rt)
#pragma unroll
        for (int gq = 0; gq < 4; ++gq) {
            const f32x2 klo = {kv[rt][gq][0], kv[rt][gq][1]}, khi = {kv[rt][gq][2], kv[rt][gq][3]};
#pragma unroll
            for (int ct = 0; ct < NCT; ++ct) { pa[ct] += RW_PAIR(T[rt][ct], 2 * gq) * klo; pb_[ct] += RW_PAIR(T[rt][ct], 2 * gq + 1) * khi; }
        }
    float bop[NCT];
#pragma unroll
    for (int ct = 0; ct < NCT; ++ct) {
        const float sa = -xhalf_sum((pa[ct][0] + pa[ct][1]) + (pb_[ct][0] + pb_[ct][1]));
        bop[ct] = h ? (ct < 2 ? vv[ct] * vmul : 0.f) : sa;
    }
    if (NCT > 2) {
#pragma unroll
        for (int rt = 0; rt < 2; ++rt)
#pragma unroll
            for (int gq = 0; gq < 4; ++gq) dv[rt][gq] = *(const LAS f32x4*)(hb + 5 * 256 + (32 * rt + 8 * gq) * 4);
        __builtin_amdgcn_sched_barrier(0);
    }
#pragma unroll
    for (int rt = 0; rt < 2; ++rt)
#pragma unroll
        for (int gq = 0; gq < 4; ++gq) {
            const f32x2 dlo = {dv[rt][gq][0], dv[rt][gq][1]}, dhi = {dv[rt][gq][2], dv[rt][gq][3]};
#pragma unroll
            for (int ct = 0; ct < NCT; ++ct) {
                const f32x2 x = RW_PAIR(T[rt][ct], 2 * gq) * dlo, y = RW_PAIR(T[rt][ct], 2 * gq + 1) * dhi;
                T[rt][ct][4 * gq] = x[0]; T[rt][ct][4 * gq + 1] = x[1]; T[rt][ct][4 * gq + 2] = y[0]; T[rt][ct][4 * gq + 3] = y[1];
            }
        }
    if (NCT > 2) {
#pragma unroll
        for (int rt = 0; rt < 2; ++rt)
#pragma unroll
            for (int gq = 0; gq < 4; ++gq) rv[rt][gq] = *(const LAS f32x4*)(hb + 0 * 256 + (32 * rt + 8 * gq) * 4);
    }
#pragma unroll
    for (int rt = 0; rt < 2; ++rt)
#pragma unroll
        for (int ct = 0; ct < NCT; ++ct) T[rt][ct] = RW_MFMA(aop[rt], bop[ct], T[rt][ct]);
#pragma unroll
    for (int ct = 0; ct < NCT; ++ct) { pa[ct] = (f32x2){0.f, 0.f}; pb_[ct] = (f32x2){0.f, 0.f}; }
#pragma unroll
    for (int rt = 0; rt < 2; ++rt)
#pragma unroll
        for (int gq = 0; gq < 4; ++gq) {
            const f32x2 rlo = {rv[rt][gq][0], rv[rt][gq][1]}, rhi = {rv[rt][gq][2], rv[rt][gq][3]};
#pragma unroll
            for (int ct = 0; ct < NCT; ++ct) { pa[ct] += RW_PAIR(T[rt][ct], 2 * gq) * rlo; pb_[ct] += RW_PAIR(T[rt][ct], 2 * gq + 1) * rhi; }
        }
#pragma unroll
    for (int ct = 0; ct < NCT; ++ct) outv[ct] = xhalf_sum((pa[ct][0] + pa[ct][1]) + (pb_[ct][0] + pb_[ct][1]));
}
__device__ __forceinline__ void pass1(const Params& p, LAS unsigned char* lds) {
    const int tid = opaque_tid(), lane = tid & 63, w = __builtin_amdgcn_readfirstlane(tid >> 6);
    LAS unsigned char* wl = lds + w * WAVE_B;
    const int npr = BATCH * 8 * NCH * 2, ntask = npr + DEC_BATCH * 8;
    for (int task = w * (int)gridDim.x + (int)blockIdx.x; task < ntask; task += gridDim.x * 8) {
        StageRegs rg;
        int lq = lane; asm volatile("" : "+v"(lq));
        const int h = lq >> 5, l31 = lq & 31;
        if (task < npr) {
            const int kind = task & 1, ct_ = task >> 1, c = ct_ % NCH, sh = ct_ / NCH, hd = sh % 8, sq = sh / 8;
            const long m0 = (long)sq * SEQ + (long)c * RC;
            f32x16 T[2][2];
#pragma unroll
            for (int rt = 0; rt < 2; ++rt)
#pragma unroll
                for (int ct = 0; ct < 2; ++ct)
#pragma unroll
                    for (int rg_ = 0; rg_ < 16; ++rg_)
                        T[rt][ct][rg_] = (kind == 1 && (32 * rt + (rg_ & 3) + 8 * (rg_ >> 2) + 4 * h) == (32 * ct + l31)) ? 1.f : 0.f;
            const float vmul = kind == 0 ? 1.f : 0.f;
            float* odst = kind == 0 ? p.RO : p.RHO;
            stage_issue(p, m0, hd, lane, rg, kind == 1); stage_commit(wl, lane, rg); lds_sync();
            constexpr int nsb = RC / SB;
            for (int sbi = 0; sbi < nsb; ++sbi) {
                const bool more = sbi + 1 < nsb;
                if (more) stage_issue(p, m0 + (long)(sbi + 1) * SB, hd, lane, rg, kind == 1);
                const LAS unsigned char* cur = wl + (sbi & 1) * SUB_B;
#pragma unroll 1
                for (int st = 0; st < SB; ++st) {
                    float ov[2];
                    step_t<2>(cur + st * STEP_B, T, lane, ov, vmul);
                    odst[(m0 + (long)sbi * SB + st) * 512 + hd * 64 + lane] = h ? ov[1] : ov[0];
                }
                if (more) stage_commit(wl + ((sbi + 1) & 1) * SUB_B, lane, rg);
                lds_sync();
            }
            float* lt = (kind == 0 ? p.RLC : p.RPC) + (long)ct_ * 4096 + (4 * h) * 64 + l31;
#pragma unroll
            for (int rt = 0; rt < 2; ++rt)
#pragma unroll
                for (int cc = 0; cc < 2; ++cc)
#pragma unroll
                    for (int rg_ = 0; rg_ < 16; ++rg_) lt[(32 * rt + (rg_ & 3) + 8 * (rg_ >> 2)) * 64 + 32 * cc] = T[rt][cc][rg_];
        } else {
            const int sh = task - npr, hd = sh % 8, n = sh / 8;
            const long m0 = (long)MP + (long)n * DEC_SEQ;
            const float* s0 = p.in[I_STATE_S] + (long)sh * 4096;
            f32x16 T[2][2];
#pragma unroll
            for (int rt = 0; rt < 2; ++rt)
#pragma unroll
                for (int ct = 0; ct < 2; ++ct)
#pragma unroll
                    for (int gq = 0; gq < 4; ++gq) {
                        const f32x4 v = *(const f32x4*)(s0 + l31 * 64 + 4 * h + ((32 * ct) * 64 + 32 * rt + 8 * gq));
#pragma unroll
                        for (int e = 0; e < 4; ++e) T[rt][ct][4 * gq + e] = v[e];
                    }
            constexpr int nsb = DEC_SEQ / SB;
            for (int sbi = 0; sbi < nsb; ++sbi) {
                stage_issue(p, m0 + (long)sbi * SB, hd, lane, rg); stage_commit(wl, lane, rg); lds_sync();
#pragma unroll 1
                for (int st = 0; st < SB; ++st) {
                    float ov[2];
                    step_t<2>(wl + st * STEP_B, T, lane, ov, 1.f);
                    p.RO[(m0 + (long)sbi * SB + st) * 512 + hd * 64 + lane] = h ? ov[1] : ov[0];
                }
                lds_sync();
            }
            float* so = p.out + O_RS_S + (long)sh * 4096;
#pragma unroll
            for (int rt = 0; rt < 2; ++rt)
#pragma unroll
                for (int ct = 0; ct < 2; ++ct)
#pragma unroll
                    for (int gq = 0; gq < 4; ++gq)
                        *(f32x4*)(so + l31 * 64 + 4 * h + ((32 * ct) * 64 + 32 * rt + 8 * gq)) = (f32x4){T[rt][ct][4 * gq], T[rt][ct][4 * gq + 1], T[rt][ct][4 * gq + 2], T[rt][ct][4 * gq + 3]};
        }
    }
}
constexpr int PT_ROW = 65 * 4, PT_B = 64 * PT_ROW;
__device__ __forceinline__ void pass2(const Params& p, LAS unsigned char* lds) {
    const int tid = opaque_tid(), lane = tid & 63, w = __builtin_amdgcn_readfirstlane(tid >> 6), h = lane >> 5, l31 = lane & 31;
    const int pr = w >> 1, ct = w & 1;
    for (int sh0 = ((int)gridDim.x - 1 - (int)blockIdx.x) * 4; sh0 < BATCH * 8; sh0 += gridDim.x * 4) {
        const int sh = sh0 + pr; const bool act = sh < BATCH * 8;
        LAS unsigned char* pb = lds + pr * PT_B;
        f32x16 S[2];
#pragma unroll
        for (int kt = 0; kt < 2; ++kt)
#pragma unroll
            for (int t = 0; t < 16; ++t) S[kt][t] = 0.f;
        f32x4 pg[8];
        const long cbase = (long)(act ? sh : 0) * NCH;
        auto issue = [&](long ctk) {
#pragma unroll
            for (int q = 0; q < 8; ++q) { const int idx = q * 64 + lane; pg[q] = *(const f32x4*)(p.RPC + ctk * 4096 + (32 * ct + (idx >> 4)) * 64 + (idx & 15) * 4); }
        };
        auto commit = [&]() {
#pragma unroll
            for (int q = 0; q < 8; ++q) {
                const int idx = q * 64 + lane; LAS float* d = (LAS float*)(pb + (32 * ct + (idx >> 4)) * PT_ROW) + (idx & 15) * 4;
                d[0] = pg[q][0]; d[1] = pg[q][1]; d[2] = pg[q][2]; d[3] = pg[q][3];
            }
        };
        issue(cbase);
        for (int c = 0; c < NCH; ++c) {
            const long ctk = cbase + c;
            __syncthreads();
            commit();
            if (act) {
                float* ss = p.RSS + ctk * 4096 + (4 * h) * 64 + 32 * ct + l31;
#pragma unroll
                for (int kt = 0; kt < 2; ++kt)
#pragma unroll
                    for (int t = 0; t < 16; ++t) ss[(32 * kt + (t & 3) + 8 * (t >> 2)) * 64] = S[kt][t];
            }
            __syncthreads();
            if (c + 1 < NCH) issue(ctk + 1);
            f32x16 N[2];
            const float* lt = p.RLC + ctk * 4096 + (4 * h) * 64 + 32 * ct + l31;
#pragma unroll
            for (int rt = 0; rt < 2; ++rt)
#pragma unroll
                for (int t = 0; t < 16; ++t) N[rt][t] = lt[(32 * rt + (t & 3) + 8 * (t >> 2)) * 64];
#pragma unroll
            for (int rt = 0; rt < 2; ++rt)
#pragma unroll
                for (int kt = 0; kt < 2; ++kt) {
                    __builtin_amdgcn_sched_barrier(0);
#pragma unroll
                    for (int t = 0; t < 16; ++t) {
                        const float a = *(const LAS float*)(pb + l31 * PT_ROW + 16 * h + ((32 * rt) * PT_ROW + (32 * kt + (t & 3) + 8 * (t >> 2)) * 4));
                        N[rt] = RW_MFMA(a, S[kt][t], N[rt]);
                    }
                }
#pragma unroll
            for (int rt = 0; rt < 2; ++rt) S[rt] = N[rt];
        }
        if (act) {
            float* so = p.out + O_RS_P + (long)sh * 4096;
#pragma unroll
            for (int kt = 0; kt < 2; ++kt)
#pragma unroll
                for (int gq = 0; gq < 4; ++gq)
                    *(f32x4*)(so + (32 * ct + l31) * 64 + 4 * h + (32 * kt + 8 * gq)) = (f32x4){S[kt][4 * gq], S[kt][4 * gq + 1], S[kt][4 * gq + 2], S[kt][4 * gq + 3]};
        }
        __syncthreads();
    }
}
__device__ __forceinline__ void pass3(const Params& p, LAS unsigned char* lds) {
    const int tid = opaque_tid(), lane = tid & 63, w = __builtin_amdgcn_readfirstlane(tid >> 6);
    LAS unsigned char* wl = lds + w * WAVE_B;
    const int npr = BATCH * 8 * NCH;
    const int skip = ((int)gridDim.x > 2 * DEC_BATCH * 2) ? DEC_BATCH * 2 : 0, gw = (int)gridDim.x - skip;
    if ((int)blockIdx.x < skip) return;
    for (int task = w * gw + ((int)blockIdx.x - skip); task < npr; task += gw * 8) {
        const int ct = task, c = ct % NCH, sh = ct / NCH, hd = sh % 8, sq = sh / 8;
        const long m0 = (long)sq * SEQ + (long)c * RC;
        f32x2 S[32];
        const float* st0 = p.RSS + (long)ct * 4096 + lane;
#pragma unroll
        for (int q = 0; q < 32; ++q) S[q] = (f32x2){st0[(2 * q) * 64], st0[(2 * q + 1) * 64]};
        f32x4 rg[4];
        auto issue = [&](int sbi) {
#pragma unroll
            for (int q = 0; q < 4; ++q) { const int idx = q * 64 + lane; rg[q] = *(const f32x4*)(p.RHO + (m0 + sbi * 16 + (idx >> 4)) * 512 + hd * 64 + (idx & 15) * 4); }
        };
        auto commit = [&](int buf) {
#pragma unroll
            for (int q = 0; q < 4; ++q) *(LAS f32x4*)(wl + buf * 4096 + (q * 64 + lane) * 16) = rg[q];
        };
        issue(0); commit(0); wave_sync();
        constexpr int nsb = RC / 16;
        for (int sbi = 0; sbi < nsb; ++sbi) {
            const bool more = sbi + 1 < nsb;
            if (more) issue(sbi + 1);
            const LAS unsigned char* cur = wl + (sbi & 1) * 4096;
#pragma unroll 2
            for (int st = 0; st < 16; ++st) {
                const long o = (m0 + sbi * 16 + st) * 512 + hd * 64 + lane;
                f32x2 a0 = {p.RO[o], 0.f}, a1 = {0.f, 0.f};
#pragma unroll
                for (int jj = 0; jj < 16; ++jj) {
                    const f32x4 r4 = *(const LAS f32x4*)(cur + st * 256 + jj * 16);
                    a0 += S[2 * jj] * (f32x2){r4[0], r4[1]}; a1 += S[2 * jj + 1] * (f32x2){r4[2], r4[3]};
                }
                p.RO[o] = (a0[0] + a0[1]) + (a1[0] + a1[1]);
            }
            if (more) commit((sbi + 1) & 1);
            wave_sync();
        }
    }
}
}

namespace ew {
__device__ __forceinline__ float wsum(float v) {
    v += __shfl_xor(v, 1); v += __shfl_xor(v, 2); v += __shfl_xor(v, 4); v += __shfl_xor(v, 8); v += __shfl_xor(v, 16); v += __shfl_xor(v, 32);
    return v;
}
#define EW_WAVES(ntask) for (long task = (long)blockIdx.x * 8 + w; task < (ntask); task += (long)gridDim.x * 8)
__device__ __forceinline__ float gsum16(float v) { v += __shfl_xor(v, 1); v += __shfl_xor(v, 2); v += __shfl_xor(v, 4); v += __shfl_xor(v, 8); return v; }
typedef float f32x4 __attribute__((ext_vector_type(4)));
typedef unsigned u32x2 __attribute__((ext_vector_type(2)));
__device__ __forceinline__ u32x2 pk4(f32x4 v) { u32x2 r; r[0] = pg8::cvt_pk_bf16(v[0], v[1]); r[1] = pg8::cvt_pk_bf16(v[2], v[3]); return r; }
__device__ __forceinline__ void p_post(const Params& p, long mbase, long ntok) {
    const int tid = opaque_tid(), lane = tid & 63, w = __builtin_amdgcn_readfirstlane(tid >> 6);
    const int d4 = (lane & 15) * 4;
    EW_WAVES(ntok) {
        const long m = mbase + task; const bool smp = m >= MP;
        const int n = tok_seq(m), i = tok_i(m);
        const float* row = p.P + m * IN_COLS;
        f32x4 x[13];
#pragma unroll
        for (int k = 0; k < 13; ++k) { const int f = lane + 64 * k; x[k] = (f < IN_COLS / 4) ? *(const f32x4*)(row + 4 * f) : (f32x4){0.f, 0.f, 0.f, 0.f}; }
        const int fl = 710 + lane;
        f32x4 prev = {0.f, 0.f, 0.f, 0.f};
        if (i > 0) prev = *(const f32x4*)(row - IN_COLS + 4 * fl);
        else if (smp) prev = *(const f32x4*)(p.in[I_STATE_SHIFT] + (long)n * RWKV_COLS + 1536 + 4 * lane);
        const f32x4 cur = *(const f32x4*)(row + 4 * fl);
        const f32x4 mu = *(const f32x4*)(p.in[I_MU] + 1536 + 4 * lane);
        const f32x4 qg = *(const f32x4*)(p.in[I_Q_G] + d4);
#pragma unroll
        for (int k = 0; k < 2; ++k) {
            const f32x4 v = x[k];
            const float r = 1.f / sqrtf(gsum16(v[0] * v[0] + v[1] * v[1] + v[2] * v[2] + v[3] * v[3]) * (1.f / 64.f) + RMS_EPS);
            const f32x4 qn = v * r * qg;
            const long o = m * 512 + 256 * k + 4 * lane;
            *(f32x4*)(p.QN + o) = qn;
            *(u32x2*)(p.QNb + o) = pk4(qn * 0.125f);
        }
        const int hv = lane >> 5, g = (lane >> 4) & 1;
#pragma unroll
        for (int k = 2; k < 5; ++k) {
            f32x4 v = x[k];
            const float ssq = gsum16(v[0] * v[0] + v[1] * v[1] + v[2] * v[2] + v[3] * v[3]);
            if (k >= 3 && hv == 0) {
                const f32x4 gn = *(const f32x4*)((k == 3 ? p.in[I_KS_G] : p.in[I_KW_G]) + d4);
                v = v * (1.f / sqrtf(ssq * (1.f / 64.f) + RMS_EPS)) * gn;
            }
            const int cc = (k - 2) * 256 + 4 * lane;
            *(f32x4*)(p.KVW + m * 768 + cc) = v;
            if (k < 4) *(f32x4*)(p.out + (smp ? O_KV_S + (m - MP) * 512 : O_KV_P + m * 512) + cc) = v;
            else if (smp) *(f32x4*)(p.out + O_WIN_S + ((long)n * WBUF + (WBUF - DEC_SEQ + i)) * 256 + cc - 512) = v;
            else if (i >= SEQ - WP) *(f32x4*)(p.out + O_WIN_P + ((long)n * WP + (i - (SEQ - WP))) * 256 + cc - 512) = v;
            if (!smp && k >= 3) {
                unsigned short* dst = k == 3 ? (hv == 0 ? p.KSb : p.VSb) : (hv == 0 ? p.KWb : p.VWb);
                *(u32x2*)(dst + (((long)n * 2 + g) * SEQ + i) * 64 + d4) = pk4(v);
            }
        }
        if (lane < 6) {
            const f32x4 gb = *(const f32x4*)(p.in[I_GATE_B] + 4 * lane);
            f32x4 gv; gv[0] = sigmoidf_(x[5][0] + gb[0]); gv[1] = sigmoidf_(x[5][1] + gb[1]); gv[2] = sigmoidf_(x[5][2] + gb[2]); gv[3] = sigmoidf_(x[5][3] + gb[3]);
            *(f32x4*)(p.GT + m * 24 + 4 * lane) = gv;
        }
#pragma unroll
        for (int k = 5; k < 13; ++k) { const int f = lane + 64 * k; if (f >= 326 && f < IN_COLS / 4) *(u32x2*)(p.PRb + m * RWKV_COLS + 4 * (f - 326)) = pk4(x[k]); }
        if (i == (smp ? DEC_SEQ : SEQ) - 1) {
            float* so = p.out + (smp ? O_SH_S : O_SH_P) + (long)n * RWKV_COLS;
#pragma unroll
            for (int k = 5; k < 13; ++k) { const int f = lane + 64 * k; if (f >= 326 && f < IN_COLS / 4) *(f32x4*)(so + 4 * (f - 326)) = x[k]; }
        }
        {
            const f32x4 xs = cur + (prev - cur) * mu;
            f32x4 lv;
#pragma unroll
            for (int e = 0; e < 4; ++e) lv[e] = (lane < 16) ? tanhf(xs[e]) : (lane < 32 ? xs[e] : sigmoidf_(xs[e]));
            *(f32x4*)(p.LIN + m * 256 + 4 * lane) = lv;
            *(u32x2*)(p.LINb + m * 256 + 4 * lane) = pk4(lv);
        }
    }
}
typedef unsigned short us4 __attribute__((ext_vector_type(4)));
__device__ __forceinline__ f32x4 ld_bf4(const unsigned short* q) { const u32x2 r = *(const u32x2*)q; f32x4 o; o[0] = __uint_as_float(r[0] << 16); o[1] = __uint_as_float(r[0] & 0xffff0000u); o[2] = __uint_as_float(r[1] << 16); o[3] = __uint_as_float(r[1] & 0xffff0000u); return o; }
__device__ __forceinline__ void lin_prep(const Params& p) {
    const int tid = opaque_tid(), lane = tid & 63, w = __builtin_amdgcn_readfirstlane(tid >> 6);
    EW_WAVES(MP) {
        const long m = task; const int i = (int)(m % SEQ);
        const f32x4 cur = ld_bf4(p.PRb + m * RWKV_COLS + 1536 + 4 * lane);
        f32x4 prev = {0.f, 0.f, 0.f, 0.f};
        if (i > 0) prev = ld_bf4(p.PRb + (m - 1) * RWKV_COLS + 1536 + 4 * lane);
        const f32x4 xs = cur + (prev - cur) * *(const f32x4*)(p.in[I_MU] + 1536 + 4 * lane);
        f32x4 lv;
#pragma unroll
        for (int e = 0; e < 4; ++e) lv[e] = (lane < 16) ? fast_tanh(xs[e]) : (lane < 32 ? xs[e] : fast_sigmoid(xs[e]));
        *(u32x2*)(p.LINb + m * 256 + 4 * lane) = pk4(lv);
    }
}
__device__ __forceinline__ void prep2(const Params& p) {
    const int tid = opaque_tid(), lane = tid & 63, w = __builtin_amdgcn_readfirstlane(tid >> 6);
    EW_WAVES(M_TOK) {
        const long m = task; const bool smp = m >= MP;
        const int n = tok_seq(m), i = tok_i(m);
        const unsigned short* row = p.PRb + m * RWKV_COLS;
        const unsigned short* dq = p.DWb + m * 1536;
        float* rb = p.RWB + m * 3 * 512; unsigned short* rh = p.RWH + m * 3 * 512;
#pragma unroll
        for (int k = 0; k < 2; ++k) {
            const int c = 256 * k + 4 * lane;
            f32x4 xs[3];
#pragma unroll
            for (int s = 0; s < 3; ++s) {
                const f32x4 cur = ld_bf4(row + 512 * s + c);
                f32x4 prev = {0.f, 0.f, 0.f, 0.f};
                if (i > 0) prev = ld_bf4(row - RWKV_COLS + 512 * s + c);
                else if (smp) prev = *(const f32x4*)(p.in[I_STATE_SHIFT] + (long)n * RWKV_COLS + 512 * s + c);
                xs[s] = cur + (prev - cur) * *(const f32x4*)(p.in[I_MU] + 512 * s + c);
            }
            const f32x4 dw = *(const f32x4*)(p.in[I_W0] + c) + ld_bf4(dq + c), da = *(const f32x4*)(p.in[I_A0] + c) + ld_bf4(dq + 512 + c);
            const f32x4 dg = ld_bf4(dq + 1024 + c);
            const f32x4 kkw = *(const f32x4*)(p.in[I_K_K] + c), kaw = *(const f32x4*)(p.in[I_K_A] + c);
            f32x4 decay, a, kkr, kh;
#pragma unroll
            for (int e = 0; e < 4; ++e) {
                decay[e] = __expf(-0.6065306597126334f * fast_sigmoid(dw[e]));
                a[e] = fast_sigmoid(da[e]);
                kkr[e] = xs[1][e] * kkw[e];
                kh[e] = xs[1][e] * (1.f + (a[e] - 1.f) * kaw[e]);
            }
            const float inv = 1.f / sqrtf(fmaxf(gsum16(kkr[0] * kkr[0] + kkr[1] * kkr[1] + kkr[2] * kkr[2] + kkr[3] * kkr[3]), 1e-24f));
            const f32x4 kk = kkr * inv;
            *(u32x2*)(rh + 0 * 512 + c) = pk4(xs[0]); *(u32x2*)(rh + 1 * 512 + c) = pk4(kh); *(u32x2*)(rh + 2 * 512 + c) = pk4(xs[2]);
            *(f32x4*)(rb + 0 * 512 + c) = kk; *(f32x4*)(rb + 1 * 512 + c) = kk * a; *(f32x4*)(rb + 2 * 512 + c) = decay;
            *(u32x2*)(p.GGb + m * 512 + c) = pk4(dg);
            const f32x4 rk = *(const f32x4*)(p.in[I_R_K] + c); const f32x4 t = xs[0] * kh * rk;
            const float bonus = gsum16(t[0] + t[1] + t[2] + t[3]);
            if ((lane & 15) == 0) p.BON[m * 8 + 4 * k + (lane >> 4)] = bonus;
        }
    }
}
__device__ __forceinline__ void rwkv_post(const Params& p, long mbase, long ntok) {
    const int tid = opaque_tid(), lane = tid & 63, w = __builtin_amdgcn_readfirstlane(tid >> 6);
    EW_WAVES(ntok) {
        const long m = mbase + task;
        const unsigned short* rh = p.RWH + m * 3 * 512;
#pragma unroll
        for (int k = 0; k < 2; ++k) {
            const int c = 256 * k + 4 * lane;
            const f32x4 ro = *(const f32x4*)(p.RO + m * 512 + c);
            const f32x4 v = ld_bf4(rh + 1024 + c);
            const f32x4 lg = *(const f32x4*)(p.in[I_LNX_G] + c), lb = *(const f32x4*)(p.in[I_LNX_B] + c);
            const f32x4 gg = ld_bf4(p.GGb + m * 512 + c);
            const float mean = gsum16(ro[0] + ro[1] + ro[2] + ro[3]) * (1.f / 64.f);
            const f32x4 dv = ro - mean;
            const float var = gsum16(dv[0] * dv[0] + dv[1] * dv[1] + dv[2] * dv[2] + dv[3] * dv[3]) * (1.f / 64.f);
            const float rstd = 1.f / sqrtf(var + LNX_EPS);
            const float bonus = p.BON[m * 8 + 4 * k + (lane >> 4)];
            const f32x4 o = (dv * rstd * lg + lb + v * bonus) * gg;
            *(u32x2*)(p.MIXb + m * MIX_W + 512 + c) = pk4(o);
        }
    }
}
__device__ __forceinline__ void memkv_post(const Params& p) {
    const int tid = opaque_tid(), lane = tid & 63, w = __builtin_amdgcn_readfirstlane(tid >> 6);
    EW_WAVES((long)MEMROWS * 4) {
        const long r = task >> 2; const int h = (int)(task & 3); const long n = r / N_MEM, j = r % N_MEM;
        float* kp = p.out + O_MKV + r * 1024 + h * 128; const float* vp = kp + 512;
        const float k0 = kp[lane], k1 = kp[lane + 64];
        const float rr = 1.f / sqrtf(wsum(k0 * k0 + k1 * k1) * (1.f / 128.f) + RMS_EPS);
        const float a0 = k0 * rr * p.in[I_XK_G][lane], a1 = k1 * rr * p.in[I_XK_G][lane + 64];
        kp[lane] = a0; kp[lane + 64] = a1;
        const long o = ((n * 4 + h) * N_MEM + j) * 128;
        p.XKb[o + lane] = f2bf(a0); p.XKb[o + lane + 64] = f2bf(a1);
        p.XVb[o + lane] = f2bf(vp[lane]); p.XVb[o + lane + 64] = f2bf(vp[lane + 64]);
    }
}
__device__ __forceinline__ void memkv_cache_cvt(const Params& p) {
    const int tid = opaque_tid(), lane = tid & 63, w = __builtin_amdgcn_readfirstlane(tid >> 6);
    EW_WAVES((long)DEC_BATCH * N_MEM * 4) {
        const long r = task >> 2; const int h = (int)(task & 3); const long n = r / N_MEM, j = r % N_MEM;
        const float* kp = p.in[I_CACHE_MEM] + r * 1024 + h * 128; const float* vp = kp + 512;
        const long o = ((n * 4 + h) * N_MEM + j) * 128;
        p.XKSb[o + lane] = f2bf(kp[lane]); p.XKSb[o + lane + 64] = f2bf(kp[lane + 64]);
        p.XVSb[o + lane] = f2bf(vp[lane]); p.XVSb[o + lane + 64] = f2bf(vp[lane + 64]);
    }
}
__device__ __forceinline__ void cmp_out(const Params& p, LAS unsigned char* lds) {
    const int tid = opaque_tid(), lane = tid & 63, w = __builtin_amdgcn_readfirstlane(tid >> 6);
    LAS float* wl = (LAS float*)lds;
    __syncthreads();
    for (int i = tid; i < 2 * 2048; i += 512) {
        const f32x4 v = *(const f32x4*)((i < 2048 ? p.in[I_W_CK2] : p.in[I_W_CV2]) + (i & 2047) * 4);
        *(LAS f32x4*)(wl + i * 4) = v;
    }
    __syncthreads();
    EW_WAVES((long)N_CBLK * 2 * 2) {
        const int c = (int)(task & 1); const long R = task >> 1; const long bu = R >> 1; const int g = (int)(R & 1);
        const LAS float* w2 = wl + c * 8192 + lane;
        const float* hp = p.CH + (R * 2 + c) * 128;
        const float h0 = hp[lane], h1 = hp[lane + 64];
        float o0 = 0.f, o1 = 0.f, o2 = 0.f, o3 = 0.f;
#pragma unroll 8
        for (int k = 0; k < 64; k += 2) {
            o0 += __int_as_float(__builtin_amdgcn_readlane(__float_as_int(h0), k)) * w2[k * 64]; o1 += __int_as_float(__builtin_amdgcn_readlane(__float_as_int(h0), k + 1)) * w2[(k + 1) * 64];
            o2 += __int_as_float(__builtin_amdgcn_readlane(__float_as_int(h1), k)) * w2[(k + 64) * 64]; o3 += __int_as_float(__builtin_amdgcn_readlane(__float_as_int(h1), k + 1)) * w2[(k + 65) * 64];
        }
        float o = (o0 + o1) + (o2 + o3);
        const bool prm = bu < (long)BATCH * NBP; const long nn = bu / NBP, bb = bu % NBP;
        if (c == 0) o = o * (1.f / sqrtf(wsum(o * o) * (1.f / 64.f) + RMS_EPS)) * p.in[I_KC_G][lane];
        float* dst = prm ? (c == 0 ? p.KCP : p.VCP) + (bu * 2 + g) * 64 : (c == 0 ? p.KCS : p.VCS) + ((bu - (long)BATCH * NBP) * 2 + g) * 64;
        dst[lane] = o;
        if (prm) { if (c == 0) p.KCb[((nn * 2 + g) * NBP + bb) * 64 + lane] = f2bf(o); else p.VCt[((nn * 2 + g) * 64 + lane) * NBP + bb] = f2bf(o); }
    }
    __syncthreads();
}
__device__ __forceinline__ void copy_rows(const Params& p) {
    const int tid = opaque_tid(), lane = tid & 63, w = __builtin_amdgcn_readfirstlane(tid >> 6);
    static_assert(D_MODEL == 1024, "copy_rows row width");
    EW_WAVES(M_TOK) {
        const long m = task;
        const float* src = m < MP ? p.in[I_X_PROMPT] + m * D_MODEL : p.in[I_X_SAMPLE] + (m - MP) * D_MODEL;
        f32x4 v[4]; float ss = 0.f;
#pragma unroll
        for (int k = 0; k < 4; ++k) v[k] = *(const f32x4*)(src + 4 * (lane + 64 * k));
#pragma unroll
        for (int k = 0; k < 4; ++k) {
            if (m >= MP) *(f32x4*)(p.X0 + m * D_MODEL + 4 * (lane + 64 * k)) = v[k];
            *(u32x2*)(p.X0b + m * D_MODEL + 4 * (lane + 64 * k)) = pk4(v[k]);
            ss += v[k][0] * v[k][0] + v[k][1] * v[k][1] + v[k][2] * v[k][2] + v[k][3] * v[k][3];
        }
        ss = wsum(ss);
        if (lane == 0) { p.RS0[m] = ss; p.RS1[m] = 0.f; p.RS2[m] = 0.f; p.RS3[m] = 0.f; p.RS4[m] = 0.f; }
    }
}
__device__ __forceinline__ void final_rows(const Params& p) {
    const int tid = opaque_tid(), lane = tid & 63, w = __builtin_amdgcn_readfirstlane(tid >> 6);
    EW_WAVES(M_TOK) {
        const long m = task;
        const float s = rs_of(p.RS4[m], D_MODEL);
        float* dst = p.out + (m < MP ? O_Y_P + m * D_MODEL : O_Y_S + (m - MP) * D_MODEL);
#pragma unroll
        for (int k = 0; k < 4; ++k) {
            const int c = 4 * (lane + 64 * k);
            *(f32x4*)(dst + c) = ld_bf4(p.X1b + m * D_MODEL + c) * s * *(const f32x4*)(p.in[I_G_OUT] + c);
        }
    }
}
}

namespace cmpk {
typedef short bf16x8 __attribute__((ext_vector_type(8)));
typedef float f32x16 __attribute__((ext_vector_type(16)));
typedef float f32x4 __attribute__((ext_vector_type(4)));
typedef unsigned u32x4 __attribute__((ext_vector_type(4)));
typedef unsigned u32x2 __attribute__((ext_vector_type(2)));
constexpr int ROWB = 144, TA = 128 * ROWB, C_A = 0, C_B = 2 * TA;
__device__ __forceinline__ void unit(const Params& p, LAS unsigned char* lds, int rt, int c) {
    const int tid = opaque_tid(), lane = tid & 63, w = __builtin_amdgcn_readfirstlane(tid >> 6), ql = lane & 31, h = lane >> 5, wr = w >> 1, wc = w & 1;
    const float* ap[4]; long astride;
    {
        const bool prm = (long)rt * 128 < (long)BATCH * NBP * 2;
        astride = prm ? 256 : 512;
#pragma unroll
        for (int q = 0; q < 4; ++q) {
            const long R = (long)rt * 128 + q * 32 + (tid >> 4); const long bu = R >> 1; const int g = (int)(R & 1);
            if (prm) { const long n = bu / NBP, b = bu % NBP; ap[q] = p.KC32 + (n * SEQ + b * 64) * 256 + c * 128 + g * 64 + (tid & 15) * 4; }
            else {
                const long bs = bu - (long)BATCH * NBP, n = bs / NBS, b = bs % NBS;
                const long phys = ((const int*)p.in[I_PAGE_TABLE])[n * NPAGES + b / BPP];
                ap[q] = p.in[I_CACHE_KV] + (((phys * PAGE_SIZE + (b % BPP) * 64) * 4 + c) * 2 + g) * 64 + (tid & 15) * 4;
            }
        }
    }
    const unsigned short* bp = p.WC1 + ((long)c * 128 + (tid >> 3)) * 4096 + (tid & 7) * 8;
    f32x4 ar[4]; u32x4 br[2];
    auto issue = [&](int s) {
#pragma unroll
        for (int q = 0; q < 4; ++q) ar[q] = *(const f32x4*)(ap[q] + (long)s * astride);
        br[0] = *(const u32x4*)(bp + s * 64); br[1] = *(const u32x4*)(bp + 64L * 4096 + s * 64);
    };
    auto commit = [&](int buf) {
#pragma unroll
        for (int q = 0; q < 4; ++q) {
            u32x2 pk; pk[0] = pg8::cvt_pk_bf16(ar[q][0], ar[q][1]); pk[1] = pg8::cvt_pk_bf16(ar[q][2], ar[q][3]);
            *(LAS u32x2*)(lds + C_A + buf * TA + (q * 32 + (tid >> 4)) * ROWB + (tid & 15) * 8) = pk;
        }
        *(LAS u32x4*)(lds + C_B + buf * TA + (tid >> 3) * ROWB + (tid & 7) * 16) = br[0];
        *(LAS u32x4*)(lds + C_B + buf * TA + (64 + (tid >> 3)) * ROWB + (tid & 7) * 16) = br[1];
    };
    f32x16 acc[2];
#pragma unroll
    for (int cb = 0; cb < 2; ++cb)
#pragma unroll
        for (int i = 0; i < 16; ++i) acc[cb][i] = 0.f;
    issue(0); commit(0);
    __syncthreads();
    for (int s = 0; s < 64; ++s) {
        const bool more = s + 1 < 64;
        if (more) issue(s + 1);
        const LAS unsigned char* A = lds + C_A + (s & 1) * TA + (32 * wr + ql) * ROWB + 16 * h;
        const LAS unsigned char* B = lds + C_B + (s & 1) * TA + (64 * wc + ql) * ROWB + 16 * h;
#pragma unroll
        for (int ks = 0; ks < 4; ++ks) {
            const bf16x8 a = *(const LAS bf16x8*)(A + 32 * ks);
#pragma unroll
            for (int cb = 0; cb < 2; ++cb) acc[cb] = __builtin_amdgcn_mfma_f32_32x32x16_bf16(a, *(const LAS bf16x8*)(B + cb * 32 * ROWB + 32 * ks), acc[cb], 0, 0, 0);
        }
        if (more) commit((s + 1) & 1);
        __syncthreads();
    }
#pragma unroll
    for (int cb = 0; cb < 2; ++cb) {
        const int col = 64 * wc + 32 * cb + ql; const float bias = p.PEB[c * 128 + col];
#pragma unroll
        for (int i = 0; i < 16; ++i) {
            const long R = (long)rt * 128 + 32 * wr + (i & 3) + 8 * (i >> 2) + 4 * h;
            p.CH[(R * 2 + c) * 128 + col] = geluf_(acc[cb][i] + bias);
        }
    }
}
static_assert((BATCH * NBP * 2) % 128 == 0 && (N_CBLK * 2) % 128 == 0, "compression row tiles");
constexpr int NPT = BATCH * NBP * 2 / 128, NST = DEC_BATCH * NBS * 2 / 128;
__device__ __forceinline__ void sample_phase(const Params& p, LAS unsigned char* lds) {
    for (int u = blockIdx.x; u < 2 * NST; u += gridDim.x) unit(p, lds, NPT + (u >> 1), u & 1);
}
__device__ __forceinline__ void prompt_phase(const Params& p, LAS unsigned char* lds) {
    for (int u = blockIdx.x; u < 2 * NPT; u += gridDim.x) unit(p, lds, u >> 1, u & 1);
}
}

namespace sk {
typedef short bf16x8 __attribute__((ext_vector_type(8)));
typedef float f32x16 __attribute__((ext_vector_type(16)));
#define SK_MFMA(a, b, c) __builtin_amdgcn_mfma_f32_32x32x16_bf16((a), (b), (c), 0, 0, 0)
__device__ __forceinline__ int crow(int i, int h) { return (i & 3) + 8 * (i >> 2) + 4 * h; }
__device__ __forceinline__ f32x16 zero16() { f32x16 z; for (int i = 0; i < 16; ++i) z[i] = 0.f; return z; }
__device__ __forceinline__ f32x16 tile1(const unsigned short* A, const unsigned short* Bt, int K, long arow0, long brow0, int lane) {
    const int r = lane & 31, h = lane >> 5;
    const unsigned short* ap = A + (arow0 + r) * K + 8 * h; const unsigned short* bp = Bt + (brow0 + r) * K + 8 * h;
    f32x16 acc = zero16();
#pragma unroll 8
    for (int k0 = 0; k0 < K; k0 += 16) acc = SK_MFMA(*(const bf16x8*)(ap + k0), *(const bf16x8*)(bp + k0), acc);
    return acc;
}
#define SK_TASKS(ntask) for (int task = blockIdx.x * 8 + w; task < (ntask); task += gridDim.x * 8)
__device__ __forceinline__ void gu(const unsigned short* A, const unsigned short* Bt, const float* ss, unsigned short* Hb) {
    const int tid = opaque_tid(), lane = tid & 63, w = __builtin_amdgcn_readfirstlane(tid >> 6), r = lane & 31, h = lane >> 5;
    SK_TASKS((MS / 32) * (D_FF / 32)) {
        const int rb = task % (MS / 32), cb = task / (MS / 32), j0 = cb * 32, pn = j0 / 128, rr = j0 % 128;
        const long row0 = (long)MP + rb * 32;
        const unsigned short* ap = A + (row0 + r) * D_MODEL + 8 * h;
        const unsigned short* gp = Bt + ((long)pn * 256 + rr + r) * D_MODEL + 8 * h; const unsigned short* up = gp + 128L * D_MODEL;
        f32x16 ag = zero16(), au = zero16();
#pragma unroll 4
        for (int k0 = 0; k0 < D_MODEL; k0 += 16) { const bf16x8 a = *(const bf16x8*)(ap + k0); ag = SK_MFMA(a, *(const bf16x8*)(gp + k0), ag); au = SK_MFMA(a, *(const bf16x8*)(up + k0), au); }
#pragma unroll
        for (int i = 0; i < 16; ++i) {
            const long row = row0 + crow(i, h); const float rs = rs_of(ss[row], D_MODEL);
            Hb[row * D_FF + j0 + r] = f2bf(pg8::silu_fast(ag[i] * rs) * (au[i] * rs));
        }
    }
}
__device__ __forceinline__ void res(const unsigned short* A, const unsigned short* Bt, int K, const float* R32, const unsigned short* Rb, float* C32, unsigned short* Cb, float alpha, float* ss) {
    const int tid = opaque_tid(), lane = tid & 63, w = __builtin_amdgcn_readfirstlane(tid >> 6), r = lane & 31, h = lane >> 5;
    SK_TASKS((MS / 32) * (D_MODEL / 32)) {
        const int rb = task % (MS / 32), cb = task / (MS / 32);
        const long row0 = (long)MP + rb * 32;
        const f32x16 acc = tile1(A, Bt, K, row0, (long)cb * 32, lane);
#pragma unroll
        for (int i = 0; i < 16; ++i) {
            const long row = row0 + crow(i, h); const long o = row * D_MODEL + cb * 32 + r;
            const float rv = R32 ? R32[o] : bf2f(Rb[o]);
            const float v = rv + alpha * acc[i];
            if (C32) C32[o] = v;
            Cb[o] = f2bf(v);
            float sq = v * v;
            sq += __shfl_xor(sq, 1); sq += __shfl_xor(sq, 2); sq += __shfl_xor(sq, 4); sq += __shfl_xor(sq, 8); sq += __shfl_xor(sq, 16);
            if (r == 0) atomicAdd(ss + row, sq);
        }
    }
}
__device__ __forceinline__ void scale(const unsigned short* A, const unsigned short* Bt, int K, float* C, int ldc, const float* ss, long row_base, int nrb, int cb0, int ncb, int nvalid, int hp_rows = 0) {
    const int tid = opaque_tid(), lane = tid & 63, w = __builtin_amdgcn_readfirstlane(tid >> 6), r = lane & 31, h = lane >> 5;
    SK_TASKS(nrb * ncb) {
        const int rb = task % nrb, cb = cb0 + task / nrb;
        const long row0 = row_base + (long)rb * 32;
        const f32x16 acc = tile1(A, Bt, K, row0, (long)cb * 32, lane);
        int col = cb * 32 + r;
        if (col < hp_rows) col = hp_src(col);
        if (col < nvalid) {
#pragma unroll
            for (int i = 0; i < 16; ++i) {
                const long row = row0 + crow(i, h);
                C[row * ldc + col] = acc[i] * (ss ? rs_of(ss[row], D_MODEL) : 1.f);
            }
        }
    }
}
__device__ __forceinline__ void scale_b(const unsigned short* A, const unsigned short* Bt, int K, unsigned short* C, int ldc, const float* ss, long row_base, int nrb, int ncb) {
    const int tid = opaque_tid(), lane = tid & 63, w = __builtin_amdgcn_readfirstlane(tid >> 6), r = lane & 31, h = lane >> 5;
    SK_TASKS(nrb * ncb) {
        const int rb = task % nrb, cb = task / nrb;
        const long row0 = row_base + (long)rb * 32;
        const f32x16 acc = tile1(A, Bt, K, row0, (long)cb * 32, lane);
#pragma unroll
        for (int i = 0; i < 16; ++i) {
            const long row = row0 + crow(i, h);
            C[row * ldc + cb * 32 + r] = f2bf(acc[i] * (ss ? rs_of(ss[row], D_MODEL) : 1.f));
        }
    }
}
__device__ __forceinline__ void win_tail(const Params& p) {
    const int tid = opaque_tid(), lane = tid & 63, w = __builtin_amdgcn_readfirstlane(tid >> 6), r = lane & 31, h = lane >> 5;
    SK_TASKS(MP / 32) {
        const long row0 = (long)task * 32;
        const f32x16 acc = tile1(p.X1b, p.Win, D_MODEL, row0, 3072, lane);
        const int col = 3072 + r;
        if (col < IN_COLS) {
#pragma unroll
            for (int i = 0; i < 16; ++i) {
                const long row = row0 + crow(i, h);
                const float v = acc[i] * rs_of(p.RS1[row], D_MODEL);
                p.PRb[row * RWKV_COLS + col - NSA_COLS] = f2bf(v);
                if (row % SEQ == SEQ - 1) p.out[O_SH_P + (row / SEQ) * RWKV_COLS + col - NSA_COLS] = v;
            }
        }
    }
}
}

__device__ __forceinline__ void wconv_tiled(LAS unsigned char* lds, const float* W, int ldw, const float* g, unsigned short* Bt, int K, int nrows, bool gu, int nvalid, int hp_rows = 0) {
    const int tid = opaque_tid(), lane = tid & 63, w = __builtin_amdgcn_readfirstlane(tid >> 6);
    LAS float* tile = (LAS float*)(lds + w * 16640);
    const int ntn = (nrows + 63) / 64, ntk = K / 64;
    for (int t = w * (int)gridDim.x + (int)blockIdx.x; t < ntn * ntk; t += gridDim.x * 8) {
        const int tn = t % ntn, tk = t / ntn;
        const int n4 = (lane & 15) * 4, n = tn * 64 + n4;
        int sc = n;
        if (gu) { const int pn = n / 256, bj = (n % 256) / 128, r = n % 128; sc = bj * D_FF + pn * 128 + r; }
        if (n < hp_rows) sc = hp_src(n);
        const bool okc = (n < nrows) && (sc < nvalid);
        float4 v[16];
#pragma unroll
        for (int q = 0; q < 16; ++q) {
            const int kk = q * 4 + (lane >> 4);
            v[q] = okc ? *(const float4*)(W + (long)(tk * 64 + kk) * ldw + sc) : make_float4(0.f, 0.f, 0.f, 0.f);
        }
#pragma unroll
        for (int q = 0; q < 16; ++q) {
            const int kk = q * 4 + (lane >> 4);
            const float gs = g ? g[tk * 64 + kk] : 1.f;
            LAS float* d = tile + kk * 65 + n4;
            d[0] = v[q].x * gs; d[1] = v[q].y * gs; d[2] = v[q].z * gs; d[3] = v[q].w * gs;
        }
        asm volatile("s_waitcnt lgkmcnt(0)" ::: "memory");
#pragma unroll
        for (int q = 0; q < 16; ++q) {
            const int nn = q * 4 + (lane >> 4), k4 = (lane & 15) * 4, nr = tn * 64 + nn;
            const unsigned lo = pg8::cvt_pk_bf16(tile[(k4 + 0) * 65 + nn], tile[(k4 + 1) * 65 + nn]), hi = pg8::cvt_pk_bf16(tile[(k4 + 2) * 65 + nn], tile[(k4 + 3) * 65 + nn]);
            if (nr < nrows) { pg8::u32x2 o; o[0] = lo; o[1] = hi; *(pg8::u32x2*)(Bt + (long)nr * K + tk * 64 + k4) = o; }
        }
        asm volatile("s_waitcnt lgkmcnt(0)" ::: "memory");
    }
}

#define NTHREADS 512
#define LDS_BYTES (159744)
#ifndef MFMA_ALL
#define MFMA_ALL 1
#endif
#ifndef NSA_MFMA_ON
#define NSA_MFMA_ON 1
#endif

__global__ void __launch_bounds__(NTHREADS, 2) k_mega(Params p) {
    extern __shared__ __attribute__((aligned(16))) unsigned char lds[];
    volatile LAS unsigned* xbw = (volatile LAS unsigned*)((LAS unsigned char*)lds + LDS_BYTES - 256);
    if (threadIdx.x < 4) xbw[threadIdx.x] = 0u;
    __syncthreads();
    XcdBarrier bar = xcd_barrier_post(p.bar, xbw);
    const long gsz = (long)gridDim.x * NTHREADS;
    PG8_LAS unsigned char* glds = (PG8_LAS unsigned char*)lds;
    const int G = (int)gridDim.x, bx = (int)blockIdx.x;
#define NAIVE(nunits, call) { const long n_ = (nunits); for (long u = (long)blockIdx.x * NTHREADS + opaque_tid(); u < n_; u += gsz) { call; } }
#ifndef PROBE_DBL
#define PROBE_DBL 0
#endif
#define PROBE_RUN(id, ...) { __VA_ARGS__ if (PROBE_DBL == (id)) { BAR __VA_ARGS__ } }
#define NAIVE_P(id, nunits, call) { NAIVE(nunits, call) if (PROBE_DBL == (id)) { BAR NAIVE(nunits, call) } }
#define BAR xcd_barrier(bar);
#define GEMM(Aptr, Bptr, Mr, Nc, Kd, EpiT, ...) { pg8::Gemm g_{Aptr, Bptr, Mr, Nc, Kd}; pg8::StaticOrder S_; S_.init(Mr, Nc, G, bx); \
        pg8::EpiT E_{__VA_ARGS__}; pg8::gemm_phase<pg8::EpiT, pg8::StaticOrder>(glds, g_, S_, E_); }
    PROBE_RUN(23, ew::copy_rows(p);)
    PROBE_RUN(7,
    wconv_tiled((LAS unsigned char*)lds, p.in[I_W_FFN1_GU], 2 * D_FF, p.in[I_G_FFN1], p.Wgu1, D_MODEL, 2 * D_FF, true, 1 << 30);
    wconv_tiled((LAS unsigned char*)lds, p.in[I_W_FFN2_GU], 2 * D_FF, p.in[I_G_FFN2], p.Wgu2, D_MODEL, 2 * D_FF, true, 1 << 30);
    wconv_tiled((LAS unsigned char*)lds, p.in[I_W_FFN1_DOWN], D_MODEL, (const float*)0, p.Wd1, D_FF, D_MODEL, false, 1 << 30);
    wconv_tiled((LAS unsigned char*)lds, p.in[I_W_FFN2_DOWN], D_MODEL, (const float*)0, p.Wd2, D_FF, D_MODEL, false, 1 << 30);
    wconv_tiled((LAS unsigned char*)lds, p.in[I_W_IN], IN_COLS, p.in[I_G_MIX], p.Win, D_MODEL, 3104, false, IN_COLS, 3072);
    wconv_tiled((LAS unsigned char*)lds, p.in[I_W_OUT], D_MODEL, (const float*)0, p.Wout, MIX_W, D_MODEL, false, 1 << 30);
    wconv_tiled((LAS unsigned char*)lds, p.in[I_W_XQ], XW, p.in[I_G_X], p.Wxq, D_MODEL, XW, false, 1 << 30);
    wconv_tiled((LAS unsigned char*)lds, p.in[I_W_XO], D_MODEL, (const float*)0, p.Wxo, XW, D_MODEL, false, 1 << 30);
    wconv_tiled((LAS unsigned char*)lds, p.in[I_W_XKV], 1024, p.in[I_G_MEM], p.Wxkv, D_MODEL, 1024, false, 1 << 30);
    wconv_tiled((LAS unsigned char*)lds, p.in[I_W_CK1], 128, (const float*)0, p.WC1, 4096, 128, false, 1 << 30);
    wconv_tiled((LAS unsigned char*)lds, p.in[I_W_CV1], 128, (const float*)0, p.WC1 + 128 * 4096, 4096, 128, false, 1 << 30);
    NAIVE((long)MEMROWS * D_MODEL / 4, u_cvt4(p.in[I_MEM_PROMPT], p.MEMb, u))
    NAIVE((long)1536 * 128, u_wconv_lora(p, u))
    NAIVE(256L, u_pebias(p, u))
    )
    NAIVE((long)MEMROWS, u_rowstat(p.in[I_MEM_PROMPT], D_MODEL, p.RSM, u))
    NAIVE((long)DEC_BATCH * (WBUF - DEC_SEQ) * 64, u_wincopy(p, u))
    ew::memkv_cache_cvt(p);
    BAR
    PROBE_RUN(11, GEMM(p.X0b, p.Wgu1, MP, 2 * D_FF, D_MODEL, EpiGU, p.Hb, D_FF, p.RS0))
    PROBE_RUN(30, GEMM(p.MEMb, p.Wxkv, MEMROWS, 1024, D_MODEL, EpiScale, p.out + O_MKV, 1024, p.RSM))
    PROBE_RUN(20, sk::gu(p.X0b, p.Wgu1, p.RS0, p.Hb);)
    PROBE_RUN(12, cmpk::sample_phase(p, (LAS unsigned char*)lds);)
    BAR
    GEMM(p.Hb, p.Wd1, MP, D_MODEL, D_FF, EpiRes2, p.in[I_X_PROMPT], (const pg8::bf16_t*)0, (float*)0, p.X1b, D_MODEL, 0.5f, p.RS1)
    sk::res(p.Hb, p.Wd1, D_FF, p.X0, (const unsigned short*)0, (float*)0, p.X1b, 0.5f, p.RS1);
    ew::memkv_post(p);
    BAR
    PROBE_RUN(18, { pg8::Gemm g_{p.X1b, p.Win, MP, 3072, D_MODEL}; pg8::StaticOrder S_; S_.init(MP, 3072, G, bx); pg8::EpiIn E_{p.RS1, p.in[I_Q_G], p.in[I_KS_G], p.in[I_KW_G], p.in[I_GATE_B], p.out, p.QNb, p.KC32, p.KSb, p.VSb, p.KWb, p.VWb, p.GT, p.PRb}; pg8::gemm_phase<pg8::EpiIn, pg8::StaticOrder>(glds, g_, S_, E_); })
    sk::win_tail(p);
    sk::scale(p.X1b, p.Win, D_MODEL, p.P, IN_COLS, p.RS1, MP, MS / 32, 0, 97, IN_COLS, 3072);
    BAR
    PROBE_RUN(13, ew::p_post(p, MP, MS);
    ew::lin_prep(p);)
    BAR
    PROBE_RUN(28, GEMM(p.LINb, p.Wlora, MP, 1536, 256, EpiScaleB, p.DWb, 1536, (const float*)0))
    sk::scale_b(p.LINb, p.Wlora, 256, p.DWb, 1536, (const float*)0, MP, MS / 32, 48);
    BAR
    PROBE_RUN(25, cmpk::prompt_phase(p, (LAS unsigned char*)lds);)
    PROBE_RUN(17, ew::prep2(p);)
    BAR
    PROBE_RUN(26, ew::cmp_out(p, (LAS unsigned char*)lds);)
    PROBE_RUN(8, rw::pass1(p, (LAS unsigned char*)lds);)
    BAR
    PROBE_RUN(16, rw::pass2(p, (LAS unsigned char*)lds);)
    PROBE_RUN(10, nsa::prompt_phase(p, (LAS unsigned char*)lds);)
    BAR
    PROBE_RUN(15, nsa::sample_phase(p, (LAS unsigned char*)lds);)
    rw::pass3(p, (LAS unsigned char*)lds);
    BAR
    PROBE_RUN(22, ew::rwkv_post(p, 0, M_TOK);)
    BAR
    GEMM(p.MIXb, p.Wout, MP, D_MODEL, MIX_W, EpiRes2, (const float*)0, p.X1b, (float*)0, p.X2b, D_MODEL, 1.0f, p.RS2)
    sk::res(p.MIXb, p.Wout, MIX_W, (const float*)0, p.X1b, (float*)0, p.X2b, 1.0f, p.RS2);
    BAR
    PROBE_RUN(29, GEMM(p.X2b, p.Wxq, MP, XW, D_MODEL, EpiScaleB, p.XQb, XW, p.RS2))
    sk::scale_b(p.X2b, p.Wxq, D_MODEL, p.XQb, XW, p.RS2, MP, MS / 32, XW / 32);
    BAR
    PROBE_RUN(14, nsa::xattn_phase(p, (LAS unsigned char*)lds);)
    BAR
    GEMM(p.OXb, p.Wxo, MP, D_MODEL, XW, EpiRes2, (const float*)0, p.X2b, (float*)0, p.X3b, D_MODEL, 1.0f, p.RS3)
    sk::res(p.OXb, p.Wxo, XW, (const float*)0, p.X2b, (float*)0, p.X3b, 1.0f, p.RS3);
    BAR
    GEMM(p.X3b, p.Wgu2, MP, 2 * D_FF, D_MODEL, EpiGU, p.Hb, D_FF, p.RS3)
    sk::gu(p.X3b, p.Wgu2, p.RS3, p.Hb);
    BAR
    GEMM(p.Hb, p.Wd2, MP, D_MODEL, D_FF, EpiRes2, (const float*)0, p.X3b, (float*)0, p.X1b, D_MODEL, 0.5f, p.RS4)
    sk::res(p.Hb, p.Wd2, D_FF, (const float*)0, p.X3b, (float*)0, p.X1b, 0.5f, p.RS4);
    BAR
    PROBE_RUN(24, ew::final_rows(p);)
}

extern "C" void kernel_launch(void* const* d_in, const int* in_sizes, int n_in, void* d_out, int out_size, void* d_ws, size_t ws_size,
                              hipStream_t stream) {
    Params p;
    memset(&p, 0, sizeof(p));
    for (int i = 0; i < N_INPUTS; ++i) p.in[i] = (const float*)d_in[i];
    p.out = (float*)d_out;
    carve(p, d_ws);
    static int grid = 0;
    if (!grid) {
        int dev = 0, cus = 0;
        (void)hipGetDevice(&dev);
        (void)hipDeviceGetAttribute(&cus, hipDeviceAttributeMultiprocessorCount, dev);
        (void)hipFuncSetAttribute((const void*)k_mega, hipFuncAttributeMaxDynamicSharedMemorySize, LDS_BYTES);
        grid = cus > 0 ? cus : 256;
    }
    (void)hipMemsetAsync(p.bar, 0, XCD_BAR_WORDS * sizeof(unsigned), stream);
    hipLaunchKernelGGL(k_mega, dim3(grid), dim3(NTHREADS), LDS_BYTES, stream, p);
}
#endif
#if defined(PROBE_ATTN) && !defined(HOST_TEST)
__global__ void __launch_bounds__(NTHREADS, 2) k_probe_attn(Params p) {
    extern __shared__ __attribute__((aligned(16))) unsigned char lds[];
    PROBE_RUN(10, nsa::prompt_phase(p, (LAS unsigned char*)lds);)
}
#endif
#if defined(PROBE_RW) && !defined(HOST_TEST)
__global__ void __launch_bounds__(NTHREADS, 2) k_probe_rw1(Params p) { extern __shared__ __attribute__((aligned(16))) unsigned char lds[]; rw::pass1(p, (LAS unsigned char*)lds); }
__global__ void __launch_bounds__(NTHREADS, 2) k_probe_rw2(Params p) { extern __shared__ __attribute__((aligned(16))) unsigned char lds[]; rw::pass2(p, (LAS unsigned char*)lds); }
__global__ void __launch_bounds__(NTHREADS, 2) k_probe_rw3(Params p) { extern __shared__ __attribute__((aligned(16))) unsigned char lds[]; rw::pass3(p, (LAS unsigned char*)lds); }
#endif
```

```cpp
#ifndef HOST_TEST
#include <hip/hip_runtime.h>
#define HD __host__ __device__ __forceinline__
#else
#include <cmath>
#include <cstdio>
#include <cstdlib>
#define HD inline
#endif
#include <stdint.h>
#include <string.h>

#ifndef D_MODEL
#define D_MODEL 1024
#endif
#ifndef BATCH
#define BATCH 8
#endif
#ifndef SEQ
#define SEQ 4096
#endif
#ifndef DEC_BATCH
#define DEC_BATCH 32
#endif
#ifndef DEC_SEQ
#define DEC_SEQ 8
#endif
#ifndef PAST_LEN
#define PAST_LEN 16384
#endif
#ifndef PAGE_SIZE
#define PAGE_SIZE 128
#endif
#ifndef N_SEL
#define N_SEL 16
#endif
#ifndef WINDOW
#define WINDOW 512
#endif
#ifndef N_MEM
#define N_MEM 256
#endif
#ifndef D_FF
#define D_FF 2816
#endif
#define NSA_COLS 1304
#define RWKV_COLS 1792
#define IN_COLS 3096
#define MIX_W 1024
#define XW 512
#define MP (BATCH * SEQ)
#define MS (DEC_BATCH * DEC_SEQ)
#define M_TOK (MP + MS)
#define NBP (SEQ / 64)
#define NBS (PAST_LEN / 64)
#define NBMAX ((NBP > NBS + 1) ? NBP : (NBS + 1))
#define WBUF ((WINDOW < PAST_LEN) ? WINDOW : PAST_LEN)
#define WP ((WINDOW < SEQ) ? WINDOW : SEQ)
#define NPAGES (PAST_LEN / PAGE_SIZE)
#define BPP (PAGE_SIZE / 64)
#define MEMROWS (BATCH * N_MEM)
#define RC 256
#define NCH (SEQ / RC)
#define RMS_EPS 1e-6f
#define LNX_EPS 64e-5f

#define O_Y_P 0L
#define O_Y_S (O_Y_P + (long)MP * D_MODEL)
#define O_KV_P (O_Y_S + (long)MS * D_MODEL)
#define O_KV_S (O_KV_P + (long)MP * 512)
#define O_WIN_P (O_KV_S + (long)MS * 512)
#define O_WIN_S (O_WIN_P + (long)BATCH * WP * 256)
#define O_RS_P (O_WIN_S + (long)DEC_BATCH * WBUF * 256)
#define O_RS_S (O_RS_P + (long)BATCH * 8 * 4096)
#define O_SH_P (O_RS_S + (long)DEC_BATCH * 8 * 4096)
#define O_SH_S (O_SH_P + (long)BATCH * RWKV_COLS)
#define O_MKV (O_SH_S + (long)DEC_BATCH * RWKV_COLS)
#define O_TOTAL (O_MKV + (long)MEMROWS * 1024)

enum {
    I_X_PROMPT = 0, I_X_SAMPLE, I_CACHE_KV, I_CACHE_WIN, I_STATE_S, I_STATE_SHIFT, I_CACHE_MEM, I_PAGE_TABLE, I_MEM_PROMPT,
    I_G_FFN1, I_W_FFN1_GU, I_W_FFN1_DOWN, I_G_MIX, I_W_IN, I_W_OUT, I_Q_G, I_KC_G, I_KS_G, I_KW_G, I_GATE_B, I_PE_K, I_PE_V,
    I_W_CK1, I_W_CK2, I_W_CV1, I_W_CV2, I_MU, I_W0, I_W_DECAY2, I_A0, I_W_ICLR2, I_W_GATE2, I_K_K, I_K_A, I_R_K, I_LNX_G, I_LNX_B,
    I_G_X, I_G_MEM, I_W_XQ, I_W_XKV, I_XQ_G, I_XK_G, I_W_XO, I_G_FFN2, I_W_FFN2_GU, I_W_FFN2_DOWN, I_G_OUT, N_INPUTS
};

struct Params {
    const float* in[N_INPUTS];
    float* out;
    float *X0, *X1, *X2, *X3, *X4, *H, *P, *QN, *KVW, *GT, *KCP, *VCP, *KCS, *VCS, *CH, *PC, *OC, *SC, *RWB, *GG, *RO, *MIX, *XQ,
        *OX, *LIN, *RS0, *RS1, *RS2, *RS3, *RS4, *RSM;
    int* IDX;
    unsigned* bar;
    unsigned short *X0b, *Hb, *X1b, *X2b, *X3b, *MIXb, *OXb, *MEMb;
    unsigned short *Wgu1, *Wd1, *Wgu2, *Wd2, *Win, *Wout, *Wxq, *Wxo, *Wxkv;
    unsigned short *QNb, *KSb, *KWb, *VSt, *VWt, *KCb, *VCt, *VSb, *VWb;
    unsigned short* RWH;
    unsigned short *XQb, *DWb, *GGb; float* BON;
    float* KC32; unsigned short* PRb;
    float *RPC, *RLC, *RSS, *RHO;
    unsigned short *XKb, *XVb, *XKSb, *XVSb;
    unsigned short *ACK, *ACV, *WC1; float* PEB;
    float* DWAG; unsigned short *LINb, *Wlora;
};
HD unsigned short f2bf(float f) {
    unsigned u;
#ifndef HOST_TEST
    u = __float_as_uint(f);
#else
    memcpy(&u, &f, 4);
#endif
    u += 0x7FFFu + ((u >> 16) & 1u);
    return (unsigned short)(u >> 16);
}
HD float rs_of(float ss, int K) { return 1.f / sqrtf(ss / (float)K + RMS_EPS); }

struct f4 { float x, y, z, w; };
HD f4 ld4(const float* p) {
#ifndef HOST_TEST
    float4 v = *(const float4*)p; f4 r; r.x = v.x; r.y = v.y; r.z = v.z; r.w = v.w; return r;
#else
    f4 r; r.x = p[0]; r.y = p[1]; r.z = p[2]; r.w = p[3]; return r;
#endif
}
HD void st4(float* p, f4 v) {
#ifndef HOST_TEST
    *(float4*)p = make_float4(v.x, v.y, v.z, v.w);
#else
    p[0] = v.x; p[1] = v.y; p[2] = v.z; p[3] = v.w;
#endif
}
HD float sigmoidf_(float x) { return 1.f / (1.f + expf(-x)); }
HD float siluf_(float x) { return x / (1.f + expf(-x)); }
HD float geluf_(float x) { return 0.5f * x * (1.f + tanhf(0.7978845608028654f * (x + 0.044715f * x * x * x))); }
HD float softplusf_(float x) { return (x > 20.f) ? x : log1pf(expf(x)); }

HD bool tok_sample(long m) { return m >= MP; }
HD int tok_seq(long m) { return m < MP ? (int)(m / SEQ) : (int)((m - MP) / DEC_SEQ); }
HD int tok_i(long m) { return m < MP ? (int)(m % SEQ) : (int)((m - MP) % DEC_SEQ); }
HD int tok_pos(long m) { return m < MP ? (int)(m % SEQ) : PAST_LEN + (int)((m - MP) % DEC_SEQ); }

HD void u_copyx(const Params& p, long u) {
    long m = u / (D_MODEL / 4); int k = (int)(u % (D_MODEL / 4)) * 4;
    const float* src = m < MP ? p.in[I_X_PROMPT] + m * D_MODEL : p.in[I_X_SAMPLE] + (m - MP) * D_MODEL;
    f4 v = ld4(src + k);
    st4(p.X0 + m * D_MODEL + k, v);
    unsigned short* b = p.X0b + m * D_MODEL + k;
    b[0] = f2bf(v.x); b[1] = f2bf(v.y); b[2] = f2bf(v.z); b[3] = f2bf(v.w);
}
HD void u_rowstat(const float* x, int K, float* ss_out, long m) {
    const float* r = x + m * K; float ss = 0.f;
    for (int k = 0; k < K; k += 4) { f4 v = ld4(r + k); ss += v.x * v.x + v.y * v.y + v.z * v.z + v.w * v.w; }
    ss_out[m] = ss;
}
HD void u_wconv(const float* W, int ldw, const float* g, unsigned short* Bt, int K, int nrows, bool gu, long u, int nvalid = 1 << 30) {
    int n = (int)(u % nrows); int k = (int)(u / nrows) * 2;
    int sc = n;
    if (gu) { int pn = n / 256, bj = (n % 256) / 128, r = n % 128; sc = bj * D_FF + pn * 128 + r; }
    float a = 0.f, b = 0.f;
    if (sc < nvalid) { a = W[(long)k * ldw + sc]; b = W[(long)(k + 1) * ldw + sc]; }
    if (g) { a *= g[k]; b *= g[k + 1]; }
    Bt[(long)n * K + k] = f2bf(a); Bt[(long)n * K + k + 1] = f2bf(b);
}
HD void u_cvt4(const float* src, unsigned short* dst, long u) {
    f4 v = ld4(src + u * 4); unsigned short* b = dst + u * 4;
    b[0] = f2bf(v.x); b[1] = f2bf(v.y); b[2] = f2bf(v.z); b[3] = f2bf(v.w);
}

template <class Epi>
HD void gemm_unit(const float* A, int lda, const float* gk, const float* W, int ldw, int K, int Nc, long u, Epi epi, long row_base = 0,
                  int col_base = 0) {
    int ncg = Nc / 4; long rg = u / ncg; int cg = (int)(u % ncg);
    long m0 = row_base + rg * 4; int n0 = col_base + cg * 4;
    float acc[4][4];
#pragma unroll
    for (int i = 0; i < 4; ++i)
#pragma unroll
        for (int j = 0; j < 4; ++j) acc[i][j] = 0.f;
    for (int k = 0; k < K; k += 4) {
        f4 a[4];
#pragma unroll
        for (int i = 0; i < 4; ++i) a[i] = ld4(A + (m0 + i) * lda + k);
        if (gk) {
            f4 g = ld4(gk + k);
#pragma unroll
            for (int i = 0; i < 4; ++i) { a[i].x *= g.x; a[i].y *= g.y; a[i].z *= g.z; a[i].w *= g.w; }
        }
        f4 w0 = ld4(W + (long)(k + 0) * ldw + n0), w1 = ld4(W + (long)(k + 1) * ldw + n0), w2 = ld4(W + (long)(k + 2) * ldw + n0),
           w3 = ld4(W + (long)(k + 3) * ldw + n0);
#pragma unroll
        for (int i = 0; i < 4; ++i) {
            acc[i][0] += a[i].x * w0.x + a[i].y * w1.x + a[i].z * w2.x + a[i].w * w3.x;
            acc[i][1] += a[i].x * w0.y + a[i].y * w1.y + a[i].z * w2.y + a[i].w * w3.y;
            acc[i][2] += a[i].x * w0.z + a[i].y * w1.z + a[i].z * w2.z + a[i].w * w3.z;
            acc[i][3] += a[i].x * w0.w + a[i].y * w1.w + a[i].z * w2.w + a[i].w * w3.w;
        }
    }
#pragma unroll
    for (int i = 0; i < 4; ++i) epi(m0 + i, n0, acc[i]);
}
struct EpiScaleStore {
    float* C; int ldc; const float* ss; int K;
    HD void operator()(long m, int n0, const float* a) const {
        float s = rs_of(ss[m], K); f4 v; v.x = a[0] * s; v.y = a[1] * s; v.z = a[2] * s; v.w = a[3] * s; st4(C + m * ldc + n0, v);
    }
};
struct EpiResidual {
    float* C; const float* R; int ldc; float alpha; unsigned short* Cb;
    HD void operator()(long m, int n0, const float* a) const {
        f4 r = ld4(R + m * ldc + n0); r.x += alpha * a[0]; r.y += alpha * a[1]; r.z += alpha * a[2]; r.w += alpha * a[3];
        st4(C + m * ldc + n0, r);
        unsigned short* b = Cb + m * ldc + n0; b[0] = f2bf(r.x); b[1] = f2bf(r.y); b[2] = f2bf(r.z); b[3] = f2bf(r.w);
    }
};
HD void u_gu(const float* A, const float* gk, const float* W, const float* ssq, float* H, long u, long row_base = 0) {
    int ncg = D_FF / 4; long rg = u / ncg; int cg = (int)(u % ncg);
    long m0 = row_base + rg * 4; int n0 = cg * 4;
    float ag[4][4], au[4][4];
#pragma unroll
    for (int i = 0; i < 4; ++i)
#pragma unroll
        for (int j = 0; j < 4; ++j) { ag[i][j] = 0.f; au[i][j] = 0.f; }
    for (int k = 0; k < D_MODEL; ++k) {
        float g = gk[k];
        f4 wg = ld4(W + (long)k * (2 * D_FF) + n0), wu = ld4(W + (long)k * (2 * D_FF) + D_FF + n0);
#pragma unroll
        for (int i = 0; i < 4; ++i) {
            float a = A[(m0 + i) * D_MODEL + k] * g;
            ag[i][0] += a * wg.x; ag[i][1] += a * wg.y; ag[i][2] += a * wg.z; ag[i][3] += a * wg.w;
            au[i][0] += a * wu.x; au[i][1] += a * wu.y; au[i][2] += a * wu.z; au[i][3] += a * wu.w;
        }
    }
#pragma unroll
    for (int i = 0; i < 4; ++i) {
        float s = rs_of(ssq[m0 + i], D_MODEL); f4 v;
        v.x = siluf_(ag[i][0] * s) * (au[i][0] * s); v.y = siluf_(ag[i][1] * s) * (au[i][1] * s);
        v.z = siluf_(ag[i][2] * s) * (au[i][2] * s); v.w = siluf_(ag[i][3] * s) * (au[i][3] * s);
        st4(H + (m0 + i) * D_FF + n0, v);
    }
}

HD void u_nsa_post(const Params& p, long m) {
    const float* row = p.P + m * IN_COLS;
    const float* qg = p.in[I_Q_G]; const float* ksg = p.in[I_KS_G]; const float* kwg = p.in[I_KW_G];
    for (int h = 0; h < 8; ++h) {
        float ss = 0.f;
        for (int d = 0; d < 64; ++d) { float v = row[h * 64 + d]; ss += v * v; }
        float r = 1.f / sqrtf(ss / 64.f + RMS_EPS);
        for (int d = 0; d < 64; ++d) p.QN[m * 512 + h * 64 + d] = row[h * 64 + d] * r * qg[d];
    }
    float* kv = p.KVW + m * 768;
    for (int c = 0; c < 6; ++c)
        for (int g = 0; g < 2; ++g) {
            const float* s = row + 512 + c * 128 + g * 64;
            if (c == 2 || c == 4) {
                const float* gg = (c == 2) ? ksg : kwg;
                float ss = 0.f;
                for (int d = 0; d < 64; ++d) ss += s[d] * s[d];
                float r = 1.f / sqrtf(ss / 64.f + RMS_EPS);
                for (int d = 0; d < 64; ++d) kv[c * 128 + g * 64 + d] = s[d] * r * gg[d];
            } else {
                for (int d = 0; d < 64; ++d) kv[c * 128 + g * 64 + d] = s[d];
            }
        }
    for (int j = 0; j < 24; ++j) p.GT[m * 24 + j] = sigmoidf_(row[1280 + j] + p.in[I_GATE_B][j]);
    int n = tok_seq(m), i = tok_i(m);
    if (!tok_sample(m)) {
        for (int c = 0; c < 512; ++c) p.QNb[m * 512 + c] = f2bf(p.QN[m * 512 + c] * 0.125f);
        for (int g = 0; g < 2; ++g)
            for (int d = 0; d < 64; ++d) {
                long kr = (((long)n * 2 + g) * SEQ + i) * 64 + d, vt = (((long)n * 2 + g) * 64 + d) * SEQ + i;
                p.KSb[kr] = f2bf(kv[256 + g * 64 + d]); p.VSt[vt] = f2bf(kv[384 + g * 64 + d]);
                p.KWb[kr] = f2bf(kv[512 + g * 64 + d]); p.VWt[vt] = f2bf(kv[640 + g * 64 + d]);
            }
        for (int c = 0; c < 512; ++c) p.out[O_KV_P + m * 512 + c] = kv[c];
        if (i >= SEQ - WP) {
            long j = i - (SEQ - WP);
            for (int c = 0; c < 256; ++c) p.out[O_WIN_P + ((long)n * WP + j) * 256 + c] = kv[512 + c];
        }
        if (i == SEQ - 1)
            for (int c = 0; c < RWKV_COLS; ++c) p.out[O_SH_P + (long)n * RWKV_COLS + c] = row[NSA_COLS + c];
    } else {
        for (int c = 0; c < 512; ++c) p.out[O_KV_S + (m - MP) * 512 + c] = kv[c];
        long j = WBUF - DEC_SEQ + i;
        for (int c = 0; c < 256; ++c) p.out[O_WIN_S + ((long)n * WBUF + j) * 256 + c] = kv[512 + c];
        if (i == DEC_SEQ - 1)
            for (int c = 0; c < RWKV_COLS; ++c) p.out[O_SH_S + (long)n * RWKV_COLS + c] = row[NSA_COLS + c];
    }
}
HD void u_wincopy(const Params& p, long u) {
    long n = u / ((WBUF - DEC_SEQ) * 64L); long r = u % ((WBUF - DEC_SEQ) * 64L);
    long j = r / 64; int c4 = (int)(r % 64) * 4;
    st4(p.out + O_WIN_S + (n * WBUF + j) * 256 + c4, ld4(p.in[I_CACHE_WIN] + (n * WBUF + j + DEC_SEQ) * 256 + c4));
}

#define N_CBLK (BATCH * NBP + DEC_BATCH * NBS)
#define N_CROWS (((N_CBLK * 2 + 255) / 256) * 256)
HD const float* cmp_row(const Params& p, long bu, int j, int c, int g) {
    if (bu < (long)BATCH * NBP) {
        long n = bu / NBP, b = bu % NBP;
        return p.KVW + (n * SEQ + b * 64 + j) * 768 + c * 128 + g * 64;
    }
    bu -= (long)BATCH * NBP;
    long n = bu / NBS, b = bu % NBS;
    long phys = ((const int*)p.in[I_PAGE_TABLE])[n * NPAGES + b / BPP];
    long prow = (b % BPP) * 64 + j;
    return p.in[I_CACHE_KV] + (((phys * PAGE_SIZE + prow) * 4 + c) * 2 + g) * 64;
}
HD void u_cmp_hidden(const Params& p, long u) {
    int hc = (int)(u % 128); long r = u / 128;
    int c = (int)(r % 2); r /= 2; int g = (int)(r % 2); long bu = r / 2;
    const float* pe = c == 0 ? p.in[I_PE_K] : p.in[I_PE_V];
    const float* w1 = c == 0 ? p.in[I_W_CK1] : p.in[I_W_CV1];
    float acc = 0.f;
    for (int j = 0; j < 64; ++j) {
        const float* row = cmp_row(p, bu, j, c, g);
        for (int d = 0; d < 64; ++d) acc += (row[d] + pe[j * 64 + d]) * w1[(long)(j * 64 + d) * 128 + hc];
    }
    p.CH[((bu * 2 + g) * 2 + c) * 128 + hc] = geluf_(acc);
}

HD float bf2f(unsigned short b) {
    unsigned u = ((unsigned)b) << 16; float f;
#ifndef HOST_TEST
    f = __uint_as_float(u);
#else
    memcpy(&f, &u, 4);
#endif
    return f;
}
HD void u_cmp_gather(const Params& p, long u) {
    int q = (int)(u % 16); long r = u / 16; int j = (int)(r % 64); r /= 64; int c = (int)(r % 2); long R = r / 2;
    unsigned short* dst = (c == 0 ? p.ACK : p.ACV) + R * 4096 + j * 64 + q * 4;
    if (R >= (long)N_CBLK * 2) { dst[0] = 0; dst[1] = 0; dst[2] = 0; dst[3] = 0; return; }
    const float* row = cmp_row(p, R / 2, j, c, (int)(R % 2));
    f4 v = ld4(row + q * 4);
    dst[0] = f2bf(v.x); dst[1] = f2bf(v.y); dst[2] = f2bf(v.z); dst[3] = f2bf(v.w);
}
HD void u_pebias(const Params& p, long u) {
    int c = (int)(u / 128), h = (int)(u % 128);
    const float* pe = c == 0 ? p.in[I_PE_K] : p.in[I_PE_V];
    const float* w1 = c == 0 ? p.in[I_W_CK1] : p.in[I_W_CV1];
    float acc = 0.f;
    for (int k = 0; k < 4096; ++k) acc += pe[k] * w1[(long)k * 128 + h];
    p.PEB[u] = acc;
}
HD void u_cmp_hidden2(const Params& p, long u) {
    int hc = (int)(u % 128); long r = u / 128; int c = (int)(r % 2); long R = r / 2;
    const unsigned short* a = (c == 0 ? p.ACK : p.ACV) + R * 4096;
    const float* w1 = c == 0 ? p.in[I_W_CK1] : p.in[I_W_CV1];
    float acc = p.PEB[c * 128 + hc];
    for (int k = 0; k < 4096; ++k) acc += bf2f(a[k]) * w1[(long)k * 128 + hc];
    p.CH[(R * 2 + c) * 128 + hc] = geluf_(acc);
}
HD void u_cmp_out(const Params& p, long u) {
    int c = (int)(u % 2); long r = u / 2; int g = (int)(r % 2); long bu = r / 2;
    const float* w2 = c == 0 ? p.in[I_W_CK2] : p.in[I_W_CV2];
    const float* h = p.CH + ((bu * 2 + g) * 2 + c) * 128;
    float o[64];
#pragma unroll
    for (int d = 0; d < 64; ++d) o[d] = 0.f;
    for (int k = 0; k < 128; ++k) {
        float hv = h[k];
#pragma unroll
        for (int d = 0; d < 64; ++d) o[d] += hv * w2[k * 64 + d];
    }
    float* dst;
    if (bu < (long)BATCH * NBP) dst = (c == 0 ? p.KCP : p.VCP) + (bu * 2 + g) * 64;
    else dst = (c == 0 ? p.KCS : p.VCS) + ((bu - (long)BATCH * NBP) * 2 + g) * 64;
    bool prm = bu < (long)BATCH * NBP; long nn = bu / NBP, bb = bu % NBP;
    if (c == 0) {
        float ss = 0.f;
#pragma unroll
        for (int d = 0; d < 64; ++d) ss += o[d] * o[d];
        float rr = 1.f / sqrtf(ss / 64.f + RMS_EPS);
#pragma unroll
        for (int d = 0; d < 64; ++d) {
            float v = o[d] * rr * p.in[I_KC_G][d]; dst[d] = v;
            if (prm) p.KCb[((nn * 2 + g) * NBP + bb) * 64 + d] = f2bf(v);
        }
    } else {
#pragma unroll
        for (int d = 0; d < 64; ++d) {
            dst[d] = o[d];
            if (prm) p.VCt[((nn * 2 + g) * 64 + d) * NBP + bb] = f2bf(o[d]);
        }
    }
}
HD void u_cmp_attn(const Params& p, long u) {
    long m = u / 8; int h = (int)(u % 8); int g = h / 4;
    int n = tok_seq(m), t = tok_pos(m);
    bool smp = tok_sample(m);
    int nbtot = smp ? NBS + 1 : NBP;
    int nvalid = smp ? NBS : (t + 1) / 64;
    const float* kc = smp ? p.KCS + (long)n * NBS * 128 : p.KCP + (long)n * NBP * 128;
    const float* vc = smp ? p.VCS + (long)n * NBS * 128 : p.VCP + (long)n * NBP * 128;
    float slope = exp2f(-(float)(h + 1));
    float q[64];
#pragma unroll
    for (int d = 0; d < 64; ++d) q[d] = p.QN[m * 512 + h * 64 + d];
    float* pc = p.PC + (m * 8 + h) * NBMAX;
    float mx = -INFINITY;
    for (int b = 0; b < nvalid; ++b) {
        const float* k = kc + (b * 2 + g) * 64;
        float s = 0.f;
#pragma unroll
        for (int d = 0; d < 64; ++d) s += q[d] * k[d];
        s = s * 0.125f - slope * (float)(t - ((b + 1) * 64 - 1));
        pc[b] = s; mx = fmaxf(mx, s);
    }
    float acc[64];
#pragma unroll
    for (int d = 0; d < 64; ++d) acc[d] = 0.f;
    float l = 0.f;
    for (int b = 0; b < nvalid; ++b) {
        float e = expf(pc[b] - mx); l += e; pc[b] = e;
        const float* v = vc + (b * 2 + g) * 64;
#pragma unroll
        for (int d = 0; d < 64; ++d) acc[d] += e * v[d];
    }
    float inv = nvalid > 0 ? 1.f / l : 0.f;
    for (int b = 0; b < nvalid; ++b) pc[b] *= inv;
    for (int b = nvalid; b < nbtot; ++b) pc[b] = 0.f;
#pragma unroll
    for (int d = 0; d < 64; ++d) p.OC[m * 512 + h * 64 + d] = acc[d] * inv;
}
HD void u_select(const Params& p, long u) {
    long m = u / 2; int g = (int)(u % 2);
    int t = tok_pos(m); bool smp = tok_sample(m);
    int nb = smp ? NBS + 1 : NBP;
    int cur = t / 64;
    float* sc = p.SC + (m * 2 + g) * NBMAX;
    for (int b = 0; b < nb; ++b) {
        bool forced = (b == 0) || (b == cur) || (b == cur - 1);
        float v;
        if (forced) v = 1e9f;
        else if (b <= cur) { v = 0.f; for (int r = 0; r < 4; ++r) v += p.PC[(m * 8 + g * 4 + r) * NBMAX + b]; }
        else v = -1e9f;
        sc[b] = v;
    }
    int K = N_SEL < nb ? N_SEL : nb;
    for (int k = 0; k < K; ++k) {
        int best = 0; float bv = sc[0];
        for (int b = 1; b < nb; ++b) { float v = sc[b]; if (v > bv) { bv = v; best = b; } }
        p.IDX[(m * 2 + g) * N_SEL + k] = best; sc[best] = -3e38f;
    }
    for (int k = K; k < N_SEL; ++k) p.IDX[(m * 2 + g) * N_SEL + k] = -1;
}
#define ONLINE_STEP(sval, vptr)                                                            \
    {                                                                                      \
        float s_ = (sval);                                                                 \
        if (s_ > mx) {                                                                     \
            float sc_ = expf(mx - s_); l = l * sc_ + 1.f; mx = s_;                         \
            _Pragma("unroll") for (int d = 0; d < 64; ++d) acc[d] = acc[d] * sc_ + (vptr)[d]; \
        } else {                                                                           \
            float e_ = expf(s_ - mx); l += e_;                                             \
            _Pragma("unroll") for (int d = 0; d < 64; ++d) acc[d] += e_ * (vptr)[d];       \
        }                                                                                  \
    }
HD void u_selwin(const Params& p, long u) {
    long m = u / 8; int h = (int)(u % 8); int g = h / 4;
    int n = tok_seq(m), t = tok_pos(m); bool smp = tok_sample(m);
    float slope = exp2f(-(float)(h + 1));
    float q[64], acc[64];
#pragma unroll
    for (int d = 0; d < 64; ++d) { q[d] = p.QN[m * 512 + h * 64 + d]; acc[d] = 0.f; }
    float g0 = p.GT[m * 24 + h * 3 + 0], g1 = p.GT[m * 24 + h * 3 + 1], g2 = p.GT[m * 24 + h * 3 + 2];
    float mx = -INFINITY, l = 0.f;
    const int* pt = (const int*)p.in[I_PAGE_TABLE];
    for (int k = 0; k < N_SEL; ++k) {
        int blk = p.IDX[(m * 2 + g) * N_SEL + k];
        if (blk < 0) continue;
        for (int s = 0; s < 64; ++s) {
            int pos = blk * 64 + s;
            if (pos > t) break;
            const float *kp, *vp;
            if (!smp) {
                const float* r = p.KVW + ((long)n * SEQ + pos) * 768; kp = r + 256 + g * 64; vp = r + 384 + g * 64;
            } else if (blk >= NBS) {
                const float* r = p.KVW + ((long)MP + (long)n * DEC_SEQ + (pos - PAST_LEN)) * 768; kp = r + 256 + g * 64; vp = r + 384 + g * 64;
            } else {
                long phys = pt[n * NPAGES + blk / BPP]; long prow = (blk % BPP) * 64 + s;
                const float* r = p.in[I_CACHE_KV] + (phys * PAGE_SIZE + prow) * 512; kp = r + (2 * 2 + g) * 64; vp = r + (3 * 2 + g) * 64;
            }
            float sv = 0.f;
#pragma unroll
            for (int d = 0; d < 64; ++d) sv += q[d] * kp[d];
            sv = sv * 0.125f - slope * (float)(t - pos);
            ONLINE_STEP(sv, vp)
        }
    }
    {
        float inv = l > 0.f ? 1.f / l : 0.f;
#pragma unroll
        for (int d = 0; d < 64; ++d) { p.MIX[m * MIX_W + h * 64 + d] = g0 * p.OC[m * 512 + h * 64 + d] + g1 * acc[d] * inv; acc[d] = 0.f; }
    }
    mx = -INFINITY; l = 0.f;
    int lo = t - WINDOW + 1;
    if (!smp) { if (lo < 0) lo = 0; } else { if (lo < PAST_LEN - WBUF) lo = PAST_LEN - WBUF; }
    for (int pos = lo; pos <= t; ++pos) {
        const float *kp, *vp;
        if (!smp) {
            const float* r = p.KVW + ((long)n * SEQ + pos) * 768; kp = r + 512 + g * 64; vp = r + 640 + g * 64;
        } else if (pos >= PAST_LEN) {
            const float* r = p.KVW + ((long)MP + (long)n * DEC_SEQ + (pos - PAST_LEN)) * 768; kp = r + 512 + g * 64; vp = r + 640 + g * 64;
        } else {
            const float* r = p.in[I_CACHE_WIN] + ((long)n * WBUF + (pos - (PAST_LEN - WBUF))) * 256; kp = r + g * 64; vp = r + 128 + g * 64;
        }
        float sv = 0.f;
#pragma unroll
        for (int d = 0; d < 64; ++d) sv += q[d] * kp[d];
        sv = sv * 0.125f - slope * (float)(t - pos);
        ONLINE_STEP(sv, vp)
    }
    float inv = l > 0.f ? 1.f / l : 0.f;
#pragma unroll
    for (int d = 0; d < 64; ++d) {
        float o = p.MIX[m * MIX_W + h * 64 + d] + g2 * acc[d] * inv;
        p.MIX[m * MIX_W + h * 64 + d] = o; p.MIXb[m * MIX_W + h * 64 + d] = f2bf(o);
    }
}

HD float rwkv_xs(const Params& p, long m, int c) {
    float cur = p.P[m * IN_COLS + NSA_COLS + c];
    int i = tok_i(m); float prev;
    if (i > 0) prev = p.P[(m - 1) * IN_COLS + NSA_COLS + c];
    else prev = tok_sample(m) ? p.in[I_STATE_SHIFT][(long)tok_seq(m) * RWKV_COLS + c] : 0.f;
    return cur + (prev - cur) * p.in[I_MU][c];
}
HD void u_lora_in(const Params& p, long u) {
    long m = u / 256; int j = (int)(u % 256);
    float x = rwkv_xs(p, m, 1536 + j);
    float v = (j < 64) ? tanhf(x) : (j < 128 ? x : sigmoidf_(x));
    p.LIN[m * 256 + j] = v; p.LINb[m * 256 + j] = f2bf(v);
}
HD void u_rwkv_prep(const Params& p, long u) {
    long m = u / 8; int h = (int)(u % 8);
    const float* lin = p.LIN + m * 256;
    float* rb = p.RWB + m * 6 * 512;
    float ss = 0.f;
    for (int d = 0; d < 64; ++d) {
        int c = h * 64 + d;
        float dw = p.in[I_W0][c], da = p.in[I_A0][c], dg = 0.f;
        for (int j = 0; j < 64; ++j) { dw += lin[j] * p.in[I_W_DECAY2][j * 512 + c]; da += lin[64 + j] * p.in[I_W_ICLR2][j * 512 + c]; }
        for (int j = 0; j < 128; ++j) dg += lin[128 + j] * p.in[I_W_GATE2][j * 512 + c];
        float wlog = -softplusf_(-dw) - 0.5f;
        float decay = expf(-expf(wlog));
        float a = sigmoidf_(da);
        float r = rwkv_xs(p, m, c), k = rwkv_xs(p, m, 512 + c), v = rwkv_xs(p, m, 1024 + c);
        float kkr = k * p.in[I_K_K][c];
        float kh = k * (1.f + (a - 1.f) * p.in[I_K_A][c]);
        ss += kkr * kkr;
        rb[0 * 512 + c] = r; rb[1 * 512 + c] = kh; rb[2 * 512 + c] = v; rb[3 * 512 + c] = kkr; rb[4 * 512 + c] = a; rb[5 * 512 + c] = decay;
        p.GG[m * 512 + c] = dg;
    }
    float inv = 1.f / sqrtf(fmaxf(ss, 1e-24f));
    for (int d = 0; d < 64; ++d) {
        int c = h * 64 + d;
        float kk = rb[3 * 512 + c] * inv; float a = rb[4 * 512 + c];
        rb[3 * 512 + c] = kk; rb[4 * 512 + c] = kk * a;
    }
}

HD void u_wconv_lora(const Params& p, long u) {
    int n = (int)(u % 1536); int k = (int)(u / 1536) * 2;
    float a = 0.f, b = 0.f;
    if (n < 512) { if (k < 64) { a = p.in[I_W_DECAY2][k * 512 + n]; b = p.in[I_W_DECAY2][(k + 1) * 512 + n]; } }
    else if (n < 1024) { if (k >= 64 && k < 128) { a = p.in[I_W_ICLR2][(k - 64) * 512 + n - 512]; b = p.in[I_W_ICLR2][(k - 63) * 512 + n - 512]; } }
    else { if (k >= 128) { a = p.in[I_W_GATE2][(k - 128) * 512 + n - 1024]; b = p.in[I_W_GATE2][(k - 127) * 512 + n - 1024]; } }
    p.Wlora[(long)n * 256 + k] = f2bf(a); p.Wlora[(long)n * 256 + k + 1] = f2bf(b);
}
struct EpiStoreOff {
    float* C; int ldc; int coff;
    HD void operator()(long m, int n0, const float* a) const { f4 v; v.x = a[0]; v.y = a[1]; v.z = a[2]; v.w = a[3]; st4(C + m * ldc + coff + n0, v); }
};
HD void u_rwkv_prep2(const Params& p, long u) {
    long m = u / 8; int h = (int)(u % 8);
    const float* dq = p.DWAG + m * 1536;
    float* rb = p.RWB + m * 6 * 512;
    float ss = 0.f;
    for (int d = 0; d < 64; ++d) {
        int c = h * 64 + d;
        float dw = p.in[I_W0][c] + dq[c], da = p.in[I_A0][c] + dq[512 + c], dg = dq[1024 + c];
        float wlog = -softplusf_(-dw) - 0.5f;
        float decay = expf(-expf(wlog));
        float a = sigmoidf_(da);
        float r = rwkv_xs(p, m, c), k = rwkv_xs(p, m, 512 + c), v = rwkv_xs(p, m, 1024 + c);
        float kkr = k * p.in[I_K_K][c];
        float kh = k * (1.f + (a - 1.f) * p.in[I_K_A][c]);
        ss += kkr * kkr;
        rb[0 * 512 + c] = r; rb[1 * 512 + c] = kh; rb[2 * 512 + c] = v; rb[3 * 512 + c] = kkr; rb[4 * 512 + c] = a; rb[5 * 512 + c] = decay;
        p.GG[m * 512 + c] = dg;
    }
    float inv = 1.f / sqrtf(fmaxf(ss, 1e-24f));
    for (int d = 0; d < 64; ++d) {
        int c = h * 64 + d;
        float kk = rb[3 * 512 + c] * inv; float a = rb[4 * 512 + c];
        rb[3 * 512 + c] = kk; rb[4 * 512 + c] = kk * a;
    }
}
HD void u_rwkv_scan(const Params& p, long u) {
    int i = (int)(u % 64); long r = u / 64; int h = (int)(r % 8); int sq = (int)(r / 8);
    bool smp = sq >= BATCH; int n = smp ? sq - BATCH : sq;
    int T = smp ? DEC_SEQ : SEQ;
    long m0 = smp ? (long)MP + (long)n * DEC_SEQ : (long)n * SEQ;
    float S[64];
    if (smp) {
        const float* s0 = p.in[I_STATE_S] + (((long)n * 8 + h) * 64 + i) * 64;
#pragma unroll
        for (int j = 0; j < 64; ++j) S[j] = s0[j];
    } else {
#pragma unroll
        for (int j = 0; j < 64; ++j) S[j] = 0.f;
    }
    for (int t = 0; t < T; ++t) {
        const float* rb = p.RWB + (m0 + t) * 6 * 512 + h * 64;
        float v = rb[2 * 512 + i];
        float sa = 0.f;
#pragma unroll
        for (int j = 0; j < 64; ++j) sa -= S[j] * rb[3 * 512 + j];
        float o = 0.f;
#pragma unroll
        for (int j = 0; j < 64; ++j) {
            S[j] = S[j] * rb[5 * 512 + j] + sa * rb[4 * 512 + j] + v * rb[1 * 512 + j];
            o += S[j] * rb[0 * 512 + j];
        }
        p.RO[(m0 + t) * 512 + h * 64 + i] = o;
    }
    float* dst = p.out + (smp ? O_RS_S : O_RS_P) + (((long)n * 8 + h) * 64 + i) * 64;
#pragma unroll
    for (int j = 0; j < 64; ++j) dst[j] = S[j];
}

HD void u_rwkv_r1(const Params& p, long u) {
    int i = (int)(u % 64); long r = u / 64; int kind = (int)(r % 2); long ct = r / 2;
    int c = (int)(ct % NCH); long sh = ct / NCH; int h = (int)(sh % 8); int sq = (int)(sh / 8);
    long m0 = (long)sq * SEQ + (long)c * RC;
    float S[64];
#pragma unroll
    for (int j = 0; j < 64; ++j) S[j] = (kind == 1 && j == i) ? 1.f : 0.f;
    for (int t = 0; t < RC; ++t) {
        const float* rb = p.RWB + (m0 + t) * 6 * 512 + h * 64;
        float v = kind == 0 ? rb[2 * 512 + i] : 0.f;
        float sa = 0.f;
#pragma unroll
        for (int j = 0; j < 64; ++j) sa -= S[j] * rb[3 * 512 + j];
        float o = 0.f;
#pragma unroll
        for (int j = 0; j < 64; ++j) { S[j] = S[j] * rb[5 * 512 + j] + sa * rb[4 * 512 + j] + v * rb[1 * 512 + j]; o += S[j] * rb[0 * 512 + j]; }
        (kind == 0 ? p.RO : p.RHO)[(m0 + t) * 512 + h * 64 + i] = o;
    }
    float* dst = (kind == 0 ? p.RLC : p.RPC) + (ct * 64 + i) * 64;
#pragma unroll
    for (int j = 0; j < 64; ++j) dst[j] = S[j];
}
HD void u_rwkv_r2(const Params& p, long u) {
    int i = (int)(u % 64); long sh = u / 64;
    float S[64], T[64];
#pragma unroll
    for (int j = 0; j < 64; ++j) S[j] = 0.f;
    for (int c = 0; c < NCH; ++c) {
        long ct = sh * NCH + c;
        float* ss = p.RSS + (ct * 64 + i) * 64;
#pragma unroll
        for (int j = 0; j < 64; ++j) ss[j] = S[j];
        const float* P = p.RPC + ct * 4096; const float* L = p.RLC + (ct * 64 + i) * 64;
#pragma unroll
        for (int j = 0; j < 64; ++j) T[j] = L[j];
        for (int k = 0; k < 64; ++k) {
            float s = S[k];
#pragma unroll
            for (int j = 0; j < 64; ++j) T[j] += s * P[k * 64 + j];
        }
#pragma unroll
        for (int j = 0; j < 64; ++j) S[j] = T[j];
    }
    float* dst = p.out + O_RS_P + (sh * 64 + i) * 64;
#pragma unroll
    for (int j = 0; j < 64; ++j) dst[j] = S[j];
}
HD void u_rwkv_r3(const Params& p, long u) {
    int i = (int)(u % 64); long ct = u / 64;
    int c = (int)(ct % NCH); long sh = ct / NCH; int h = (int)(sh % 8); int sq = (int)(sh / 8);
    long m0 = (long)sq * SEQ + (long)c * RC;
    const float* ss = p.RSS + (ct * 64 + i) * 64;
    for (int t = 0; t < RC; ++t) {
        const float* rho = p.RHO + (m0 + t) * 512 + h * 64;
        float o = p.RO[(m0 + t) * 512 + h * 64 + i];
        for (int k = 0; k < 64; ++k) o += ss[k] * rho[k];
        p.RO[(m0 + t) * 512 + h * 64 + i] = o;
    }
}
HD void u_rwkv_post(const Params& p, long u) {
    long m = u / 8; int h = (int)(u % 8);
    const float* ro = p.RO + m * 512 + h * 64;
    const float* rb = p.RWB + m * 6 * 512 + h * 64;
    float mean = 0.f;
    for (int i = 0; i < 64; ++i) mean += ro[i];
    mean *= (1.f / 64.f);
    float var = 0.f;
    for (int i = 0; i < 64; ++i) { float d = ro[i] - mean; var += d * d; }
    var *= (1.f / 64.f);
    float rstd = 1.f / sqrtf(var + LNX_EPS);
    float bonus = 0.f;
    for (int j = 0; j < 64; ++j) bonus += rb[0 * 512 + j] * rb[1 * 512 + j] * p.in[I_R_K][h * 64 + j];
    for (int i = 0; i < 64; ++i) {
        int c = h * 64 + i;
        float o = (ro[i] - mean) * rstd * p.in[I_LNX_G][c] + p.in[I_LNX_B][c] + bonus * rb[2 * 512 + i];
        o *= p.GG[m * 512 + c];
        p.MIX[m * MIX_W + 512 + c] = o; p.MIXb[m * MIX_W + 512 + c] = f2bf(o);
    }
}
HD void u_headnorm128(float* base, long rowstride, const float* g, long u) {
    long m = u / 4; int h = (int)(u % 4);
    float* x = base + m * rowstride + h * 128;
    float ss = 0.f;
    for (int d = 0; d < 128; ++d) ss += x[d] * x[d];
    float r = 1.f / sqrtf(ss / 128.f + RMS_EPS);
    for (int d = 0; d < 128; ++d) x[d] = x[d] * r * g[d];
}
HD void u_xattn(const Params& p, long u) {
    int half = (int)(u % 4); long r = u / 4; int h = (int)(r % 4); long m = r / 4;
    int n = tok_seq(m);
    const float* kvb = tok_sample(m) ? p.in[I_CACHE_MEM] + (long)n * N_MEM * 1024 : p.out + O_MKV + (long)n * N_MEM * 1024;
    float acc[32];
    const float* q = p.XQ + m * XW + h * 128;
#pragma unroll
    for (int d = 0; d < 32; ++d) acc[d] = 0.f;
    float mx = -INFINITY, l = 0.f;
    for (int j = 0; j < N_MEM; ++j) {
        const float* kp = kvb + (long)j * 1024 + h * 128;
        const float* vp = kvb + (long)j * 1024 + 512 + h * 128 + half * 32;
        float sv = 0.f;
#pragma unroll
        for (int d = 0; d < 128; ++d) sv += q[d] * kp[d];
        sv *= 0.08838834764831845f;
        if (sv > mx) {
            float sc_ = expf(mx - sv); l = l * sc_ + 1.f; mx = sv;
#pragma unroll
            for (int d = 0; d < 32; ++d) acc[d] = acc[d] * sc_ + vp[d];
        } else {
            float e_ = expf(sv - mx); l += e_;
#pragma unroll
            for (int d = 0; d < 32; ++d) acc[d] += e_ * vp[d];
        }
    }
    float inv = 1.f / l;
#pragma unroll
    for (int d = 0; d < 32; ++d) {
        float o = acc[d] * inv; p.OX[m * XW + h * 128 + half * 32 + d] = o; p.OXb[m * XW + h * 128 + half * 32 + d] = f2bf(o);
    }
}
HD void u_final(const Params& p, long u) {
    long m = u / (D_MODEL / 4); int k = (int)(u % (D_MODEL / 4)) * 4;
    f4 v = ld4(p.X4 + m * D_MODEL + k); f4 g = ld4(p.in[I_G_OUT] + k); float s = rs_of(p.RS4[m], D_MODEL);
    v.x *= s * g.x; v.y *= s * g.y; v.z *= s * g.z; v.w *= s * g.w;
    st4(p.out + (m < MP ? O_Y_P + m * D_MODEL : O_Y_S + (m - MP) * D_MODEL) + k, v);
}

#ifdef HOST_CMP2
#define HOST_CMP_HIDDEN u_cmp_hidden2(p, u)
#else
#define HOST_CMP_HIDDEN u_cmp_hidden(p, u)
#endif
#define GEMM_UNITS(rows, cols) ((long)(rows) / 4 * ((cols) / 4))
#define PHASES(X)                                                                                                              \
    X(copyx, (long)M_TOK * (D_MODEL / 4), u_copyx(p, u))                                                                       \
    X(rs0, (long)M_TOK, u_rowstat(p.X0, D_MODEL, p.RS0, u))                                                                    \
    X(gu1, GEMM_UNITS(M_TOK, D_FF), u_gu(p.X0, p.in[I_G_FFN1], p.in[I_W_FFN1_GU], p.RS0, p.H, u))                               \
    X(down1, GEMM_UNITS(M_TOK, D_MODEL),                                                                                       \
      gemm_unit(p.H, D_FF, (const float*)0, p.in[I_W_FFN1_DOWN], D_MODEL, D_FF, D_MODEL, u, EpiResidual{p.X1, p.X0, D_MODEL, 0.5f, p.X1b})) \
    X(rs1, (long)M_TOK, u_rowstat(p.X1, D_MODEL, p.RS1, u))                                                                    \
    X(win, GEMM_UNITS(M_TOK, IN_COLS),                                                                                         \
      gemm_unit(p.X1, D_MODEL, p.in[I_G_MIX], p.in[I_W_IN], IN_COLS, D_MODEL, IN_COLS, u, EpiScaleStore{p.P, IN_COLS, p.RS1, D_MODEL}))  \
    X(nsa_post, (long)M_TOK, u_nsa_post(p, u))                                                                                 \
    X(wincopy, (long)DEC_BATCH * (WBUF - DEC_SEQ) * 64, u_wincopy(p, u))                                                       \
    X(pebias, 256L, u_pebias(p, u))                                                                                            \
    X(cmp_gather, (long)N_CROWS * 2 * 64 * 16, u_cmp_gather(p, u))                                                             \
    X(cmp_hidden, (long)N_CBLK * 2 * 2 * 128, HOST_CMP_HIDDEN)                                                                 \
    X(cmp_out, (long)N_CBLK * 2 * 2, u_cmp_out(p, u))                                                                          \
    X(cmp_attn, (long)M_TOK * 8, u_cmp_attn(p, u))                                                                             \
    X(select, (long)M_TOK * 2, u_select(p, u))                                                                                 \
    X(selwin, (long)M_TOK * 8, u_selwin(p, u))                                                                                 \
    X(lora_in, (long)M_TOK * 256, u_lora_in(p, u))                                                                             \
    X(lora_d, GEMM_UNITS(M_TOK, 512), gemm_unit(p.LIN, 256, (const float*)0, p.in[I_W_DECAY2], 512, 64, 512, u, EpiStoreOff{p.DWAG, 1536, 0}))  \
    X(lora_a, GEMM_UNITS(M_TOK, 512), gemm_unit(p.LIN + 64, 256, (const float*)0, p.in[I_W_ICLR2], 512, 64, 512, u, EpiStoreOff{p.DWAG, 1536, 512}))  \
    X(lora_g, GEMM_UNITS(M_TOK, 512), gemm_unit(p.LIN + 128, 256, (const float*)0, p.in[I_W_GATE2], 512, 128, 512, u, EpiStoreOff{p.DWAG, 1536, 1024}))  \
    X(rwkv_prep2, (long)M_TOK * 8, u_rwkv_prep2(p, u))                                                                         \
    X(rwkv_r1, (long)BATCH * 8 * NCH * 2 * 64, u_rwkv_r1(p, u))                                                                \
    X(rwkv_r2, (long)BATCH * 8 * 64, u_rwkv_r2(p, u))                                                                          \
    X(rwkv_r3, (long)BATCH * 8 * NCH * 64, u_rwkv_r3(p, u))                                                                    \
    X(rwkv_scan_s, (long)DEC_BATCH * 8 * 64, u_rwkv_scan(p, (long)BATCH * 8 * 64 + u))                                         \
    X(rwkv_post, (long)M_TOK * 8, u_rwkv_post(p, u))                                                                           \
    X(wout, GEMM_UNITS(M_TOK, D_MODEL),                                                                                        \
      gemm_unit(p.MIX, MIX_W, (const float*)0, p.in[I_W_OUT], D_MODEL, MIX_W, D_MODEL, u, EpiResidual{p.X2, p.X1, D_MODEL, 1.0f, p.X2b})) \
    X(rs2, (long)M_TOK, u_rowstat(p.X2, D_MODEL, p.RS2, u))                                                                    \
    X(xq, GEMM_UNITS(M_TOK, XW),                                                                                               \
      gemm_unit(p.X2, D_MODEL, p.in[I_G_X], p.in[I_W_XQ], XW, D_MODEL, XW, u, EpiScaleStore{p.XQ, XW, p.RS2, D_MODEL}))                  \
    X(xq_norm, (long)M_TOK * 4, u_headnorm128(p.XQ, XW, p.in[I_XQ_G], u))                                                      \
    X(rsm, (long)MEMROWS, u_rowstat(p.in[I_MEM_PROMPT], D_MODEL, p.RSM, u))                                                    \
    X(memkv, GEMM_UNITS(MEMROWS, 1024),                                                                                        \
      gemm_unit(p.in[I_MEM_PROMPT], D_MODEL, p.in[I_G_MEM], p.in[I_W_XKV], 1024, D_MODEL, 1024, u,                             \
                EpiScaleStore{p.out + O_MKV, 1024, p.RSM, D_MODEL}))                                                                    \
    X(memk_norm, (long)MEMROWS * 4, u_headnorm128(p.out + O_MKV, 1024, p.in[I_XK_G], u))                                       \
    X(xattn, (long)M_TOK * 4 * 4, u_xattn(p, u))                                                                               \
    X(xo, GEMM_UNITS(M_TOK, D_MODEL),                                                                                          \
      gemm_unit(p.OX, XW, (const float*)0, p.in[I_W_XO], D_MODEL, XW, D_MODEL, u, EpiResidual{p.X3, p.X2, D_MODEL, 1.0f, p.X3b}))      \
    X(rs3, (long)M_TOK, u_rowstat(p.X3, D_MODEL, p.RS3, u))                                                                    \
    X(gu2, GEMM_UNITS(M_TOK, D_FF), u_gu(p.X3, p.in[I_G_FFN2], p.in[I_W_FFN2_GU], p.RS3, p.H, u))                               \
    X(down2, GEMM_UNITS(M_TOK, D_MODEL),                                                                                       \
      gemm_unit(p.H, D_FF, (const float*)0, p.in[I_W_FFN2_DOWN], D_MODEL, D_FF, D_MODEL, u, EpiResidual{p.X4, p.X3, D_MODEL, 0.5f, p.X1b})) \
    X(rs4, (long)M_TOK, u_rowstat(p.X4, D_MODEL, p.RS4, u))                                                                    \
    X(final, (long)M_TOK * (D_MODEL / 4), u_final(p, u))

struct WsAlloc {
    char* base; size_t off;
    float* take(size_t nfloats) { float* r = (float*)(base + off); off += ((nfloats * 4 + 255) / 256) * 256; return r; }
};
static size_t carve(Params& p, void* ws) {
    WsAlloc a{(char*)ws, 0};
    p.bar = (unsigned*)a.take(4096);
    p.X0 = a.take((size_t)M_TOK * D_MODEL); p.X1 = a.take((size_t)M_TOK * D_MODEL); p.X2 = a.take((size_t)M_TOK * D_MODEL);
    p.X3 = a.take((size_t)M_TOK * D_MODEL); p.X4 = a.take((size_t)M_TOK * D_MODEL);
    p.H = a.take((size_t)M_TOK * D_FF); p.P = a.take((size_t)M_TOK * IN_COLS);
    p.QN = a.take((size_t)M_TOK * 512); p.KVW = a.take((size_t)M_TOK * 768); p.GT = a.take((size_t)M_TOK * 24);
    p.KCP = a.take((size_t)BATCH * NBP * 128); p.VCP = a.take((size_t)BATCH * NBP * 128);
    p.KCS = a.take((size_t)DEC_BATCH * NBS * 128); p.VCS = a.take((size_t)DEC_BATCH * NBS * 128);
    p.CH = a.take((size_t)N_CBLK * 4 * 128);
    p.PC = a.take((size_t)M_TOK * 8 * NBMAX); p.OC = a.take((size_t)M_TOK * 512); p.SC = a.take((size_t)M_TOK * 2 * NBMAX);
    p.IDX = (int*)a.take((size_t)M_TOK * 2 * N_SEL);
    p.RWB = a.take((size_t)M_TOK * 6 * 512); p.GG = a.take((size_t)M_TOK * 512); p.RO = a.take((size_t)M_TOK * 512);
    p.MIX = a.take((size_t)M_TOK * MIX_W); p.XQ = a.take((size_t)M_TOK * XW); p.OX = a.take((size_t)M_TOK * XW);
    p.LIN = a.take((size_t)M_TOK * 256);
    p.RS0 = a.take(M_TOK); p.RS1 = a.take(M_TOK); p.RS2 = a.take(M_TOK); p.RS3 = a.take(M_TOK); p.RS4 = a.take(M_TOK);
    p.RSM = a.take(MEMROWS);
    p.X0b = (unsigned short*)a.take((size_t)M_TOK * D_MODEL / 2); p.X1b = (unsigned short*)a.take((size_t)M_TOK * D_MODEL / 2);
    p.X2b = (unsigned short*)a.take((size_t)M_TOK * D_MODEL / 2); p.X3b = (unsigned short*)a.take((size_t)M_TOK * D_MODEL / 2);
    p.Hb = (unsigned short*)a.take((size_t)M_TOK * D_FF / 2); p.MIXb = (unsigned short*)a.take((size_t)M_TOK * MIX_W / 2);
    p.OXb = (unsigned short*)a.take((size_t)M_TOK * XW / 2); p.MEMb = (unsigned short*)a.take((size_t)MEMROWS * D_MODEL / 2);
    p.Wgu1 = (unsigned short*)a.take((size_t)D_MODEL * D_FF); p.Wgu2 = (unsigned short*)a.take((size_t)D_MODEL * D_FF);
    p.Wd1 = (unsigned short*)a.take((size_t)D_MODEL * D_FF / 2); p.Wd2 = (unsigned short*)a.take((size_t)D_MODEL * D_FF / 2);
    p.Win = (unsigned short*)a.take((size_t)D_MODEL * 3104 / 2); p.Wout = (unsigned short*)a.take((size_t)MIX_W * D_MODEL / 2);
    p.Wxq = (unsigned short*)a.take((size_t)D_MODEL * XW / 2); p.Wxo = (unsigned short*)a.take((size_t)XW * D_MODEL / 2);
    p.Wxkv = (unsigned short*)a.take((size_t)D_MODEL * 1024 / 2);
    p.QNb = (unsigned short*)a.take((size_t)M_TOK * 512 / 2);
    p.KSb = (unsigned short*)a.take((size_t)MP * 128 / 2); p.KWb = (unsigned short*)a.take((size_t)MP * 128 / 2);
    p.VSt = (unsigned short*)a.take((size_t)MP * 128 / 2); p.VWt = (unsigned short*)a.take((size_t)MP * 128 / 2);
    p.VSb = (unsigned short*)a.take((size_t)MP * 128 / 2); p.VWb = (unsigned short*)a.take((size_t)MP * 128 / 2);
    p.KCb = (unsigned short*)a.take((size_t)BATCH * NBP * 128 / 2); p.VCt = (unsigned short*)a.take((size_t)BATCH * NBP * 128 / 2);
    p.XKb = (unsigned short*)a.take((size_t)BATCH * N_MEM * 512 / 2); p.XVb = (unsigned short*)a.take((size_t)BATCH * N_MEM * 512 / 2);
    p.XKSb = (unsigned short*)a.take((size_t)DEC_BATCH * N_MEM * 512 / 2); p.XVSb = (unsigned short*)a.take((size_t)DEC_BATCH * N_MEM * 512 / 2);
    p.ACK = (unsigned short*)a.take((size_t)N_CROWS * 4096 / 2); p.ACV = (unsigned short*)a.take((size_t)N_CROWS * 4096 / 2);
    p.WC1 = (unsigned short*)a.take((size_t)256 * 4096 / 2); p.PEB = a.take(256);
    p.DWAG = a.take((size_t)M_TOK * 1536); p.LINb = (unsigned short*)a.take((size_t)M_TOK * 256 / 2); p.Wlora = (unsigned short*)a.take((size_t)1536 * 256 / 2);
    p.RWH = (unsigned short*)a.take((size_t)M_TOK * 3 * 512 / 2);
    p.XQb = (unsigned short*)a.take((size_t)M_TOK * XW / 2); p.DWb = (unsigned short*)a.take((size_t)M_TOK * 1536 / 2); p.GGb = (unsigned short*)a.take((size_t)M_TOK * 512 / 2); p.BON = a.take((size_t)M_TOK * 8);
    p.KC32 = a.take((size_t)MP * 256); p.PRb = (unsigned short*)a.take((size_t)M_TOK * 1792 / 2);
    p.RHO = a.take((size_t)MP * 512);
    p.RPC = a.take((size_t)BATCH * 8 * NCH * 4096); p.RLC = a.take((size_t)BATCH * 8 * NCH * 4096); p.RSS = a.take((size_t)BATCH * 8 * NCH * 4096);
    return a.off;
}

#ifndef HOST_TEST
#define XB_TMO      128
#define XB_XCNT(j)  (256  + 64 * (j))
#define XB_XSUB(j)  (1280 + 64 * (j))
#define XB_XGEN(j)  (2304 + 64 * (j))
#define XB_TOP      3328
#define XB_TOPGEN   3392
#define XCD_BAR_WORDS 3456
#define XB_SPIN_CAP (1u << 28)
#define LAS __attribute__((address_space(3)))
__device__ __forceinline__ unsigned xb_ld(unsigned* p)              { return __hip_atomic_load(p, __ATOMIC_RELAXED, __HIP_MEMORY_SCOPE_AGENT); }
__device__ __forceinline__ unsigned xb_add(unsigned* p, unsigned v) { return __hip_atomic_fetch_add(p, v, __ATOMIC_RELAXED, __HIP_MEMORY_SCOPE_AGENT); }
__device__ __forceinline__ unsigned xb_xcc_id() { return (unsigned)__builtin_amdgcn_s_getreg((3 << 11) | 20) & 0xFu; }
#define XB_SPIN(cond, bar) do { unsigned _sp = 0; while (cond) { __builtin_amdgcn_s_sleep(1); \
    if ((++_sp & 255u) == 0u) { if (xb_ld(&(bar)[XB_TMO])) break; if (_sp > XB_SPIN_CAP) { atomicAdd(&(bar)[XB_TMO], 1u); break; } } } } while (0)
struct XcdBarrier { unsigned* bar; unsigned x; volatile LAS unsigned* st; };
__device__ __forceinline__ XcdBarrier xcd_barrier_post(unsigned* bar, volatile LAS unsigned* st) {
    XcdBarrier b; b.bar = bar; b.x = xb_xcc_id(); b.st = st;
    if (threadIdx.x == 0) (void)xb_add(&bar[XB_XCNT(b.x)], 1u);
    return b;
}
__device__ __forceinline__ void xcd_barrier_complete(unsigned* bar, unsigned x, unsigned& nloc, unsigned& nx) {
    const unsigned G = gridDim.x * gridDim.y * gridDim.z;
    unsigned sum, cnt, mine, sp = 0u;
    for (;;) {
        sum = 0u; cnt = 0u; mine = 0u;
#pragma unroll
        for (unsigned j = 0; j < 16; ++j) { const unsigned c = xb_ld(&bar[XB_XCNT(j)]); sum += c; cnt += (c > 0u) ? 1u : 0u; mine = (j == x) ? c : mine; }
        if (sum == G) break;
        __builtin_amdgcn_s_sleep(1);
        if ((++sp & 255u) == 0u) { if (xb_ld(&bar[XB_TMO])) break; if (sp > XB_SPIN_CAP) { atomicAdd(&bar[XB_TMO], 1u); break; } }
    }
    nloc = mine > 0u ? mine : 1u; nx = cnt > 0u ? cnt : 1u;
}
__device__ __forceinline__ void xcd_barrier(const XcdBarrier& b) {
    asm volatile("s_waitcnt vmcnt(0)" ::: "memory");
    __syncthreads();
    if (threadIdx.x == 0) {
        unsigned* bar = b.bar;
        __builtin_amdgcn_s_waitcnt(0);
        unsigned nloc = b.st[0], nx = b.st[1];
        if (nloc == 0u) { xcd_barrier_complete(bar, b.x, nloc, nx); b.st[0] = nloc; b.st[1] = nx; }
        const unsigned old = xb_add(&bar[XB_XSUB(b.x)], 1u);
        const unsigned gen = old / nloc;
        if (old + 1u == (gen + 1u) * nloc) {
            __builtin_amdgcn_fence(__ATOMIC_RELEASE, "agent");
            asm volatile("s_waitcnt vmcnt(0)" ::: "memory");
            const unsigned og = xb_add(&bar[XB_TOP], 1u);
            const unsigned tg = og / nx;
            if (og + 1u == (tg + 1u) * nx) xb_add(&bar[XB_TOPGEN], 1u);
            else XB_SPIN(xb_ld(&bar[XB_TOPGEN]) == tg, bar);
            __builtin_amdgcn_fence(__ATOMIC_ACQUIRE, "agent");
            xb_add(&bar[XB_XGEN(b.x)], 1u);
            asm volatile("s_waitcnt vmcnt(0)" ::: "memory");
        } else {
            XB_SPIN(xb_ld(&bar[XB_XGEN(b.x)]) == gen, bar);
            __builtin_amdgcn_fence(__ATOMIC_ACQUIRE, "agent");
            asm volatile("s_waitcnt vmcnt(0)" ::: "memory");
        }
    }
    __syncthreads();
}

__device__ __forceinline__ float xhalf_sum(float x) { const unsigned u = __float_as_uint(x); const auto r = __builtin_amdgcn_permlane32_swap(u, u, false, false); return __uint_as_float(r[0]) + __uint_as_float(r[1]); }
__device__ __forceinline__ float xhalf_max(float x) { const unsigned u = __float_as_uint(x); const auto r = __builtin_amdgcn_permlane32_swap(u, u, false, false); return fmaxf(__uint_as_float(r[0]), __uint_as_float(r[1])); }
__device__ __forceinline__ int hp_src(int n) { const int pn = n >> 8, t = n & 255; return (pn << 8) + 64 * ((t & 127) >> 5) + 32 * (t >> 7) + (t & 31); }
__device__ __forceinline__ float fast_sigmoid(float x) { return __builtin_amdgcn_rcpf(1.f + __expf(-x)); }
__device__ __forceinline__ float fast_tanh(float x) { return 1.f - 2.f * __builtin_amdgcn_rcpf(1.f + __expf(2.f * x)); }
__device__ __forceinline__ int opaque_tid() { int t = threadIdx.x; asm volatile("" : "+v"(t)); return t; }
namespace pg8 {
#define PG8_LAS __attribute__((address_space(3)))
typedef unsigned short bf16_t;
typedef short bf16x8 __attribute__((ext_vector_type(8)));
typedef float f32x4 __attribute__((ext_vector_type(4)));
typedef unsigned u32x4 __attribute__((ext_vector_type(4)));
typedef unsigned u32x2 __attribute__((ext_vector_type(2)));
constexpr int BM = 256, BK = 64, HALF = 128, HTB = HALF * BK * 2, STAGE_BYTES = 8 * HTB, NXCD = 8, WGM = 8;
__host__ __device__ __forceinline__ int lds_byte(int r, int c) { const int st = (r >> 4) * 2 + (c >> 5), rr = r & 15, cc = c & 31, ob = rr * 64 + cc * 2; return st * 1024 + (ob ^ (((ob >> 9) & 1) << 5)); }
__host__ __device__ __forceinline__ void stage_rc(int b, int& R, int& C) { const int st = b / 1024, sb = b % 1024, swz = sb ^ (((sb >> 9) & 1) << 5); R = (st >> 1) * 16 + swz / 64; C = (st & 1) * 32 + (swz % 64) / 2; }
__host__ __device__ __forceinline__ int perm32(int rho) { const int n = rho >> 4, i = rho & 15; return 8 * (i >> 2) + 4 * n + (i & 3); }
struct Unit { int pm, pn; };
struct Gemm { const bf16_t* A; const bf16_t* Bt; int M, N, K; };
struct StaticOrder {
    int nM, nN, nwg, G, c;
    __host__ __device__ void init(int M, int N, int G_, int c_) { nM = M / BM; nN = N / BM; nwg = nM * nN; G = G_; c = c_; }
    __host__ __device__ bool next(int i, Unit& u) const {
        const long L = (long)i * G + c; if (L >= nwg) return false;
        int wgid = (int)L; { const int q = nwg / NXCD, r = nwg % NXCD, xcd = wgid % NXCD, off = wgid / NXCD; wgid = (xcd < r ? xcd * (q + 1) : r * (q + 1) + (xcd - r) * q) + off; }
        const int nig = WGM * nN, gid = wgid / nig, fm = gid * WGM, gsz = (nM - fm) < WGM ? (nM - fm) : WGM;
        u.pm = fm + ((wgid % nig) % gsz); u.pn = (wgid % nig) / gsz; return true;
    }
    __device__ __forceinline__ void a_ready(const Unit&) const {}
    __device__ __forceinline__ void done(const Unit&) const {}
};
struct RangeOrder {
    StaticOrder S; int i0, i1;
    __host__ __device__ bool next(int i, Unit& u) const { return (i0 + i < i1) && S.next(i0 + i, u); }
    __device__ __forceinline__ void a_ready(const Unit&) const {}
    __device__ __forceinline__ void done(const Unit&) const {}
};
__device__ __forceinline__ unsigned cvt_pk_bf16(float lo, float hi) { unsigned r; asm volatile("v_cvt_pk_bf16_f32 %0, %1, %2" : "=v"(r) : "v"(lo), "v"(hi)); return r; }

__device__ __forceinline__ float silu_fast(float x) { return x * __builtin_amdgcn_rcpf(1.f + __expf(-x)); }
struct EpiGU {
    static constexpr bool PERM = true, AFTER_DRAIN = false;
    bf16_t* H; int ldh; const float* ss;
    __device__ __forceinline__ void operator()(const f32x4 (&acc)[2][2][4][2], const Unit& u, int wr, int wc, int fr, int fq) const {
        const int row0 = u.pm * BM + wr * 64 + fr, col0 = u.pn * HALF + wc * 32 + 8 * fq;
#pragma unroll
        for (int ai = 0; ai < 2; ++ai)
#pragma unroll
            for (int m = 0; m < 4; ++m) {
                const int row = row0 + ai * HALF + m * 16;
                const float rs = rs_of(ss[row], D_MODEL);
                u32x4 o;
#pragma unroll
                for (int n = 0; n < 2; ++n) {
                    const f32x4 g = acc[ai][0][m][n] * rs, up = acc[ai][1][m][n] * rs;
                    o[2 * n] = cvt_pk_bf16(silu_fast(g[0]) * up[0], silu_fast(g[1]) * up[1]);
                    o[2 * n + 1] = cvt_pk_bf16(silu_fast(g[2]) * up[2], silu_fast(g[3]) * up[3]);
                }
                *(u32x4*)(H + (size_t)row * ldh + col0) = o;
            }
    }
};
struct EpiRes {
    static constexpr bool PERM = false, AFTER_DRAIN = false;
    float* C; const float* R; bf16_t* Cb; int ldc; float alpha; float* ss;
    __device__ __forceinline__ void operator()(const f32x4 (&acc)[2][2][4][2], const Unit& u, int wr, int wc, int fr, int fq) const {
        const int row0 = u.pm * BM + wr * 64 + fr, col0 = u.pn * BM + wc * 32 + 4 * fq;
#pragma unroll
        for (int ai = 0; ai < 2; ++ai)
#pragma unroll
            for (int m = 0; m < 4; ++m) {
                const int row = row0 + ai * HALF + m * 16;
                const size_t ro = (size_t)row * ldc + col0;
                float sq = 0.f;
#pragma unroll
                for (int bj = 0; bj < 2; ++bj)
#pragma unroll
                    for (int n = 0; n < 2; ++n) {
                        const size_t o = ro + bj * HALF + n * 16;
                        f32x4 v = *(const f32x4*)(R + o) + acc[ai][bj][m][n] * alpha;
                        *(f32x4*)(C + o) = v;
                        u32x2 b; b[0] = cvt_pk_bf16(v[0], v[1]); b[1] = cvt_pk_bf16(v[2], v[3]);
                        *(u32x2*)(Cb + o) = b;
                        sq += v[0] * v[0] + v[1] * v[1] + v[2] * v[2] + v[3] * v[3];
                    }
                sq += __shfl_xor(sq, 16); sq += __shfl_xor(sq, 32);
                if (fq == 0) atomicAdd(ss + row, sq);
            }
    }
};
struct EpiRes2 {
    static constexpr bool PERM = true, AFTER_DRAIN = false;
    const float* R32; const bf16_t* Rb; float* C32; bf16_t* Cb; int ldc; float alpha; float* ss;
    __device__ __forceinline__ void operator()(const f32x4 (&acc)[2][2][4][2], const Unit& u, int wr, int wc, int fr, int fq) const {
        const int row0 = u.pm * BM + wr * 64 + fr, col0 = u.pn * BM + wc * 32 + 8 * fq;
#pragma unroll
        for (int ai = 0; ai < 2; ++ai)
#pragma unroll
            for (int m = 0; m < 4; ++m) {
                const int row = row0 + ai * HALF + m * 16;
                const size_t ro = (size_t)row * ldc + col0;
                float sq = 0.f;
#pragma unroll
                for (int bj = 0; bj < 2; ++bj) {
                    const size_t o = ro + bj * HALF;
                    f32x4 r0, r1;
                    if (R32) { r0 = *(const f32x4*)(R32 + o); r1 = *(const f32x4*)(R32 + o + 4); }
                    else {
                        const u32x4 rb = *(const u32x4*)(Rb + o);
                        r0[0] = __uint_as_float(rb[0] << 16); r0[1] = __uint_as_float(rb[0] & 0xffff0000u); r0[2] = __uint_as_float(rb[1] << 16); r0[3] = __uint_as_float(rb[1] & 0xffff0000u);
                        r1[0] = __uint_as_float(rb[2] << 16); r1[1] = __uint_as_float(rb[2] & 0xffff0000u); r1[2] = __uint_as_float(rb[3] << 16); r1[3] = __uint_as_float(rb[3] & 0xffff0000u);
                    }
                    const f32x4 v0 = r0 + acc[ai][bj][m][0] * alpha, v1 = r1 + acc[ai][bj][m][1] * alpha;
                    if (C32) { *(f32x4*)(C32 + o) = v0; *(f32x4*)(C32 + o + 4) = v1; }
                    u32x4 b; b[0] = cvt_pk_bf16(v0[0], v0[1]); b[1] = cvt_pk_bf16(v0[2], v0[3]); b[2] = cvt_pk_bf16(v1[0], v1[1]); b[3] = cvt_pk_bf16(v1[2], v1[3]);
                    *(u32x4*)(Cb + o) = b;
                    sq += v0[0] * v0[0] + v0[1] * v0[1] + v0[2] * v0[2] + v0[3] * v0[3] + v1[0] * v1[0] + v1[1] * v1[1] + v1[2] * v1[2] + v1[3] * v1[3];
                }
                sq += __shfl_xor(sq, 16); sq += __shfl_xor(sq, 32);
                if (fq == 0) atomicAdd(ss + row, sq);
            }
    }
};
struct EpiScaleB {
    static constexpr bool PERM = true, AFTER_DRAIN = false;
    bf16_t* O; int ldc; const float* ss;
    __device__ __forceinline__ void operator()(const f32x4 (&acc)[2][2][4][2], const Unit& u, int wr, int wc, int fr, int fq) const {
        const int row0 = u.pm * BM + wr * 64 + fr, col0 = u.pn * BM + wc * 32 + 8 * fq;
#pragma unroll
        for (int ai = 0; ai < 2; ++ai)
#pragma unroll
            for (int m = 0; m < 4; ++m) {
                const int row = row0 + ai * HALF + m * 16;
                const float rs = ss ? rs_of(ss[row], D_MODEL) : 1.f;
#pragma unroll
                for (int bj = 0; bj < 2; ++bj) {
                    const f32x4 v0 = acc[ai][bj][m][0] * rs, v1 = acc[ai][bj][m][1] * rs;
                    u32x4 b; b[0] = cvt_pk_bf16(v0[0], v0[1]); b[1] = cvt_pk_bf16(v0[2], v0[3]); b[2] = cvt_pk_bf16(v1[0], v1[1]); b[3] = cvt_pk_bf16(v1[2], v1[3]);
                    *(u32x4*)(O + (size_t)row * ldc + col0 + bj * HALF) = b;
                }
            }
    }
};
struct EpiCmp {
    static constexpr bool PERM = false, AFTER_DRAIN = false;
    float* CH; const float* bias; int c; int nrows;
    __device__ __forceinline__ void operator()(const f32x4 (&acc)[2][2][4][2], const Unit& u, int wr, int wc, int fr, int fq) const {
        const int row0 = u.pm * BM + wr * 64 + fr, col0 = wc * 32 + 4 * fq;
#pragma unroll
        for (int ai = 0; ai < 2; ++ai)
#pragma unroll
            for (int m = 0; m < 4; ++m) {
                const int row = row0 + ai * HALF + m * 16;
                if (row < nrows) {
#pragma unroll
                    for (int n = 0; n < 2; ++n) {
                        const f32x4 b = *(const f32x4*)(bias + c * 128 + col0 + n * 16);
                        const f32x4 x = (c == 0 ? acc[ai][0][m][n] : acc[ai][1][m][n]) + b;
                        f32x4 o; o[0] = geluf_(x[0]); o[1] = geluf_(x[1]); o[2] = geluf_(x[2]); o[3] = geluf_(x[3]);
                        *(f32x4*)(CH + ((size_t)row * 2 + c) * 128 + col0 + n * 16) = o;
                    }
                }
            }
    }
};
struct EpiIn {
    static constexpr bool PERM = true, AFTER_DRAIN = false;
    const float* RS1; const float* q_g; const float* ks_g; const float* kw_g; const float* gate_b; float* out; bf16_t* QNb; float* KC32;
    bf16_t *KSb, *VSb, *KWb, *VWb; float* GT; bf16_t* PRb;
    __device__ __forceinline__ void operator()(const f32x4 (&acc)[2][2][4][2], const Unit& u, int wr, int wc, int fr, int fq) const {
        const int G = 4 * u.pn + wc;
        const int row0 = u.pm * BM + wr * 64 + fr;
        const bool nrm = (G < 8) || G == 12 || G == 13 || G == 16 || G == 17;
        f32x4 gn[2][2];
        if (nrm) {
#pragma unroll
            for (int bj = 0; bj < 2; ++bj)
#pragma unroll
                for (int n = 0; n < 2; ++n) {
                    const int go = 32 * bj + 8 * fq + 4 * n;
                    if (G < 8) gn[bj][n] = *(const f32x4*)(q_g + go) * 0.125f; else if (G < 14) gn[bj][n] = *(const f32x4*)(ks_g + go); else gn[bj][n] = *(const f32x4*)(kw_g + go);
                }
        }
#pragma unroll
        for (int ai = 0; ai < 2; ++ai)
#pragma unroll
            for (int m = 0; m < 4; ++m) {
                const int row = row0 + ai * HALF + m * 16;
                const float rs = __builtin_amdgcn_rsqf(RS1[row] * (1.f / D_MODEL) + RMS_EPS);
                const int nb = row / SEQ, ti = row % SEQ;
                f32x4 v[2][2];
#pragma unroll
                for (int bj = 0; bj < 2; ++bj)
#pragma unroll
                    for (int n = 0; n < 2; ++n) v[bj][n] = acc[ai][bj][m][n] * rs;
                if (nrm) {
                    float sq = 0.f;
#pragma unroll
                    for (int bj = 0; bj < 2; ++bj)
#pragma unroll
                        for (int n = 0; n < 2; ++n) sq += v[bj][n][0] * v[bj][n][0] + v[bj][n][1] * v[bj][n][1] + v[bj][n][2] * v[bj][n][2] + v[bj][n][3] * v[bj][n][3];
                    sq += __shfl_xor(sq, 16); sq += __shfl_xor(sq, 32);
                    const float rr = __builtin_amdgcn_rsqf(sq * (1.f / 64.f) + RMS_EPS);
#pragma unroll
                    for (int bj = 0; bj < 2; ++bj)
#pragma unroll
                        for (int n = 0; n < 2; ++n) v[bj][n] = v[bj][n] * rr * gn[bj][n];
                }
#pragma unroll
                for (int bj = 0; bj < 2; ++bj) {
                    const int d = 32 * bj + 8 * fq;
                    const f32x4 x0 = v[bj][0], x1 = v[bj][1];
                    u32x4 b; b[0] = cvt_pk_bf16(x0[0], x0[1]); b[1] = cvt_pk_bf16(x0[2], x0[3]); b[2] = cvt_pk_bf16(x1[0], x1[1]); b[3] = cvt_pk_bf16(x1[2], x1[3]);
                    if (G < 8) {
                        *(u32x4*)(QNb + (size_t)row * 512 + 64 * G + d) = b;
                    } else if (G < 20) {
                        const int c6 = (G - 8) >> 1, g = G & 1, cc = c6 * 128 + g * 64 + d;
                        if (c6 < 2) { float* q = KC32 + (size_t)row * 256 + cc; *(f32x4*)q = x0; *(f32x4*)(q + 4) = x1; }
                        if (c6 < 4) { float* q = out + O_KV_P + (size_t)row * 512 + cc; *(f32x4*)q = x0; *(f32x4*)(q + 4) = x1; }
                        else if (ti >= SEQ - WP) { float* q = out + O_WIN_P + ((size_t)nb * WP + (ti - (SEQ - WP))) * 256 + cc - 512; *(f32x4*)q = x0; *(f32x4*)(q + 4) = x1; }
                        if (c6 >= 2) {
                            const size_t o = (((size_t)nb * 2 + g) * SEQ + ti) * 64 + d;
                            if (c6 == 2) *(u32x4*)(KSb + o) = b; else if (c6 == 3) *(u32x4*)(VSb + o) = b; else if (c6 == 4) *(u32x4*)(KWb + o) = b; else *(u32x4*)(VWb + o) = b;
                        }
                    } else {
                        const int c = 64 * G + d - NSA_COLS;
                        if (c < 0) {
                            const f32x4 g0 = *(const f32x4*)(gate_b + d), g1 = *(const f32x4*)(gate_b + d + 4);
                            f32x4 a0, a1;
#pragma unroll
                            for (int e = 0; e < 4; ++e) { a0[e] = fast_sigmoid(x0[e] + g0[e]); a1[e] = fast_sigmoid(x1[e] + g1[e]); }
                            *(f32x4*)(GT + (size_t)row * 24 + d) = a0; *(f32x4*)(GT + (size_t)row * 24 + d + 4) = a1;
                        } else {
                            *(u32x4*)(PRb + (size_t)row * RWKV_COLS + c) = b;
                            if (ti == SEQ - 1) { float* q = out + O_SH_P + (size_t)nb * RWKV_COLS + c; *(f32x4*)q = x0; *(f32x4*)(q + 4) = x1; }
                        }
                    }
                }
            }
    }
};
struct EpiScale {
    static constexpr bool PERM = false, AFTER_DRAIN = false;
    float* C; int ldc; const float* ss;
    __device__ __forceinline__ void operator()(const f32x4 (&acc)[2][2][4][2], const Unit& u, int wr, int wc, int fr, int fq) const {
        const int row0 = u.pm * BM + wr * 64 + fr, col0 = u.pn * BM + wc * 32 + 4 * fq;
#pragma unroll
        for (int ai = 0; ai < 2; ++ai)
#pragma unroll
            for (int m = 0; m < 4; ++m) {
                const int row = row0 + ai * HALF + m * 16;
                const float rs = ss ? rs_of(ss[row], D_MODEL) : 1.f;
                float* rowp = C + (size_t)row * ldc + col0;
#pragma unroll
                for (int bj = 0; bj < 2; ++bj)
#pragma unroll
                    for (int n = 0; n < 2; ++n) *(f32x4*)(rowp + bj * HALF + n * 16) = acc[ai][bj][m][n] * rs;
            }
    }
};

template <class Epi, class Sched>
__device__ __forceinline__ void gemm_phase(PG8_LAS unsigned char* lds, const Gemm g, const Sched& S, const Epi& E) {
    const int tid = opaque_tid(), wid = __builtin_amdgcn_readfirstlane(tid >> 6), lane = tid & 63, wr = wid >> 2, wc = wid & 3, fr = lane & 15, fq = lane >> 4;
    const int K = g.K, nt = K / BK;
    unsigned voffA[2], voffB[2];
#pragma unroll
    for (int i = 0; i < 2; ++i) { int R, C; stage_rc(tid * 16 + i * 8192, R, C); const int Rb = Epi::PERM ? ((R & ~31) + perm32(R & 31)) : R;
        voffA[i] = (unsigned)(R * K + C) * 2u; voffB[i] = (unsigned)(Rb * K + C) * 2u; }
    const size_t kstep = (size_t)(BK * 2);
    const size_t hstep = (size_t)HALF * K * 2;
    const size_t tstep = 2 * hstep;
    const unsigned ldsw = (unsigned)wid * 1024u;
    const int aoff = lds_byte(wr * 64 + fr, fq * 8), boff = lds_byte(wc * 32 + fr, fq * 8);
#define PG8_SA(b, h) (((b) * 2 + (h)) * HTB)
#define PG8_SB(b, h) ((4 + (b) * 2 + (h)) * HTB)
#define PG8_STAGE(bufoff, gbase, voff) do { _Pragma("unroll") for (int _i = 0; _i < 2; ++_i) \
        __builtin_amdgcn_global_load_lds((const unsigned*)((const char*)(gbase) + (voff)[_i]), (PG8_LAS unsigned*)(lds + (bufoff) + ldsw + _i * 8192), 16, 0, 0); } while (0)
#define PG8_LDA(dst, b, h) do { _Pragma("unroll") for (int m = 0; m < 4; ++m) _Pragma("unroll") for (int k = 0; k < 2; ++k) dst[m][k] = *(const PG8_LAS bf16x8*)(lds + PG8_SA(b, h) + aoff + m * 2048 + k * 1024); } while (0)
#define PG8_LDB(dst, b, h) do { _Pragma("unroll") for (int n = 0; n < 2; ++n) _Pragma("unroll") for (int k = 0; k < 2; ++k) dst[n][k] = *(const PG8_LAS bf16x8*)(lds + PG8_SB(b, h) + boff + n * 2048 + k * 1024); } while (0)
#define PG8_MMA(ai, bj, At, Bt) do { __builtin_amdgcn_s_setprio(1); _Pragma("unroll") for (int m = 0; m < 4; ++m) _Pragma("unroll") for (int n = 0; n < 2; ++n) _Pragma("unroll") for (int k = 0; k < 2; ++k) \
        acc[ai][bj][m][n] = __builtin_amdgcn_mfma_f32_16x16x32_bf16(Bt[n][k], At[m][k], acc[ai][bj][m][n], 0, 0, 0); __builtin_amdgcn_s_setprio(0); } while (0)
#define PG8_WAIT_V(n) asm volatile("s_waitcnt vmcnt(" #n ")" ::: "memory")
#define PG8_WAIT_L(n) asm volatile("s_waitcnt lgkmcnt(" #n ")" ::: "memory")
#define PG8_BAR __builtin_amdgcn_s_barrier()
#define PG8_SCHED __builtin_amdgcn_sched_barrier(0)
    Unit cur, nxt; int ui = 0;
    if (!S.next(0, cur)) return;
    f32x4 acc[2][2][4][2];
#pragma unroll
    for (int a = 0; a < 2; ++a)
#pragma unroll
        for (int b = 0; b < 2; ++b)
#pragma unroll
            for (int m = 0; m < 4; ++m)
#pragma unroll
                for (int n = 0; n < 2; ++n) acc[a][b][m][n] = (f32x4){0.f, 0.f, 0.f, 0.f};
    bf16x8 At[4][2], B0[2][2], B1[2][2];
    const char* cA = (const char*)g.A + (size_t)cur.pm * tstep; const char* cB = (const char*)g.Bt + (size_t)cur.pn * tstep;
    S.a_ready(cur);
    PG8_STAGE(PG8_SB(0, 0), cB, voffB); PG8_STAGE(PG8_SA(0, 0), cA, voffA); PG8_STAGE(PG8_SB(0, 1), cB + hstep, voffB); PG8_STAGE(PG8_SA(0, 1), cA + hstep, voffA);
    if (wr == 1) PG8_BAR;
    PG8_WAIT_V(4); PG8_BAR;
    PG8_STAGE(PG8_SB(1, 0), cB + kstep, voffB); PG8_STAGE(PG8_SA(1, 0), cA + kstep, voffA); PG8_STAGE(PG8_SB(1, 1), cB + hstep + kstep, voffB);
    PG8_WAIT_V(6); PG8_BAR;
    for (;;) {
        const bool has_next = S.next(ui + 1, nxt);
        const char* nA = has_next ? (const char*)g.A + (size_t)nxt.pm * tstep : cA; const char* nB = has_next ? (const char*)g.Bt + (size_t)nxt.pn * tstep : cB;
        for (int t = 0; t < nt; t += 2) {
            const bool last = (t == nt - 2);
            const char* a1 = cA + (size_t)(t + 1) * kstep;
            const char* a2 = last ? nA : cA + (size_t)(t + 2) * kstep; const char* b2 = last ? nB : cB + (size_t)(t + 2) * kstep;
            const char* a3 = a2 + kstep; const char* b3 = b2 + kstep;
            if (last && has_next) S.a_ready(nxt);
            PG8_LDB(B0, 0, 0); PG8_SCHED; PG8_LDA(At, 0, 0); PG8_STAGE(PG8_SA(1, 1), a1 + hstep, voffA);
            PG8_WAIT_L(8); PG8_BAR; PG8_WAIT_L(0); PG8_MMA(0, 0, At, B0); PG8_BAR; PG8_SCHED;
            PG8_LDB(B1, 0, 1); PG8_STAGE(PG8_SB(0, 0), b2, voffB);
            PG8_BAR; PG8_WAIT_L(0); PG8_MMA(0, 1, At, B1); PG8_BAR;
            PG8_LDA(At, 0, 1); PG8_STAGE(PG8_SA(0, 0), a2, voffA);
            PG8_BAR; PG8_WAIT_L(0); PG8_MMA(1, 0, At, B0); PG8_BAR; PG8_SCHED;
            PG8_STAGE(PG8_SB(0, 1), b2 + hstep, voffB);
            PG8_WAIT_V(6); PG8_BAR; PG8_MMA(1, 1, At, B1); PG8_BAR;
            PG8_LDB(B0, 1, 0); PG8_SCHED; PG8_LDA(At, 1, 0); PG8_STAGE(PG8_SA(0, 1), a2 + hstep, voffA);
            PG8_WAIT_L(8); PG8_BAR; PG8_WAIT_L(0); PG8_MMA(0, 0, At, B0); PG8_BAR; PG8_SCHED;
            PG8_LDB(B1, 1, 1); PG8_STAGE(PG8_SB(1, 0), b3, voffB);
            PG8_BAR; PG8_WAIT_L(0); PG8_MMA(0, 1, At, B1); PG8_BAR;
            PG8_LDA(At, 1, 1); PG8_STAGE(PG8_SA(1, 0), a3, voffA);
            PG8_BAR; PG8_WAIT_L(0); PG8_MMA(1, 0, At, B0); PG8_BAR; PG8_SCHED;
            PG8_STAGE(PG8_SB(1, 1), b3 + hstep, voffB);
            PG8_WAIT_V(6); PG8_BAR; PG8_MMA(1, 1, At, B1); PG8_BAR;
        }
        E(acc, cur, wr, wc, fr, fq); S.done(cur);
        if (!has_next) break;
#pragma unroll
        for (int a = 0; a < 2; ++a)
#pragma unroll
            for (int b = 0; b < 2; ++b)
#pragma unroll
                for (int m = 0; m < 4; ++m)
#pragma unroll
                    for (int n = 0; n < 2; ++n) acc[a][b][m][n] = (f32x4){0.f, 0.f, 0.f, 0.f};
        cur = nxt; cA = nA; cB = nB; ++ui;
    }
    PG8_WAIT_V(0);
    if (wr == 0) PG8_BAR;
    PG8_BAR;
#undef PG8_SA
#undef PG8_SB
#undef PG8_STAGE
#undef PG8_LDA
#undef PG8_LDB
#undef PG8_MMA
#undef PG8_WAIT_V
#undef PG8_WAIT_L
#undef PG8_BAR
#undef PG8_SCHED
}
}

namespace nsa {
typedef short bf16x8 __attribute__((ext_vector_type(8)));
typedef short s16x4 __attribute__((ext_vector_type(4)));
typedef float f32x16 __attribute__((ext_vector_type(16)));
typedef unsigned u32x4 __attribute__((ext_vector_type(4)));
typedef unsigned u32x2 __attribute__((ext_vector_type(2)));
#define NSA_MFMA(a, b, c) __builtin_amdgcn_mfma_f32_32x32x16_bf16((a), (b), (c), 0, 0, 0)
constexpr int KROW = 144, TILE_B = 64 * KROW;
constexpr int L_K = 0, L_V = 2 * TILE_B, L_IMP = 4 * TILE_B, L_UN = L_IMP + 8 * 2048, L_END = L_UN + 128;
constexpr float LOG2E = 1.4426950408889634f;
#define NSA_NEG (-__builtin_inff())
__device__ __forceinline__ bf16x8 pack8(const f32x16& x, int s) {
    u32x4 p;
    asm volatile("v_cvt_pk_bf16_f32 %0, %4, %5\n\tv_cvt_pk_bf16_f32 %1, %6, %7\n\tv_cvt_pk_bf16_f32 %2, %8, %9\n\tv_cvt_pk_bf16_f32 %3, %10, %11\n\ts_nop 1"
                 : "=&v"(p[0]), "=&v"(p[1]), "=&v"(p[2]), "=&v"(p[3])
                 : "v"(x[8 * s]), "v"(x[8 * s + 1]), "v"(x[8 * s + 2]), "v"(x[8 * s + 3]), "v"(x[8 * s + 4]), "v"(x[8 * s + 5]), "v"(x[8 * s + 6]), "v"(x[8 * s + 7]));
    return __builtin_bit_cast(bf16x8, p);
}
template <int DS, int NDB, int KSTR, int VSTR, bool HASB>
__device__ __forceinline__ void tile_step_g(const LAS unsigned char* Kb, const LAS unsigned char* Vb, const bf16x8 (&qf)[DS], f32x16 (&o)[NDB], f32x16 (&st)[2],
                                            float& m_run, float& l_run, float SC, const bf16x8 (&kext)[2], const bf16x8& qext, int lim_lo, int lim_hi, int ql, int h) {
#pragma unroll
    for (int sub = 0; sub < 2; ++sub) {
#pragma unroll
        for (int i = 0; i < 16; ++i) st[sub][i] = 0.f;
#pragma unroll
        for (int s = 0; s < DS; ++s) {
            const bf16x8 a = *(const LAS bf16x8*)(Kb + (32 * sub + ql) * KSTR + 32 * s + 16 * h);
            st[sub] = NSA_MFMA(a, qf[s], st[sub]);
        }
        if (HASB) st[sub] = NSA_MFMA(kext[sub], qext, st[sub]);
    }
    __builtin_amdgcn_sched_barrier(0);
    float mloc = NSA_NEG;
    const bool rowfull = (lim_lo <= 0 && lim_hi >= 59), rownone = (lim_hi < 0) || (lim_lo > 63);
    bool dead = false;
    if (__all(rowfull || rownone)) {
#pragma unroll
        for (int sub = 0; sub < 2; ++sub)
#pragma unroll
            for (int i = 0; i < 16; ++i) mloc = fmaxf(mloc, st[sub][i]);
        dead = rownone;
        if (dead) mloc = NSA_NEG;
    } else {
#pragma unroll
        for (int sub = 0; sub < 2; ++sub)
#pragma unroll
            for (int i = 0; i < 16; ++i) {
                const int c = 32 * sub + (i & 3) + 8 * (i >> 2);
                const float sv = ((c >= lim_lo) && (c <= lim_hi)) ? st[sub][i] : NSA_NEG;
                st[sub][i] = sv; mloc = fmaxf(mloc, sv);
            }
    }
    mloc = xhalf_max(mloc);
    const float mnew = fmaxf(m_run, mloc);
    const float msafe = (mnew == NSA_NEG) ? 0.f : mnew;
    const float alpha = __builtin_amdgcn_exp2f((m_run - msafe) * SC);
    const float nm = dead ? NSA_NEG : -msafe * SC;
    m_run = mnew;
    float ls = 0.f;
#pragma unroll
    for (int sub = 0; sub < 2; ++sub)
#pragma unroll
        for (int i = 0; i < 16; ++i) { const float pv = __builtin_amdgcn_exp2f(fmaf(st[sub][i], SC, nm)); st[sub][i] = pv; ls += pv; }
    l_run = l_run * alpha + ls;
    if (!__all(alpha == 1.f)) {
#pragma unroll
        for (int db = 0; db < NDB; ++db)
#pragma unroll
            for (int i = 0; i < 16; ++i) o[db][i] *= alpha;
    }
    __builtin_amdgcn_sched_barrier(0);
#pragma unroll
    for (int sub = 0; sub < 2; ++sub)
#pragma unroll
        for (int s2 = 0; s2 < 2; ++s2) {
            __builtin_amdgcn_sched_barrier(0);
            const bf16x8 pf = pack8(st[sub], s2);
#pragma unroll
            for (int db = 0; db < NDB; ++db) {
                const LAS unsigned char* vr = Vb + (32 * db + ql) * VSTR + (32 * sub + 16 * s2 + 4 * h) * 2;
                const s16x4 lo = *(const LAS s16x4*)(vr), hi = *(const LAS s16x4*)(vr + 16);
                const bf16x8 vf = __builtin_shufflevector(lo, hi, 0, 1, 2, 3, 4, 5, 6, 7);
                o[db] = NSA_MFMA(vf, pf, o[db]);
            }
        }
}
__device__ __forceinline__ bf16x8 bias_kext(int c64, int c65, int h) {
    bf16x8 v = {0, 0, 0, 0, 0, 0, 0, 0};
    if (h == 0) { v[0] = (short)f2bf((float)c64); v[1] = (short)f2bf((float)c65); }
    return v;
}
__device__ __forceinline__ bf16x8 bias_qext(float slope, int h) {
    bf16x8 v = {0, 0, 0, 0, 0, 0, 0, 0};
    if (h == 0) { v[0] = (short)f2bf(64.f * slope); v[1] = (short)f2bf(slope); }
    return v;
}
struct TileSrc { const unsigned short* k; const unsigned short* v; long vstride; };
__device__ __forceinline__ void tile_issue(const TileSrc& t, int tid, u32x4& kr, u32x4& vr) {
    const int row = tid >> 3, seg = tid & 7;
    kr = *(const u32x4*)(t.k + row * 64 + seg * 8);
    vr = *(const u32x4*)(t.v + (t.vstride > 0 ? (long)row * t.vstride : (long)row * 64) + seg * 8);
}
template <bool VT>
__device__ __forceinline__ void tile_commit(LAS unsigned char* lds, int buf, int tid, const u32x4& kr, const u32x4& vr) {
    const int row = tid >> 3, seg = tid & 7;
    *(LAS u32x4*)(lds + L_K + buf * TILE_B + row * KROW + seg * 16) = kr;
    if (VT) *(LAS u32x4*)(lds + L_V + buf * TILE_B + row * KROW + seg * 16) = vr;
    else {
        LAS unsigned char* vb = lds + L_V + buf * TILE_B + (seg * 8) * KROW + row * 2;
#pragma unroll
        for (int e = 0; e < 8; ++e) *(LAS unsigned short*)(vb + e * KROW) = (unsigned short)(vr[e >> 1] >> (16 * (e & 1)));
    }
}

__device__ __forceinline__ void prompt_unit(const Params& p, LAS unsigned char* lds, int n, int g, int qb) {
    const int tid = opaque_tid(), lane = tid & 63, w = __builtin_amdgcn_readfirstlane(tid >> 6), ql = lane & 31, h = lane >> 5;
    const int tloc = ql >> 2, r = ql & 3, tl = 8 * w + tloc, head = g * 4 + r;
    const int t0 = qb * 64, tq = t0 + tl;
    const long m = (long)n * SEQ + tq;
    const bf16x8 qext = bias_qext(exp2f(-(float)(head + 1)), h);
    bf16x8 qf[4];
#pragma unroll
    for (int s = 0; s < 4; ++s) qf[s] = *(const bf16x8*)(p.QNb + m * 512 + head * 64 + 16 * s + 8 * h);
    const float gc = p.GT[m * 24 + head * 3 + 0], gs = p.GT[m * 24 + head * 3 + 1], gw = p.GT[m * 24 + head * 3 + 2];
    f32x16 outacc[2], o[2], st[2];
#pragma unroll
    for (int db = 0; db < 2; ++db)
#pragma unroll
        for (int i = 0; i < 16; ++i) { outacc[db][i] = 0.f; o[db][i] = 0.f; }
    u32x4 kr, vr;
    const long ng = (long)n * 2 + g;
    {
        TileSrc ts{p.KCb + ng * NBP * 64, p.VCt + ng * 64 * NBP, NBP};
        tile_issue(ts, tid, kr, vr); tile_commit<true>(lds, 0, tid, kr, vr);
        __syncthreads();
        float m_run = NSA_NEG, l_run = 0.f;
        const bf16x8 kext[2] = {bias_kext(ql - qb, 63, h), bias_kext(32 + ql - qb, 63, h)};
        tile_step_g<4, 2, KROW, KROW, true>(lds + L_K, lds + L_V, qf, o, st, m_run, l_run, LOG2E, kext, qext, -1000, ((tq + 1) >> 6) - 1 - 4 * h, ql, h);
        const float ltot = xhalf_sum(l_run);
        const float inv = ltot > 0.f ? 1.f / ltot : 0.f;
#pragma unroll
        for (int db = 0; db < 2; ++db)
#pragma unroll
            for (int i = 0; i < 16; ++i) { outacc[db][i] += gc * inv * o[db][i]; o[db][i] = 0.f; }
        LAS float* impw = (LAS float*)(lds + L_IMP + w * 2048);
#pragma unroll
        for (int sub = 0; sub < 2; ++sub)
#pragma unroll
            for (int i = 0; i < 16; ++i) {
                float v = st[sub][i] * inv;
                v += __shfl_xor(v, 1); v += __shfl_xor(v, 2);
                const int kk = 32 * sub + (i & 3) + 8 * (i >> 2) + 4 * h;
                if (r == 0) impw[tloc * 64 + kk] = v;
            }
    }
    __syncthreads();
    unsigned long long mymask = 0ull, un = 0ull;
    {
        const LAS float* impw = (const LAS float*)(lds + L_IMP + w * 2048);
        for (int tt = 0; tt < 8; ++tt) {
            const int b = lane;
            const bool forced = (b == 0) || (b == qb) || (b == qb - 1);
            float sc = forced ? 1e9f : ((b <= qb) ? impw[tt * 64 + b] : -1e9f);
            int rank = 0;
#pragma unroll
            for (int j = 0; j < 64; ++j) {
                const float sj = __int_as_float(__builtin_amdgcn_readlane(__float_as_int(sc), j));
                rank += (sj > sc || (sj == sc && j < b)) ? 1 : 0;
            }
            const unsigned long long mk = __ballot(rank < N_SEL);
            if (tloc == tt) mymask = mk;
            un |= mk;
        }
        if (lane == 0) *(LAS unsigned long long*)(lds + L_UN + w * 8) = un;
    }
    __syncthreads();
    {
        unsigned long long u2 = 0ull;
#pragma unroll
        for (int k = 0; k < 8; ++k) u2 |= *(const LAS unsigned long long*)(lds + L_UN + k * 8);
        un = u2;
        const unsigned lo32 = __builtin_amdgcn_readfirstlane((unsigned)un), hi32 = __builtin_amdgcn_readfirstlane((unsigned)(un >> 32));
        un = ((unsigned long long)hi32 << 32) | lo32;
        if (qb < 63) un &= ((1ull << (qb + 1)) - 1ull);
    }
    {
        float m_run = NSA_NEG, l_run = 0.f;
        unsigned long long rem = un;
        auto nextb = [&]() { if (rem == 0ull) return -1; const int x = 63 - (int)__builtin_clzll(rem); rem &= ~(1ull << x); return x; };
        u32x4 kr2, vr2;
        int b = nextb(), b1 = nextb();
        { TileSrc ts{p.KSb + (ng * SEQ + (long)b * 64) * 64, p.VSb + (ng * SEQ + (long)b * 64) * 64, 0}; tile_issue(ts, tid, kr, vr); tile_commit<false>(lds, 0, tid, kr, vr); }
        if (b1 >= 0) { TileSrc ts{p.KSb + (ng * SEQ + (long)b1 * 64) * 64, p.VSb + (ng * SEQ + (long)b1 * 64) * 64, 0}; tile_issue(ts, tid, kr, vr); }
        __syncthreads();
        int buf = 0;
        for (;;) {
            const int b2 = (b1 >= 0) ? nextb() : -1;
            if (b2 >= 0) { TileSrc tn{p.KSb + (ng * SEQ + (long)b2 * 64) * 64, p.VSb + (ng * SEQ + (long)b2 * 64) * 64, 0}; tile_issue(tn, tid, kr2, vr2); }
            const int kb0 = b * 64;
            const bool selb = (mymask >> b) & 1ull;
            const bf16x8 kext[2] = {bias_kext(b - qb, ql, h), bias_kext(b - qb, 32 + ql, h)};
            tile_step_g<4, 2, KROW, KROW, true>(lds + L_K + buf * TILE_B, lds + L_V + buf * TILE_B, qf, o, st, m_run, l_run, LOG2E, kext, qext, -1000,
                                                selb ? (tq - kb0 - 4 * h) : -2000, ql, h);
            if (b1 >= 0) tile_commit<false>(lds, buf ^ 1, tid, kr, vr);
            __syncthreads();
            if (b1 < 0) break;
            b = b1; b1 = b2; kr = kr2; vr = vr2; buf ^= 1;
        }
        const float ltot = xhalf_sum(l_run);
        const float inv = ltot > 0.f ? 1.f / ltot : 0.f;
#pragma unroll
        for (int db = 0; db < 2; ++db)
#pragma unroll
            for (int i = 0; i < 16; ++i) { outacc[db][i] += gs * inv * o[db][i]; o[db][i] = 0.f; }
    }
    {
        float m_run = NSA_NEG, l_run = 0.f;
        int b = qb; const int blo = (qb - WINDOW / 64) < 0 ? 0 : (qb - WINDOW / 64);
        u32x4 kr2, vr2;
        { TileSrc ts{p.KWb + (ng * SEQ + (long)b * 64) * 64, p.VWb + (ng * SEQ + (long)b * 64) * 64, 0}; tile_issue(ts, tid, kr, vr); tile_commit<false>(lds, 0, tid, kr, vr); }
        if (b - 1 >= blo) { TileSrc ts{p.KWb + (ng * SEQ + (long)(b - 1) * 64) * 64, p.VWb + (ng * SEQ + (long)(b - 1) * 64) * 64, 0}; tile_issue(ts, tid, kr, vr); }
        __syncthreads();
        int buf = 0;
        for (;;) {
            const bool more = b - 1 >= blo;
            if (b - 2 >= blo) { TileSrc tn{p.KWb + (ng * SEQ + (long)(b - 2) * 64) * 64, p.VWb + (ng * SEQ + (long)(b - 2) * 64) * 64, 0}; tile_issue(tn, tid, kr2, vr2); }
            const int kb0 = b * 64;
            const bf16x8 kext[2] = {bias_kext(b - qb, ql, h), bias_kext(b - qb, 32 + ql, h)};
            tile_step_g<4, 2, KROW, KROW, true>(lds + L_K + buf * TILE_B, lds + L_V + buf * TILE_B, qf, o, st, m_run, l_run, LOG2E, kext, qext,
                                                tq - (WINDOW - 1) - kb0 - 4 * h, tq - kb0 - 4 * h, ql, h);
            if (more) tile_commit<false>(lds, buf ^ 1, tid, kr, vr);
            __syncthreads();
            if (!more) break;
            --b; kr = kr2; vr = vr2; buf ^= 1;
        }
        const float ltot = xhalf_sum(l_run);
        const float inv = ltot > 0.f ? 1.f / ltot : 0.f;
#pragma unroll
        for (int db = 0; db < 2; ++db)
#pragma unroll
            for (int i = 0; i < 16; ++i) outacc[db][i] += gw * inv * o[db][i];
    }
#pragma unroll
    for (int db = 0; db < 2; ++db)
#pragma unroll
        for (int g4 = 0; g4 < 4; ++g4) {
            u32x2 v; v[0] = pg8::cvt_pk_bf16(outacc[db][4 * g4 + 0], outacc[db][4 * g4 + 1]); v[1] = pg8::cvt_pk_bf16(outacc[db][4 * g4 + 2], outacc[db][4 * g4 + 3]);
            *(u32x2*)(p.MIXb + m * MIX_W + head * 64 + 32 * db + 8 * g4 + 4 * h) = v;
        }
}
__device__ __forceinline__ void prompt_phase(const Params& p, LAS unsigned char* lds) {
    const int nu = BATCH * 2 * NBP;
    for (int u = blockIdx.x; u < nu; u += gridDim.x) {
        const int per = BATCH * 2;
        const int rnd = u / 256, idx = u % 256;
        int qb, ngi;
        if (NBP == 64 && per == 16) {
            const int a = idx / 16; ngi = idx % 16;
            qb = rnd == 0 ? 63 - a : rnd == 1 ? 32 + a : rnd == 2 ? 31 - a : a;
        } else { qb = NBP - 1 - u / per; ngi = u % per; }
        prompt_unit(p, lds, ngi >> 1, (ngi & 1) ^ (rnd & 1), qb);
    }
}

constexpr int XK_ROW = 272, XK_TILE = 64 * XK_ROW, XV_TILE = 128 * KROW, XL_K = 0, XL_V = 2 * XK_TILE;
__device__ __forceinline__ void x_issue(const unsigned short* kb, const unsigned short* vb, int tid, u32x4 (&kr)[2], u32x4 (&vr)[2]) {
#pragma unroll
    for (int q = 0; q < 2; ++q) { const int idx = tid + 512 * q; kr[q] = *(const u32x4*)(kb + idx * 8); vr[q] = *(const u32x4*)(vb + idx * 8); }
}
__device__ __forceinline__ void x_commit(LAS unsigned char* lds, int buf, int tid, const u32x4 (&kr)[2], const u32x4 (&vr)[2]) {
#pragma unroll
    for (int q = 0; q < 2; ++q) {
        const int idx = tid + 512 * q, row = idx >> 4, seg = idx & 15;
        *(LAS u32x4*)(lds + XL_K + buf * XK_TILE + row * XK_ROW + seg * 16) = kr[q];
        LAS unsigned char* vt = lds + XL_V + buf * XV_TILE + (seg * 8) * KROW + row * 2;
#pragma unroll
        for (int e = 0; e < 8; ++e) *(LAS unsigned short*)(vt + e * KROW) = (unsigned short)(vr[q][e >> 1] >> (16 * (e & 1)));
    }
}
__device__ __forceinline__ void xattn_unit(const Params& p, LAS unsigned char* lds, const unsigned short* kb, const unsigned short* vb, long m0, int nv, int head) {
    const int tid = opaque_tid(), lane = tid & 63, w = __builtin_amdgcn_readfirstlane(tid >> 6), ql = lane & 31, h = lane >> 5;
    const int rowi = 32 * w + ql; const bool valid = rowi < nv;
    const long m = m0 + (valid ? rowi : 0);
    bf16x8 qf[8];
    {
        const unsigned short* qrow = p.XQb + m * XW + head * 128 + 8 * h;
        const float* gq = p.in[I_XQ_G] + 8 * h;
        float ss = 0.f;
#pragma unroll
        for (int s = 0; s < 8; ++s)
#pragma unroll
            for (int j = 0; j < 8; ++j) { const float v = bf2f(qrow[16 * s + j]); ss += v * v; }
        ss += __shfl_xor(ss, 32);
        const float r = valid ? (1.f / sqrtf(ss * (1.f / 128.f) + RMS_EPS)) * (LOG2E * 0.08838834764831845f) : 0.f;
#pragma unroll
        for (int s = 0; s < 8; ++s)
#pragma unroll
            for (int j = 0; j < 8; ++j) qf[s][j] = (short)f2bf(bf2f(qrow[16 * s + j]) * r * gq[16 * s + j]);
    }
    f32x16 o[4], st[2];
#pragma unroll
    for (int db = 0; db < 4; ++db)
#pragma unroll
        for (int i = 0; i < 16; ++i) o[db][i] = 0.f;
    u32x4 kr[2], vr[2];
    x_issue(kb, vb, tid, kr, vr); x_commit(lds, 0, tid, kr, vr);
    __syncthreads();
    float m_run = NSA_NEG, l_run = 0.f;
    const bf16x8 kext0[2] = {{0, 0, 0, 0, 0, 0, 0, 0}, {0, 0, 0, 0, 0, 0, 0, 0}};
    constexpr int NT = N_MEM / 64;
    for (int t = 0; t < NT; ++t) {
        const bool more = t + 1 < NT;
        if (more) x_issue(kb + (long)(t + 1) * 64 * 128, vb + (long)(t + 1) * 64 * 128, tid, kr, vr);
        tile_step_g<8, 4, XK_ROW, KROW, false>(lds + XL_K + (t & 1) * XK_TILE, lds + XL_V + (t & 1) * XV_TILE, qf, o, st, m_run, l_run, 1.f, kext0, kext0[0], -1000, 1000, ql, h);
        if (more) x_commit(lds, (t + 1) & 1, tid, kr, vr);
        __syncthreads();
    }
    const float ltot = xhalf_sum(l_run);
    const float inv = 1.f / ltot;
    if (valid) {
#pragma unroll
        for (int db = 0; db < 4; ++db)
#pragma unroll
            for (int g4 = 0; g4 < 4; ++g4) {
                u32x2 v; v[0] = pg8::cvt_pk_bf16(o[db][4 * g4 + 0] * inv, o[db][4 * g4 + 1] * inv); v[1] = pg8::cvt_pk_bf16(o[db][4 * g4 + 2] * inv, o[db][4 * g4 + 3] * inv);
                *(u32x2*)(p.OXb + m * XW + head * 128 + 32 * db + 8 * g4 + 4 * h) = v;
            }
    }
}
__device__ __forceinline__ void xattn_phase(const Params& p, LAS unsigned char* lds) {
    constexpr int QT = SEQ / 256, NPU = BATCH * 4 * QT, NSU = DEC_BATCH * 4;
    for (int u = blockIdx.x; u < NPU + NSU; u += gridDim.x) {
        if (u < NPU) {
            const int qt = u % QT, nh = u / QT, hd = nh % 4, n = nh / 4;
            xattn_unit(p, lds, p.XKb + (long)nh * N_MEM * 128, p.XVb + (long)nh * N_MEM * 128, (long)n * SEQ + qt * 256, 256, hd);
        } else {
            const int nh = u - NPU, hd = nh % 4, n = nh / 4;
            xattn_unit(p, lds, p.XKSb + (long)nh * N_MEM * 128, p.XVSb + (long)nh * N_MEM * 128, (long)MP + (long)n * DEC_SEQ, DEC_SEQ, hd);
        }
    }
}

constexpr int SW_BYTES = 16384, S_SH = 8 * SW_BYTES, S_ML = S_SH, S_OACC = S_ML + 3 * 2048, S_IMP = S_OACC + 8192, S_MASK = S_IMP + 8 * 320 * 4, S_END = S_MASK + 8 * 8 * 8;
__device__ __forceinline__ void stage_f32(LAS unsigned char* wk, LAS unsigned char* wv, const float* kp, const float* vp, long stride, int nvalid, int lane) {
#pragma unroll 4
    for (int it = 0; it < 16; ++it) {
        const int idx = it * 64 + lane, row = idx >> 4, q = idx & 15;
        pg8::f32x4 kv = {0.f, 0.f, 0.f, 0.f}, vv = {0.f, 0.f, 0.f, 0.f};
        if (row < nvalid) { kv = *(const pg8::f32x4*)(kp + (long)row * stride + q * 4); vv = *(const pg8::f32x4*)(vp + (long)row * stride + q * 4); }
        u32x2 pk; pk[0] = pg8::cvt_pk_bf16(kv[0], kv[1]); pk[1] = pg8::cvt_pk_bf16(kv[2], kv[3]);
        *(LAS u32x2*)(wk + row * 128 + q * 8) = pk;
#pragma unroll
        for (int e = 0; e < 4; ++e) *(LAS unsigned short*)(wv + (q * 4 + e) * 128 + row * 2) = f2bf(vv[e]);
    }
    asm volatile("s_waitcnt vmcnt(0) lgkmcnt(0)" ::: "memory");
}
__device__ __forceinline__ float combine_branch(LAS unsigned char* lds, int slot, int w, int ql, int h, float m_run, float l_run, const f32x16 (&o)[2], float gate) {
    LAS float* ml = (LAS float*)(lds + S_ML + slot * 2048);
    const float ltot = xhalf_sum(l_run);
    if (h == 0) { ml[(w * 32 + ql) * 2] = m_run; ml[(w * 32 + ql) * 2 + 1] = ltot; }
    __syncthreads();
    float M = NSA_NEG;
#pragma unroll
    for (int k = 0; k < 8; ++k) M = fmaxf(M, ml[(k * 32 + ql) * 2]);
    const float Ms = (M == NSA_NEG) ? 0.f : M;
    float L = 0.f;
#pragma unroll
    for (int k = 0; k < 8; ++k) L += ml[(k * 32 + ql) * 2 + 1] * __builtin_amdgcn_exp2f((ml[(k * 32 + ql) * 2] - Ms) * LOG2E);
    const float f = (L > 0.f) ? __builtin_amdgcn_exp2f((m_run - Ms) * LOG2E) / L : 0.f;
    const float gf = gate * f;
    if (gf != 0.f) {
        LAS float* oa = (LAS float*)(lds + S_OACC) + ql * 64;
#pragma unroll
        for (int db = 0; db < 2; ++db)
#pragma unroll
            for (int i = 0; i < 16; ++i)
                (void)__hip_atomic_fetch_add(oa + 32 * db + (i & 3) + 8 * (i >> 2) + 4 * h, gf * o[db][i], __ATOMIC_RELAXED, __HIP_MEMORY_SCOPE_WORKGROUP);
    }
    return f;
}
__device__ __forceinline__ void sample_unit(const Params& p, LAS unsigned char* lds, int n, int g) {
    static_assert(NBS % 64 == 0 && NBS / 64 <= 8 && WBUF == 512 && DEC_SEQ == 8 && NBS + 1 <= 320, "sample NSA unit geometry");
    const int tid = opaque_tid(), lane = tid & 63, w = __builtin_amdgcn_readfirstlane(tid >> 6), ql = lane & 31, h = lane >> 5;
    const int tloc = ql >> 2, r = ql & 3, head = g * 4 + r;
    const int tq = PAST_LEN + tloc, t0 = PAST_LEN;
    const long m = (long)MP + (long)n * DEC_SEQ + tloc;
    const bf16x8 qext = bias_qext(exp2f(-(float)(head + 1)), h);
    LAS unsigned char* wk = lds + w * SW_BYTES; LAS unsigned char* wv = wk + 8192;
    bf16x8 qf[4];
#pragma unroll
    for (int s = 0; s < 4; ++s) qf[s] = *(const bf16x8*)(p.QNb + m * 512 + head * 64 + 16 * s + 8 * h);
    const float gc = p.GT[m * 24 + head * 3 + 0], gs = p.GT[m * 24 + head * 3 + 1], gw = p.GT[m * 24 + head * 3 + 2];
    for (int i = tid; i < 2048; i += 512) ((LAS float*)(lds + S_OACC))[i] = 0.f;
    f32x16 o[2], st[2];
    const int* pt = (const int*)p.in[I_PAGE_TABLE] + n * NPAGES;
    const float* newrow = p.KVW + ((long)MP + (long)n * DEC_SEQ) * 768;
    {
#pragma unroll
        for (int db = 0; db < 2; ++db)
#pragma unroll
            for (int i = 0; i < 16; ++i) o[db][i] = 0.f;
        float m_run = NSA_NEG, l_run = 0.f;
        const bool mine = w < NBS / 64;
        if (mine) {
            const float* kp = p.KCS + (((long)n * NBS + w * 64) * 2 + g) * 64; const float* vp = p.VCS + (((long)n * NBS + w * 64) * 2 + g) * 64;
            stage_f32(wk, wv, kp, vp, 128, 64, lane);
            const bf16x8 kext[2] = {bias_kext(w * 64 + ql - NBS, 63, h), bias_kext(w * 64 + 32 + ql - NBS, 63, h)};
            tile_step_g<4, 2, 128, 128, true>(wk, wv, qf, o, st, m_run, l_run, LOG2E, kext, qext, -1000, 1000, ql, h);
        }
        const float f = combine_branch(lds, 0, w, ql, h, m_run, l_run, o, gc);
        if (mine) {
            LAS float* imp = (LAS float*)(lds + S_IMP) + tloc * 320;
#pragma unroll
            for (int sub = 0; sub < 2; ++sub)
#pragma unroll
                for (int i = 0; i < 16; ++i) {
                    float v = st[sub][i] * f;
                    v += __shfl_xor(v, 1); v += __shfl_xor(v, 2);
                    if (r == 0) imp[w * 64 + 32 * sub + (i & 3) + 8 * (i >> 2) + 4 * h] = v;
                }
        }
    }
    __syncthreads();
    {
        LAS float* sc = (LAS float*)(lds + S_IMP) + w * 320;
        float scq[5]; int rk[5];
#pragma unroll
        for (int q = 0; q < 5; ++q) {
            const int b = lane + 64 * q;
            const bool forced = (b == 0) || (b == NBS) || (b == NBS - 1);
            float v = -3e38f;
            if (b <= NBS) v = forced ? 1e9f : sc[b];
            scq[q] = v; rk[q] = 0;
        }
        asm volatile("s_waitcnt lgkmcnt(0)" ::: "memory");
#pragma unroll
        for (int q = 0; q < 5; ++q) sc[lane + 64 * q] = scq[q];
        asm volatile("s_waitcnt lgkmcnt(0)" ::: "memory");
        for (int j = 0; j <= NBS; ++j) {
            const float sj = sc[j];
#pragma unroll
            for (int q = 0; q < 5; ++q) rk[q] += (sj > scq[q] || (sj == scq[q] && j < lane + 64 * q)) ? 1 : 0;
        }
#pragma unroll
        for (int q = 0; q < 5; ++q) {
            const unsigned long long mk = __ballot(rk[q] < N_SEL && (lane + 64 * q) <= NBS);
            if (lane == 0) *(LAS unsigned long long*)(lds + S_MASK + (w * 8 + q) * 8) = mk;
        }
    }
    __syncthreads();
    {
#pragma unroll
        for (int db = 0; db < 2; ++db)
#pragma unroll
            for (int i = 0; i < 16; ++i) o[db][i] = 0.f;
        float m_run = NSA_NEG, l_run = 0.f;
        int k = 0;
        for (int q = 0; q < 5; ++q) {
            unsigned long long un = 0ull;
#pragma unroll
            for (int t = 0; t < 8; ++t) un |= *(const LAS unsigned long long*)(lds + S_MASK + (t * 8 + q) * 8);
            const unsigned lo32 = __builtin_amdgcn_readfirstlane((unsigned)un), hi32 = __builtin_amdgcn_readfirstlane((unsigned)(un >> 32));
            un = ((unsigned long long)hi32 << 32) | lo32;
            const unsigned long long mine_mask = *(const LAS unsigned long long*)(lds + S_MASK + (tloc * 8 + q) * 8);
            while (un) {
                const int bit = (int)__builtin_ctzll(un); un &= un - 1ull;
                const int b = 64 * q + bit;
                if ((k++ & 7) != w) continue;
                const float *kp, *vp; long stride; int nvalid;
                if (b < NBS) {
                    const long phys = pt[b / BPP];
                    kp = p.in[I_CACHE_KV] + (((phys * PAGE_SIZE + (long)(b % BPP) * 64) * 4 + 2) * 2 + g) * 64; vp = kp + 128; stride = 512; nvalid = 64;
                } else { kp = newrow + 256 + g * 64; vp = newrow + 384 + g * 64; stride = 768; nvalid = DEC_SEQ; }
                stage_f32(wk, wv, kp, vp, stride, nvalid, lane);
                const int kb0 = b * 64;
                const bool selb = (mine_mask >> bit) & 1ull;
                const bf16x8 kext[2] = {bias_kext(b - NBS, ql, h), bias_kext(b - NBS, 32 + ql, h)};
                tile_step_g<4, 2, 128, 128, true>(wk, wv, qf, o, st, m_run, l_run, LOG2E, kext, qext, -1000, selb ? (tq - kb0 - 4 * h) : -2000, ql, h);
            }
        }
        (void)combine_branch(lds, 1, w, ql, h, m_run, l_run, o, gs);
    }
    {
#pragma unroll
        for (int db = 0; db < 2; ++db)
#pragma unroll
            for (int i = 0; i < 16; ++i) o[db][i] = 0.f;
        float m_run = NSA_NEG, l_run = 0.f;
        for (int t = w; t < 9; t += 8) {
            const float *kp, *vp; long stride; int nvalid, kb0;
            if (t < 8) { kp = p.in[I_CACHE_WIN] + ((long)n * WBUF + 64 * t) * 256 + g * 64; vp = kp + 128; stride = 256; nvalid = 64; kb0 = PAST_LEN - WBUF + 64 * t; }
            else { kp = newrow + 512 + g * 64; vp = newrow + 640 + g * 64; stride = 768; nvalid = DEC_SEQ; kb0 = PAST_LEN; }
            stage_f32(wk, wv, kp, vp, stride, nvalid, lane);
            const bf16x8 kext[2] = {bias_kext((kb0 - t0) / 64, ql, h), bias_kext((kb0 - t0) / 64, 32 + ql, h)};
            tile_step_g<4, 2, 128, 128, true>(wk, wv, qf, o, st, m_run, l_run, LOG2E, kext, qext, tq - (WINDOW - 1) - kb0 - 4 * h, tq - kb0 - 4 * h, ql, h);
        }
        (void)combine_branch(lds, 2, w, ql, h, m_run, l_run, o, gw);
    }
    __syncthreads();
    for (int i = tid; i < 2048; i += 512) {
        const int row = i >> 6, d = i & 63, tl = row >> 2, rr = row & 3;
        const float v = ((const LAS float*)(lds + S_OACC))[i];
        const long mm = (long)MP + (long)n * DEC_SEQ + tl;
        p.MIXb[mm * MIX_W + (g * 4 + rr) * 64 + d] = f2bf(v);
    }
    __syncthreads();
}
static_assert(S_END <= 159744 - 256, "sample NSA LDS map");
__device__ __forceinline__ void sample_phase(const Params& p, LAS unsigned char* lds) {
    for (int u = blockIdx.x; u < DEC_BATCH * 2; u += gridDim.x) sample_unit(p, lds, u >> 1, u & 1);
}
}

namespace ew { __device__ __forceinline__ float wsum(float v); }
namespace rw {
typedef float f32x2 __attribute__((ext_vector_type(2)));
typedef float f32x4 __attribute__((ext_vector_type(4)));
constexpr int SB = 4, STEP_B = 6 * 64 * 4, SUB_B = SB * STEP_B, WAVE_B = 2 * SUB_B;
__device__ __forceinline__ void wave_sync() { asm volatile("s_waitcnt vmcnt(0) lgkmcnt(0)" ::: "memory"); }
__device__ __forceinline__ void lds_sync() { asm volatile("s_waitcnt lgkmcnt(0)" ::: "memory"); }
typedef unsigned u32x4_ __attribute__((ext_vector_type(4)));
struct StageRegs { f32x4 fr[3]; u32x4_ hr[2]; };
__device__ __forceinline__ void stage_issue(const Params& p, long m, int h, int lane, StageRegs& rg, bool skip_v = false) {
    const float* fb = p.RWB + m * 1536 + h * 64;
    const unsigned short* hb_ = p.RWH + m * 1536 + h * 64;
#pragma unroll
    for (int q = 0; q < 3; ++q) {
        const int idx = q * 64 + lane, seg = idx >> 4, f = idx & 15, st = seg / 3, vv = seg % 3;
        const int off = st * 1536 + vv * 512 + f * 4;
        rg.fr[q] = *(const f32x4*)(fb + off);
    }
#pragma unroll
    for (int q = 0; q < 2; ++q) {
        const int idx = q * 64 + lane, seg = idx >> 3, f8 = idx & 7, st = seg / 3, vv = seg % 3;
        const int off = st * 1536 + vv * 512 + f8 * 8;
        if (idx < 96) { if (skip_v && vv != 0) rg.hr[q] = (u32x4_){0u, 0u, 0u, 0u}; else rg.hr[q] = *(const u32x4_*)(hb_ + off); }
    }
}
__device__ __forceinline__ void stage_commit(LAS unsigned char* buf, int lane, const StageRegs& rg) {
#pragma unroll
    for (int q = 0; q < 3; ++q) {
        const int idx = q * 64 + lane, seg = idx >> 4, f = idx & 15, st = seg / 3, vv = seg % 3;
        *(LAS f32x4*)(buf + (st * 6 + 3 + vv) * 256 + f * 16) = rg.fr[q];
    }
#pragma unroll
    for (int q = 0; q < 2; ++q) {
        const int idx = q * 64 + lane, seg = idx >> 3, f8 = idx & 7, st = seg / 3, vv = seg % 3;
        if (idx < 96) {
            const u32x4_ r = rg.hr[q];
            LAS unsigned char* d = buf + (st * 6 + vv) * 256 + f8 * 32;
            *(LAS f32x4*)(d) = (f32x4){__uint_as_float(r[0] << 16), __uint_as_float(r[0] & 0xffff0000u), __uint_as_float(r[1] << 16), __uint_as_float(r[1] & 0xffff0000u)};
            *(LAS f32x4*)(d + 16) = (f32x4){__uint_as_float(r[2] << 16), __uint_as_float(r[2] & 0xffff0000u), __uint_as_float(r[3] << 16), __uint_as_float(r[3] & 0xffff0000u)};
        }
    }
}
template <int MODE>
__device__ __forceinline__ float step(const LAS unsigned char* sb, f32x2 (&S)[32], int lane, float vmul) {
    f32x2 a0 = {0.f, 0.f}, a1 = {0.f, 0.f};
#pragma unroll
    for (int jj = 0; jj < 16; ++jj) {
        const f32x4 k4 = *(const LAS f32x4*)(sb + 3 * 256 + jj * 16);
        a0 += S[2 * jj] * (f32x2){k4[0], k4[1]}; a1 += S[2 * jj + 1] * (f32x2){k4[2], k4[3]};
    }
    const float sa = -((a0[0] + a0[1]) + (a1[0] + a1[1]));
    const f32x2 sa2 = {sa, sa};
    float v = 0.f;
    if (MODE != 1) v = *(const LAS float*)(sb + 2 * 256 + lane * 4) * vmul;
    const f32x2 v2 = {v, v};
    f32x2 o0 = {0.f, 0.f}, o1 = {0.f, 0.f};
#pragma unroll
    for (int jj = 0; jj < 16; ++jj) {
        const f32x4 d4 = *(const LAS f32x4*)(sb + 5 * 256 + jj * 16), b4 = *(const LAS f32x4*)(sb + 4 * 256 + jj * 16);
        f32x2 t0 = sa2 * (f32x2){b4[0], b4[1]}, t1 = sa2 * (f32x2){b4[2], b4[3]};
        if (MODE != 1) {
            const f32x4 k4 = *(const LAS f32x4*)(sb + 1 * 256 + jj * 16);
            t0 += v2 * (f32x2){k4[0], k4[1]}; t1 += v2 * (f32x2){k4[2], k4[3]};
        }
        S[2 * jj] = S[2 * jj] * (f32x2){d4[0], d4[1]} + t0; S[2 * jj + 1] = S[2 * jj + 1] * (f32x2){d4[2], d4[3]} + t1;
        if (MODE == 2) {
            const f32x4 r4 = *(const LAS f32x4*)(sb + 0 * 256 + jj * 16);
            o0 += S[2 * jj] * (f32x2){r4[0], r4[1]}; o1 += S[2 * jj + 1] * (f32x2){r4[2], r4[3]};
        }
    }
    return (o0[0] + o0[1]) + (o1[0] + o1[1]);
}
template <int MODE>
__device__ __forceinline__ void run(const Params& p, LAS unsigned char* wl, long m0, int h, int T, f32x2 (&S)[32], int lane, float vmul, float* odst) {
    StageRegs rg;
    stage_issue(p, m0, h, lane, rg); stage_commit(wl, lane, rg); wave_sync();
    const int nsb = T / SB;
    for (int sbi = 0; sbi < nsb; ++sbi) {
        const bool more = sbi + 1 < nsb;
        if (more) stage_issue(p, m0 + (long)(sbi + 1) * SB, h, lane, rg);
        const LAS unsigned char* cur = wl + (sbi & 1) * SUB_B;
#pragma unroll 1
        for (int st = 0; st < SB; ++st) {
            __builtin_amdgcn_sched_barrier(0);
            const float o = step<MODE>(cur + st * STEP_B, S, lane, vmul);
            if (MODE == 2) odst[(m0 + (long)sbi * SB + st) * 512 + h * 64 + lane] = o;
        }
        if (more) stage_commit(wl + ((sbi + 1) & 1) * SUB_B, lane, rg);
        wave_sync();
    }
}
__device__ __forceinline__ void load_rows(const float* src, f32x2 (&S)[32]) {
#pragma unroll
    for (int q = 0; q < 16; ++q) { const f32x4 v = *(const f32x4*)(src + q * 4); S[2 * q] = (f32x2){v[0], v[1]}; S[2 * q + 1] = (f32x2){v[2], v[3]}; }
}
__device__ __forceinline__ void store_rows(float* dst, const f32x2 (&S)[32]) {
#pragma unroll
    for (int q = 0; q < 16; ++q) *(f32x4*)(dst + q * 4) = (f32x4){S[2 * q][0], S[2 * q][1], S[2 * q + 1][0], S[2 * q + 1][1]};
}
typedef float f32x16 __attribute__((ext_vector_type(16)));
#define RW_MFMA(a, b, c) __builtin_amdgcn_mfma_f32_32x32x2f32((a), (b), (c), 0, 0, 0)
#define RW_PAIR(v, q) ((f32x2){(v)[2 * (q)], (v)[2 * (q) + 1]})
template <int NCT>
__device__ __forceinline__ void step_t(const LAS unsigned char* sb, f32x16 (&T)[2][NCT], int lane, float (&outv)[NCT], float vmul) {
    const int h = lane >> 5, l31 = lane & 31;
    const LAS unsigned char* hb = sb + 16 * h;
    f32x4 kv[2][4], dv[2][4], rv[2][4]; float aop[2], vv[NCT];
#pragma unroll
    for (int rt = 0; rt < 2; ++rt)
#pragma unroll
        for (int gq = 0; gq < 4; ++gq) kv[rt][gq] = *(const LAS f32x4*)(hb + 3 * 256 + (32 * rt + 8 * gq) * 4);
#pragma unroll
    for (int ct = 0; ct < NCT; ++ct) vv[ct] = *(const LAS float*)(sb + 2 * 256 + (32 * (ct & 1) + l31) * 4);
#pragma unroll
    for (int rt = 0; rt < 2; ++rt) aop[rt] = *(const LAS float*)(sb + (h ? 1 * 256 : 4 * 256) + (32 * rt + l31) * 4);
    if (NCT <= 2) {
#pragma unroll
        for (int rt = 0; rt < 2; ++rt)
#pragma unroll
            for (int gq = 0; gq < 4; ++gq) { dv[rt][gq] = *(const LAS f32x4*)(hb + 5 * 256 + (32 * rt + 8 * gq) * 4); rv[rt][gq] = *(const LAS f32x4*)(hb + 0 * 256 + (32 * rt + 8 * gq) * 4); }
    }
    __builtin_amdgcn_sched_barrier(0);
    f32x2 pa[NCT], pb_[NCT];
#pragma unroll
    for (int ct = 0; ct < NCT; ++ct) { pa[ct] = (f32x2){0.f, 0.f}; pb_[ct] = (f32x2){0.f, 0.f}; }
#pragma unroll
    for (int rt = 0; rt < 2; ++rt)
#pragma unroll
        for (int gq = 0; gq < 4; ++gq) {
            const f32x2 klo = {kv[rt][gq][0], kv[rt][gq][1]}, khi = {kv[rt][gq][2], kv[rt][gq][3]};
#pragma unroll
            for (int ct = 0; ct < NCT; ++ct) { pa[ct] += RW_PAIR(T[rt][ct], 2 * gq) * klo; pb_[ct] += RW_PAIR(T[rt][ct], 2 * gq + 1) * khi; }
        }
    float bop[NCT];
#pragma unroll
    for (int ct = 0; ct < NCT; ++ct) {
        const float sa = -xhalf_sum((pa[ct][0] + pa[ct][1]) + (pb_[ct][0] + pb_[ct][1]));
        bop[ct] = h ? (ct < 2 ? vv[ct] * vmul : 0.f) : sa;
    }
    if (NCT > 2) {
#pragma unroll
        for (int rt = 0; rt < 2; ++rt)
#pragma unroll
            for (int gq = 0; gq < 4; ++gq) dv[rt][gq] = *(const LAS f32x4*)(hb + 5 * 256 + (32 * rt + 8 * gq) * 4);
        __builtin_amdgcn_sched_barrier(0);
    }
#pragma unroll
    for (int rt = 0; rt < 2; ++rt)
#pragma unroll
        for (int gq = 0; gq < 4; ++gq) {
            const f32x2 dlo = {dv[rt][gq][0], dv[rt][gq][1]}, dhi = {dv[rt][gq][2], dv[rt][gq][3]};
#pragma unroll
            for (int ct = 0; ct < NCT; ++ct) {
                const f32x2 x = RW_PAIR(T[rt][ct], 2 * gq) * dlo, y = RW_PAIR(T[rt][ct], 2 * gq + 1) * dhi;
                T[rt][ct][4 * gq] = x[0]; T[rt][ct][4 * gq + 1] = x[1]; T[rt][ct][4 * gq + 2] = y[0]; T[rt][ct][4 * gq + 3] = y[1];
            }
        }
    if (NCT > 2) {
#pragma unroll
        for (int rt = 0; rt < 2; ++rt)
#pragma unroll
            for (int gq = 0; gq < 4; ++gq) rv[rt][gq] = *(const LAS f32x4*)(hb + 0 * 256 + (32 * rt + 8 * gq) * 4);
    }
#pragma unroll
    for (int rt = 0; rt < 2; ++rt)
#pragma unroll
        for (int ct = 0; ct < NCT; ++ct) T[rt][ct] = RW_MFMA(aop[rt], bop[ct], T[rt][ct]);
#pragma unroll
    for (int ct = 0; ct < NCT; ++ct) { pa[ct] = (f32x2){0.f, 0.f}; pb_[ct] = (f32x2){0.f, 0.f}; }
#pragma unroll
    for (int rt = 0; rt < 2; ++rt)
#pragma unroll
        for (int gq = 0; gq < 4; ++gq) {
            const f32x2 rlo = {rv[rt][gq][0], rv[rt][gq][1]}, rhi = {rv[rt][gq][2], rv[rt][gq][3]};
#pragma unroll
            for (int ct = 0; ct < NCT; ++ct) { pa[ct] += RW_PAIR(T[rt][ct], 2 * gq) * rlo; pb_[ct] += RW_PAIR(T[rt][ct], 2 * gq + 1) * rhi; }
        }
#pragma unroll
    for (int ct = 0; ct < NCT; ++ct) outv[ct] = xhalf_sum((pa[ct][0] + pa[ct][1]) + (pb_[ct][0] + pb_[ct][1]));
}
__device__ __forceinline__ void pass1(const Params& p, LAS unsigned char* lds) {
    const int tid = opaque_tid(), lane = tid & 63, w = __builtin_amdgcn_readfirstlane(tid >> 6);
    LAS unsigned char* wl = lds + w * WAVE_B;
    const int npr = BATCH * 8 * NCH * 2, ntask = npr + DEC_BATCH * 8;
    for (int task = w * (int)gridDim.x + (int)blockIdx.x; task < ntask; task += gridDim.x * 8) {
        StageRegs rg;
        int lq = lane; asm volatile("" : "+v"(lq));
        const int h = lq >> 5, l31 = lq & 31;
        if (task < npr) {
            const int kind = task & 1, ct_ = task >> 1, c = ct_ % NCH, sh = ct_ / NCH, hd = sh % 8, sq = sh / 8;
            const long m0 = (long)sq * SEQ + (long)c * RC;
            f32x16 T[2][2];
#pragma unroll
            for (int rt = 0; rt < 2; ++rt)
#pragma unroll
                for (int ct = 0; ct < 2; ++ct)
#pragma unroll
                    for (int rg_ = 0; rg_ < 16; ++rg_)
                        T[rt][ct][rg_] = (kind == 1 && (32 * rt + (rg_ & 3) + 8 * (rg_ >> 2) + 4 * h) == (32 * ct + l31)) ? 1.f : 0.f;
            const float vmul = kind == 0 ? 1.f : 0.f;
            float* odst = kind == 0 ? p.RO : p.RHO;
            stage_issue(p, m0, hd, lane, rg, kind == 1); stage_commit(wl, lane, rg); lds_sync();
            constexpr int nsb = RC / SB;
            for (int sbi = 0; sbi < nsb; ++sbi) {
                const bool more = sbi + 1 < nsb;
                if (more) stage_issue(p, m0 + (long)(sbi + 1) * SB, hd, lane, rg, kind == 1);
                const LAS unsigned char* cur = wl + (sbi & 1) * SUB_B;
#pragma unroll 1
                for (int st = 0; st < SB; ++st) {
                    float ov[2];
                    step_t<2>(cur + st * STEP_B, T, lane, ov, vmul);
                    odst[(m0 + (long)sbi * SB + st) * 512 + hd * 64 + lane] = h ? ov[1] : ov[0];
                }
                if (more) stage_commit(wl + ((sbi + 1) & 1) * SUB_B, lane, rg);
                lds_sync();
            }
            float* lt = (kind == 0 ? p.RLC : p.RPC) + (long)ct_ * 4096 + (4 * h) * 64 + l31;
#pragma unroll
            for (int rt = 0; rt < 2; ++rt)
#pragma unroll
                for (int cc = 0; cc < 2; ++cc)
#pragma unroll
                    for (int rg_ = 0; rg_ < 16; ++rg_) lt[(32 * rt + (rg_ & 3) + 8 * (rg_ >> 2)) * 64 + 32 * cc] = T[rt][cc][rg_];
        } else {
            const int sh = task - npr, hd = sh % 8, n = sh / 8;
            const long m0 = (long)MP + (long)n * DEC_SEQ;
            const float* s0 = p.in[I_STATE_S] + (long)sh * 4096;
            f32x16 T[2][2];
#pragma unroll
            for (int rt = 0; rt < 2; ++rt)
#pragma unroll
                for (int ct = 0; ct < 2; ++ct)
#pragma unroll
                    for (int gq = 0; gq < 4; ++gq) {
                        const f32x4 v = *(const f32x4*)(s0 + l31 * 64 + 4 * h + ((32 * ct) * 64 + 32 * rt + 8 * gq));
#pragma unroll
                        for (int e = 0; e < 4; ++e) T[rt][ct][4 * gq + e] = v[e];
                    }
            constexpr int nsb = DEC_SEQ / SB;
            for (int sbi = 0; sbi < nsb; ++sbi) {
                stage_issue(p, m0 + (long)sbi * SB, hd, lane, rg); stage_commit(wl, lane, rg); lds_sync();
#pragma unroll 1
                for (int st = 0; st < SB; ++st) {
                    float ov[2];
                    step_t<2>(wl + st * STEP_B, T, lane, ov, 1.f);
                    p.RO[(m0 + (long)sbi * SB + st) * 512 + hd * 64 + lane] = h ? ov[1] : ov[0];
                }
                lds_sync();
            }
            float* so = p.out + O_RS_S + (long)sh * 4096;
#pragma unroll
            for (int rt = 0; rt < 2; ++rt)
#pragma unroll
                for (int ct = 0; ct < 2; ++ct)
#pragma unroll
                    for (int gq = 0; gq < 4; ++gq)
                        *(f32x4*)(so + l31 * 64 + 4 * h + ((32 * ct) * 64 + 32 * rt + 8 * gq)) = (f32x4){T[rt][ct][4 * gq], T[rt][ct][4 * gq + 1], T[rt][ct][4 * gq + 2], T[rt][ct][4 * gq + 3]};
        }
    }
}
constexpr int PT_ROW = 65 * 4, PT_B = 64 * PT_ROW;
__device__ __forceinline__ void pass2(const Params& p, LAS unsigned char* lds) {
    const int tid = opaque_tid(), lane = tid & 63, w = __builtin_amdgcn_readfirstlane(tid >> 6), h = lane >> 5, l31 = lane & 31;
    const int pr = w >> 1, ct = w & 1;
    for (int sh0 = ((int)gridDim.x - 1 - (int)blockIdx.x) * 4; sh0 < BATCH * 8; sh0 += gridDim.x * 4) {
        const int sh = sh0 + pr; const bool act = sh < BATCH * 8;
        LAS unsigned char* pb = lds + pr * PT_B;
        f32x16 S[2];
#pragma unroll
        for (int kt = 0; kt < 2; ++kt)
#pragma unroll
            for (int t = 0; t < 16; ++t) S[kt][t] = 0.f;
        f32x4 pg[8];
        const long cbase = (long)(act ? sh : 0) * NCH;
        auto issue = [&](long ctk) {
#pragma unroll
            for (int q = 0; q < 8; ++q) { const int idx = q * 64 + lane; pg[q] = *(const f32x4*)(p.RPC + ctk * 4096 + (32 * ct + (idx >> 4)) * 64 + (idx & 15) * 4); }
        };
        auto commit = [&]() {
#pragma unroll
            for (int q = 0; q < 8; ++q) {
                const int idx = q * 64 + lane; LAS float* d = (LAS float*)(pb + (32 * ct + (idx >> 4)) * PT_ROW) + (idx & 15) * 4;
                d[0] = pg[q][0]; d[1] = pg[q][1]; d[2] = pg[q][2]; d[3] = pg[q][3];
            }
        };
        issue(cbase);
        for (int c = 0; c < NCH; ++c) {
            const long ctk = cbase + c;
            __syncthreads();
            commit();
            if (act) {
                float* ss = p.RSS + ctk * 4096 + (4 * h) * 64 + 32 * ct + l31;
#pragma unroll
                for (int kt = 0; kt < 2; ++kt)
#pragma unroll
                    for (int t = 0; t < 16; ++t) ss[(32 * kt + (t & 3) + 8 * (t >> 2)) * 64] = S[kt][t];
            }
            __syncthreads();
            if (c + 1 < NCH) issue(ctk + 1);
            f32x16 N[2];
            const float* lt = p.RLC + ctk * 4096 + (4 * h) * 64 + 32 * ct + l31;
#pragma unroll
            for (int rt = 0; rt < 2; ++rt)
#pragma unroll
                for (int t = 0; t < 16; ++t) N[rt][t] = lt[(32 * rt + (t & 3) + 8 * (t >> 2)) * 64];
#pragma unroll
            for (int rt = 0; rt < 2; ++rt)
#pragma unroll
                for (int kt = 0; kt < 2; ++kt) {
                    __builtin_amdgcn_sched_barrier(0);
#pragma unroll
                    for (int t = 0; t < 16; ++t) {
                        const float a = *(const LAS float*)(pb + l31 * PT_ROW + 16 * h + ((32 * rt) * PT_ROW + (32 * kt + (t & 3) + 8 * (t >> 2)) * 4));
                        N[rt] = RW_MFMA(a, S[kt][t], N[rt]);
                    }
                }
#pragma unroll
            for (int rt = 0; rt < 2; ++rt) S[rt] = N[rt];
        }
        if (act) {
            float* so = p.out + O_RS_P + (long)sh * 4096;
#pragma unroll
            for (int kt = 0; kt < 2; ++kt)
#pragma unroll
                for (int gq = 0; gq < 4; ++gq)
                    *(f32x4*)(so + (32 * ct + l31) * 64 + 4 * h + (32 * kt + 8 * gq)) = (f32x4){S[kt][4 * gq], S[kt][4 * gq + 1], S[kt][4 * gq + 2], S[kt][4 * gq + 3]};
        }
        __syncthreads();
    }
}
__device__ __forceinline__ void pass3(const Params& p, LAS unsigned char* lds) {
    const int tid = opaque_tid(), lane = tid & 63, w = __builtin_amdgcn_readfirstlane(tid >> 6);
    LAS unsigned char* wl = lds + w * WAVE_B;
    const int npr = BATCH * 8 * NCH;
    const int skip = ((int)gridDim.x > 2 * DEC_BATCH * 2) ? DEC_BATCH * 2 : 0, gw = (int)gridDim.x - skip;
    if ((int)blockIdx.x < skip) return;
    for (int task = w * gw + ((int)blockIdx.x - skip); task < npr; task += gw * 8) {
        const int ct = task, c = ct % NCH, sh = ct / NCH, hd = sh % 8, sq = sh / 8;
        const long m0 = (long)sq * SEQ + (long)c * RC;
        f32x2 S[32];
        const float* st0 = p.RSS + (long)ct * 4096 + lane;
#pragma unroll
        for (int q = 0; q < 32; ++q) S[q] = (f32x2){st0[(2 * q) * 64], st0[(2 * q + 1) * 64]};
        f32x4 rg[4];
        auto issue = [&](int sbi) {
#pragma unroll
            for (int q = 0; q < 4; ++q) { const int idx = q * 64 + lane; rg[q] = *(const f32x4*)(p.RHO + (m0 + sbi * 16 + (idx >> 4)) * 512 + hd * 64 + (idx & 15) * 4); }
        };
        auto commit = [&](int buf) {
#pragma unroll
            for (int q = 0; q < 4; ++q) *(LAS f32x4*)(wl + buf * 4096 + (q * 64 + lane) * 16) = rg[q];
        };
        issue(0); commit(0); wave_sync();
        constexpr int nsb = RC / 16;
        for (int sbi = 0; sbi < nsb; ++sbi) {
            const bool more = sbi + 1 < nsb;
            if (more) issue(sbi + 1);
            const LAS unsigned char* cur = wl + (sbi & 1) * 4096;
#pragma unroll 2
            for (int st = 0; st < 16; ++st) {
                const long o = (m0 + sbi * 16 + st) * 512 + hd * 64 + lane;
                f32x2 a0 = {p.RO[o], 0.f}, a1 = {0.f, 0.f};
#pragma unroll
                for (int jj = 0; jj < 16; ++jj) {
                    const f32x4 r4 = *(const LAS f32x4*)(cur + st * 256 + jj * 16);
                    a0 += S[2 * jj] * (f32x2){r4[0], r4[1]}; a1 += S[2 * jj + 1] * (f32x2){r4[2], r4[3]};
                }
                p.RO[o] = (a0[0] + a0[1]) + (a1[0] + a1[1]);
            }
            if (more) commit((sbi + 1) & 1);
            wave_sync();
        }
    }
}
}

namespace ew {
__device__ __forceinline__ float wsum(float v) {
    v += __shfl_xor(v, 1); v += __shfl_xor(v, 2); v += __shfl_xor(v, 4); v += __shfl_xor(v, 8); v += __shfl_xor(v, 16); v += __shfl_xor(v, 32);
    return v;
}
#define EW_WAVES(ntask) for (long task = (long)blockIdx.x * 8 + w; task < (ntask); task += (long)gridDim.x * 8)
__device__ __forceinline__ float gsum16(float v) { v += __shfl_xor(v, 1); v += __shfl_xor(v, 2); v += __shfl_xor(v, 4); v += __shfl_xor(v, 8); return v; }
typedef float f32x4 __attribute__((ext_vector_type(4)));
typedef unsigned u32x2 __attribute__((ext_vector_type(2)));
__device__ __forceinline__ u32x2 pk4(f32x4 v) { u32x2 r; r[0] = pg8::cvt_pk_bf16(v[0], v[1]); r[1] = pg8::cvt_pk_bf16(v[2], v[3]); return r; }
__device__ __forceinline__ void p_post(const Params& p, long mbase, long ntok) {
    const int tid = opaque_tid(), lane = tid & 63, w = __builtin_amdgcn_readfirstlane(tid >> 6);
    const int d4 = (lane & 15) * 4;
    EW_WAVES(ntok) {
        const long m = mbase + task; const bool smp = m >= MP;
        const int n = tok_seq(m), i = tok_i(m);
        const float* row = p.P + m * IN_COLS;
        f32x4 x[13];
#pragma unroll
        for (int k = 0; k < 13; ++k) { const int f = lane + 64 * k; x[k] = (f < IN_COLS / 4) ? *(const f32x4*)(row + 4 * f) : (f32x4){0.f, 0.f, 0.f, 0.f}; }
        const int fl = 710 + lane;
        f32x4 prev = {0.f, 0.f, 0.f, 0.f};
        if (i > 0) prev = *(const f32x4*)(row - IN_COLS + 4 * fl);
        else if (smp) prev = *(const f32x4*)(p.in[I_STATE_SHIFT] + (long)n * RWKV_COLS + 1536 + 4 * lane);
        const f32x4 cur = *(const f32x4*)(row + 4 * fl);
        const f32x4 mu = *(const f32x4*)(p.in[I_MU] + 1536 + 4 * lane);
        const f32x4 qg = *(const f32x4*)(p.in[I_Q_G] + d4);
#pragma unroll
        for (int k = 0; k < 2; ++k) {
            const f32x4 v = x[k];
            const float r = 1.f / sqrtf(gsum16(v[0] * v[0] + v[1] * v[1] + v[2] * v[2] + v[3] * v[3]) * (1.f / 64.f) + RMS_EPS);
            const f32x4 qn = v * r * qg;
            const long o = m * 512 + 256 * k + 4 * lane;
            *(f32x4*)(p.QN + o) = qn;
            *(u32x2*)(p.QNb + o) = pk4(qn * 0.125f);
        }
        const int hv = lane >> 5, g = (lane >> 4) & 1;
#pragma unroll
        for (int k = 2; k < 5; ++k) {
            f32x4 v = x[k];
            const float ssq = gsum16(v[0] * v[0] + v[1] * v[1] + v[2] * v[2] + v[3] * v[3]);
            if (k >= 3 && hv == 0) {
                const f32x4 gn = *(const f32x4*)((k == 3 ? p.in[I_KS_G] : p.in[I_KW_G]) + d4);
                v = v * (1.f / sqrtf(ssq * (1.f / 64.f) + RMS_EPS)) * gn;
            }
            const int cc = (k - 2) * 256 + 4 * lane;
            *(f32x4*)(p.KVW + m * 768 + cc) = v;
            if (k < 4) *(f32x4*)(p.out + (smp ? O_KV_S + (m - MP) * 512 : O_KV_P + m * 512) + cc) = v;
            else if (smp) *(f32x4*)(p.out + O_WIN_S + ((long)n * WBUF + (WBUF - DEC_SEQ + i)) * 256 + cc - 512) = v;
            else if (i >= SEQ - WP) *(f32x4*)(p.out + O_WIN_P + ((long)n * WP + (i - (SEQ - WP))) * 256 + cc - 512) = v;
            if (!smp && k >= 3) {
                unsigned short* dst = k == 3 ? (hv == 0 ? p.KSb : p.VSb) : (hv == 0 ? p.KWb : p.VWb);
                *(u32x2*)(dst + (((long)n * 2 + g) * SEQ + i) * 64 + d4) = pk4(v);
            }
        }
        if (lane < 6) {
            const f32x4 gb = *(const f32x4*)(p.in[I_GATE_B] + 4 * lane);
            f32x4 gv; gv[0] = sigmoidf_(x[5][0] + gb[0]); gv[1] = sigmoidf_(x[5][1] + gb[1]); gv[2] = sigmoidf_(x[5][2] + gb[2]); gv[3] = sigmoidf_(x[5][3] + gb[3]);
            *(f32x4*)(p.GT + m * 24 + 4 * lane) = gv;
        }
#pragma unroll
        for (int k = 5; k < 13; ++k) { const int f = lane + 64 * k; if (f >= 326 && f < IN_COLS / 4) *(u32x2*)(p.PRb + m * RWKV_COLS + 4 * (f - 326)) = pk4(x[k]); }
        if (i == (smp ? DEC_SEQ : SEQ) - 1) {
            float* so = p.out + (smp ? O_SH_S : O_SH_P) + (long)n * RWKV_COLS;
#pragma unroll
            for (int k = 5; k < 13; ++k) { const int f = lane + 64 * k; if (f >= 326 && f < IN_COLS / 4) *(f32x4*)(so + 4 * (f - 326)) = x[k]; }
        }
        {
            const f32x4 xs = cur + (prev - cur) * mu;
            f32x4 lv;
#pragma unroll
            for (int e = 0; e < 4; ++e) lv[e] = (lane < 16) ? tanhf(xs[e]) : (lane < 32 ? xs[e] : sigmoidf_(xs[e]));
            *(f32x4*)(p.LIN + m * 256 + 4 * lane) = lv;
            *(u32x2*)(p.LINb + m * 256 + 4 * lane) = pk4(lv);
        }
    }
}
typedef unsigned short us4 __attribute__((ext_vector_type(4)));
__device__ __forceinline__ f32x4 ld_bf4(const unsigned short* q) { const u32x2 r = *(const u32x2*)q; f32x4 o; o[0] = __uint_as_float(r[0] << 16); o[1] = __uint_as_float(r[0] & 0xffff0000u); o[2] = __uint_as_float(r[1] << 16); o[3] = __uint_as_float(r[1] & 0xffff0000u); return o; }
__device__ __forceinline__ void lin_prep(const Params& p) {
    const int tid = opaque_tid(), lane = tid & 63, w = __builtin_amdgcn_readfirstlane(tid >> 6);
    EW_WAVES(MP) {
        const long m = task; const int i = (int)(m % SEQ);
        const f32x4 cur = ld_bf4(p.PRb + m * RWKV_COLS + 1536 + 4 * lane);
        f32x4 prev = {0.f, 0.f, 0.f, 0.f};
        if (i > 0) prev = ld_bf4(p.PRb + (m - 1) * RWKV_COLS + 1536 + 4 * lane);
        const f32x4 xs = cur + (prev - cur) * *(const f32x4*)(p.in[I_MU] + 1536 + 4 * lane);
        f32x4 lv;
#pragma unroll
        for (int e = 0; e < 4; ++e) lv[e] = (lane < 16) ? fast_tanh(xs[e]) : (lane < 32 ? xs[e] : fast_sigmoid(xs[e]));
        *(u32x2*)(p.LINb + m * 256 + 4 * lane) = pk4(lv);
    }
}
__device__ __forceinline__ void prep2(const Params& p) {
    const int tid = opaque_tid(), lane = tid & 63, w = __builtin_amdgcn_readfirstlane(tid >> 6);
    EW_WAVES(M_TOK) {
        const long m = task; const bool smp = m >= MP;
        const int n = tok_seq(m), i = tok_i(m);
        const unsigned short* row = p.PRb + m * RWKV_COLS;
        const unsigned short* dq = p.DWb + m * 1536;
        float* rb = p.RWB + m * 3 * 512; unsigned short* rh = p.RWH + m * 3 * 512;
#pragma unroll
        for (int k = 0; k < 2; ++k) {
            const int c = 256 * k + 4 * lane;
            f32x4 xs[3];
#pragma unroll
            for (int s = 0; s < 3; ++s) {
                const f32x4 cur = ld_bf4(row + 512 * s + c);
                f32x4 prev = {0.f, 0.f, 0.f, 0.f};
                if (i > 0) prev = ld_bf4(row - RWKV_COLS + 512 * s + c);
                else if (smp) prev = *(const f32x4*)(p.in[I_STATE_SHIFT] + (long)n * RWKV_COLS + 512 * s + c);
                xs[s] = cur + (prev - cur) * *(const f32x4*)(p.in[I_MU] + 512 * s + c);
            }
            const f32x4 dw = *(const f32x4*)(p.in[I_W0] + c) + ld_bf4(dq + c), da = *(const f32x4*)(p.in[I_A0] + c) + ld_bf4(dq + 512 + c);
            const f32x4 dg = ld_bf4(dq + 1024 + c);
            const f32x4 kkw = *(const f32x4*)(p.in[I_K_K] + c), kaw = *(const f32x4*)(p.in[I_K_A] + c);
            f32x4 decay, a, kkr, kh;
#pragma unroll
            for (int e = 0; e < 4; ++e) {
                decay[e] = __expf(-0.6065306597126334f * fast_sigmoid(dw[e]));
                a[e] = fast_sigmoid(da[e]);
                kkr[e] = xs[1][e] * kkw[e];
                kh[e] = xs[1][e] * (1.f + (a[e] - 1.f) * kaw[e]);
            }
            const float inv = 1.f / sqrtf(fmaxf(gsum16(kkr[0] * kkr[0] + kkr[1] * kkr[1] + kkr[2] * kkr[2] + kkr[3] * kkr[3]), 1e-24f));
            const f32x4 kk = kkr * inv;
            *(u32x2*)(rh + 0 * 512 + c) = pk4(xs[0]); *(u32x2*)(rh + 1 * 512 + c) = pk4(kh); *(u32x2*)(rh + 2 * 512 + c) = pk4(xs[2]);
            *(f32x4*)(rb + 0 * 512 + c) = kk; *(f32x4*)(rb + 1 * 512 + c) = kk * a; *(f32x4*)(rb + 2 * 512 + c) = decay;
            *(u32x2*)(p.GGb + m * 512 + c) = pk4(dg);
            const f32x4 rk = *(const f32x4*)(p.in[I_R_K] + c); const f32x4 t = xs[0] * kh * rk;
            const float bonus = gsum16(t[0] + t[1] + t[2] + t[3]);
            if ((lane & 15) == 0) p.BON[m * 8 + 4 * k + (lane >> 4)] = bonus;
        }
    }
}
__device__ __forceinline__ void rwkv_post(const Params& p, long mbase, long ntok) {
    const int tid = opaque_tid(), lane = tid & 63, w = __builtin_amdgcn_readfirstlane(tid >> 6);
    EW_WAVES(ntok) {
        const long m = mbase + task;
        const unsigned short* rh = p.RWH + m * 3 * 512;
#pragma unroll
        for (int k = 0; k < 2; ++k) {
            const int c = 256 * k + 4 * lane;
            const f32x4 ro = *(const f32x4*)(p.RO + m * 512 + c);
            const f32x4 v = ld_bf4(rh + 1024 + c);
            const f32x4 lg = *(const f32x4*)(p.in[I_LNX_G] + c), lb = *(const f32x4*)(p.in[I_LNX_B] + c);
            const f32x4 gg = ld_bf4(p.GGb + m * 512 + c);
            const float mean = gsum16(ro[0] + ro[1] + ro[2] + ro[3]) * (1.f / 64.f);
            const f32x4 dv = ro - mean;
            const float var = gsum16(dv[0] * dv[0] + dv[1] * dv[1] + dv[2] * dv[2] + dv[3] * dv[3]) * (1.f / 64.f);
            const float rstd = 1.f / sqrtf(var + LNX_EPS);
            const float bonus = p.BON[m * 8 + 4 * k + (lane >> 4)];
            const f32x4 o = (dv * rstd * lg + lb + v * bonus) * gg;
            *(u32x2*)(p.MIXb + m * MIX_W + 512 + c) = pk4(o);
        }
    }
}
__device__ __forceinline__ void memkv_post(const Params& p) {
    const int tid = opaque_tid(), lane = tid & 63, w = __builtin_amdgcn_readfirstlane(tid >> 6);
    EW_WAVES((long)MEMROWS * 4) {
        const long r = task >> 2; const int h = (int)(task & 3); const long n = r / N_MEM, j = r % N_MEM;
        float* kp = p.out + O_MKV + r * 1024 + h * 128; const float* vp = kp + 512;
        const float k0 = kp[lane], k1 = kp[lane + 64];
        const float rr = 1.f / sqrtf(wsum(k0 * k0 + k1 * k1) * (1.f / 128.f) + RMS_EPS);
        const float a0 = k0 * rr * p.in[I_XK_G][lane], a1 = k1 * rr * p.in[I_XK_G][lane + 64];
        kp[lane] = a0; kp[lane + 64] = a1;
        const long o = ((n * 4 + h) * N_MEM + j) * 128;
        p.XKb[o + lane] = f2bf(a0); p.XKb[o + lane + 64] = f2bf(a1);
        p.XVb[o + lane] = f2bf(vp[lane]); p.XVb[o + lane + 64] = f2bf(vp[lane + 64]);
    }
}
__device__ __forceinline__ void memkv_cache_cvt(const Params& p) {
    const int tid = opaque_tid(), lane = tid & 63, w = __builtin_amdgcn_readfirstlane(tid >> 6);
    EW_WAVES((long)DEC_BATCH * N_MEM * 4) {
        const long r = task >> 2; const int h = (int)(task & 3); const long n = r / N_MEM, j = r % N_MEM;
        const float* kp = p.in[I_CACHE_MEM] + r * 1024 + h * 128; const float* vp = kp + 512;
        const long o = ((n * 4 + h) * N_MEM + j) * 128;
        p.XKSb[o + lane] = f2bf(kp[lane]); p.XKSb[o + lane + 64] = f2bf(kp[lane + 64]);
        p.XVSb[o + lane] = f2bf(vp[lane]); p.XVSb[o + lane + 64] = f2bf(vp[lane + 64]);
    }
}
__device__ __forceinline__ void cmp_out(const Params& p, LAS unsigned char* lds) {
    const int tid = opaque_tid(), lane = tid & 63, w = __builtin_amdgcn_readfirstlane(tid >> 6);
    LAS float* wl = (LAS float*)lds;
    __syncthreads();
    for (int i = tid; i < 2 * 2048; i += 512) {
        const f32x4 v = *(const f32x4*)((i < 2048 ? p.in[I_W_CK2] : p.in[I_W_CV2]) + (i & 2047) * 4);
        *(LAS f32x4*)(wl + i * 4) = v;
    }
    __syncthreads();
    EW_WAVES((long)N_CBLK * 2 * 2) {
        const int c = (int)(task & 1); const long R = task >> 1; const long bu = R >> 1; const int g = (int)(R & 1);
        const LAS float* w2 = wl + c * 8192 + lane;
        const float* hp = p.CH + (R * 2 + c) * 128;
        const float h0 = hp[lane], h1 = hp[lane + 64];
        float o0 = 0.f, o1 = 0.f, o2 = 0.f, o3 = 0.f;
#pragma unroll 8
        for (int k = 0; k < 64; k += 2) {
            o0 += __int_as_float(__builtin_amdgcn_readlane(__float_as_int(h0), k)) * w2[k * 64]; o1 += __int_as_float(__builtin_amdgcn_readlane(__float_as_int(h0), k + 1)) * w2[(k + 1) * 64];
            o2 += __int_as_float(__builtin_amdgcn_readlane(__float_as_int(h1), k)) * w2[(k + 64) * 64]; o3 += __int_as_float(__builtin_amdgcn_readlane(__float_as_int(h1), k + 1)) * w2[(k + 65) * 64];
        }
        float o = (o0 + o1) + (o2 + o3);
        const bool prm = bu < (long)BATCH * NBP; const long nn = bu / NBP, bb = bu % NBP;
        if (c == 0) o = o * (1.f / sqrtf(wsum(o * o) * (1.f / 64.f) + RMS_EPS)) * p.in[I_KC_G][lane];
        float* dst = prm ? (c == 0 ? p.KCP : p.VCP) + (bu * 2 + g) * 64 : (c == 0 ? p.KCS : p.VCS) + ((bu - (long)BATCH * NBP) * 2 + g) * 64;
        dst[lane] = o;
        if (prm) { if (c == 0) p.KCb[((nn * 2 + g) * NBP + bb) * 64 + lane] = f2bf(o); else p.VCt[((nn * 2 + g) * 64 + lane) * NBP + bb] = f2bf(o); }
    }
    __syncthreads();
}
__device__ __forceinline__ void copy_rows(const Params& p) {
    const int tid = opaque_tid(), lane = tid & 63, w = __builtin_amdgcn_readfirstlane(tid >> 6);
    static_assert(D_MODEL == 1024, "copy_rows row width");
    EW_WAVES(M_TOK) {
        const long m = task;
        const float* src = m < MP ? p.in[I_X_PROMPT] + m * D_MODEL : p.in[I_X_SAMPLE] + (m - MP) * D_MODEL;
        f32x4 v[4]; float ss = 0.f;
#pragma unroll
        for (int k = 0; k < 4; ++k) v[k] = *(const f32x4*)(src + 4 * (lane + 64 * k));
#pragma unroll
        for (int k = 0; k < 4; ++k) {
            if (m >= MP) *(f32x4*)(p.X0 + m * D_MODEL + 4 * (lane + 64 * k)) = v[k];
            *(u32x2*)(p.X0b + m * D_MODEL + 4 * (lane + 64 * k)) = pk4(v[k]);
            ss += v[k][0] * v[k][0] + v[k][1] * v[k][1] + v[k][2] * v[k][2] + v[k][3] * v[k][3];
        }
        ss = wsum(ss);
        if (lane == 0) { p.RS0[m] = ss; p.RS1[m] = 0.f; p.RS2[m] = 0.f; p.RS3[m] = 0.f; p.RS4[m] = 0.f; }
    }
}
__device__ __forceinline__ void final_rows(const Params& p) {
    const int tid = opaque_tid(), lane = tid & 63, w = __builtin_amdgcn_readfirstlane(tid >> 6);
    EW_WAVES(M_TOK) {
        const long m = task;
        const float s = rs_of(p.RS4[m], D_MODEL);
        float* dst = p.out + (m < MP ? O_Y_P + m * D_MODEL : O_Y_S + (m - MP) * D_MODEL);
#pragma unroll
        for (int k = 0; k < 4; ++k) {
            const int c = 4 * (lane + 64 * k);
            *(f32x4*)(dst + c) = ld_bf4(p.X1b + m * D_MODEL + c) * s * *(const f32x4*)(p.in[I_G_OUT] + c);
        }
    }
}
}

namespace cmpk {
typedef short bf16x8 __attribute__((ext_vector_type(8)));
typedef float f32x16 __attribute__((ext_vector_type(16)));
typedef float f32x4 __attribute__((ext_vector_type(4)));
typedef unsigned u32x4 __attribute__((ext_vector_type(4)));
typedef unsigned u32x2 __attribute__((ext_vector_type(2)));
constexpr int ROWB = 144, TA = 128 * ROWB, C_A = 0, C_B = 2 * TA;
__device__ __forceinline__ void unit(const Params& p, LAS unsigned char* lds, int rt, int c) {
    const int tid = opaque_tid(), lane = tid & 63, w = __builtin_amdgcn_readfirstlane(tid >> 6), ql = lane & 31, h = lane >> 5, wr = w >> 1, wc = w & 1;
    const float* ap[4]; long astride;
    {
        const bool prm = (long)rt * 128 < (long)BATCH * NBP * 2;
        astride = prm ? 256 : 512;
#pragma unroll
        for (int q = 0; q < 4; ++q) {
            const long R = (long)rt * 128 + q * 32 + (tid >> 4); const long bu = R >> 1; const int g = (int)(R & 1);
            if (prm) { const long n = bu / NBP, b = bu % NBP; ap[q] = p.KC32 + (n * SEQ + b * 64) * 256 + c * 128 + g * 64 + (tid & 15) * 4; }
            else {
                const long bs = bu - (long)BATCH * NBP, n = bs / NBS, b = bs % NBS;
                const long phys = ((const int*)p.in[I_PAGE_TABLE])[n * NPAGES + b / BPP];
                ap[q] = p.in[I_CACHE_KV] + (((phys * PAGE_SIZE + (b % BPP) * 64) * 4 + c) * 2 + g) * 64 + (tid & 15) * 4;
            }
        }
    }
    const unsigned short* bp = p.WC1 + ((long)c * 128 + (tid >> 3)) * 4096 + (tid & 7) * 8;
    f32x4 ar[4], ar2[4]; u32x4 br[2], br2[2];
    auto issue = [&](int s, f32x4 (&a_)[4], u32x4 (&b_)[2]) {
#pragma unroll
        for (int q = 0; q < 4; ++q) a_[q] = *(const f32x4*)(ap[q] + (long)s * astride);
        b_[0] = *(const u32x4*)(bp + s * 64); b_[1] = *(const u32x4*)(bp + 64L * 4096 + s * 64);
    };
    auto commit = [&](int buf, const f32x4 (&a_)[4], const u32x4 (&b_)[2]) {
#pragma unroll
        for (int q = 0; q < 4; ++q) {
            u32x2 pk; pk[0] = pg8::cvt_pk_bf16(a_[q][0], a_[q][1]); pk[1] = pg8::cvt_pk_bf16(a_[q][2], a_[q][3]);
            *(LAS u32x2*)(lds + C_A + buf * TA + (q * 32 + (tid >> 4)) * ROWB + (tid & 15) * 8) = pk;
        }
        *(LAS u32x4*)(lds + C_B + buf * TA + (tid >> 3) * ROWB + (tid & 7) * 16) = b_[0];
        *(LAS u32x4*)(lds + C_B + buf * TA + (64 + (tid >> 3)) * ROWB + (tid & 7) * 16) = b_[1];
    };
    f32x16 acc[2];
#pragma unroll
    for (int cb = 0; cb < 2; ++cb)
#pragma unroll
        for (int i = 0; i < 16; ++i) acc[cb][i] = 0.f;
    issue(0, ar, br); commit(0, ar, br);
    issue(1, ar, br);
    __syncthreads();
    for (int s = 0; s < 64; ++s) {
        if (s + 2 < 64) issue(s + 2, ar2, br2);
        const LAS unsigned char* A = lds + C_A + (s & 1) * TA + (32 * wr + ql) * ROWB + 16 * h;
        const LAS unsigned char* B = lds + C_B + (s & 1) * TA + (64 * wc + ql) * ROWB + 16 * h;
#pragma unroll
        for (int ks = 0; ks < 4; ++ks) {
            const bf16x8 a = *(const LAS bf16x8*)(A + 32 * ks);
#pragma unroll
            for (int cb = 0; cb < 2; ++cb) acc[cb] = __builtin_amdgcn_mfma_f32_32x32x16_bf16(a, *(const LAS bf16x8*)(B + cb * 32 * ROWB + 32 * ks), acc[cb], 0, 0, 0);
        }
        if (s + 1 < 64) commit((s + 1) & 1, ar, br);
        __syncthreads();
#pragma unroll
        for (int q = 0; q < 4; ++q) ar[q] = ar2[q];
        br[0] = br2[0]; br[1] = br2[1];
    }
#pragma unroll
    for (int cb = 0; cb < 2; ++cb) {
        const int col = 64 * wc + 32 * cb + ql; const float bias = p.PEB[c * 128 + col];
#pragma unroll
        for (int i = 0; i < 16; ++i) {
            const long R = (long)rt * 128 + 32 * wr + (i & 3) + 8 * (i >> 2) + 4 * h;
            p.CH[(R * 2 + c) * 128 + col] = geluf_(acc[cb][i] + bias);
        }
    }
}
static_assert((BATCH * NBP * 2) % 128 == 0 && (N_CBLK * 2) % 128 == 0, "compression row tiles");
constexpr int NPT = BATCH * NBP * 2 / 128, NST = DEC_BATCH * NBS * 2 / 128;
__device__ __forceinline__ void sample_phase(const Params& p, LAS unsigned char* lds) {
    for (int u = blockIdx.x; u < 2 * NST; u += gridDim.x) unit(p, lds, NPT + (u >> 1), u & 1);
}
__device__ __forceinline__ void prompt_phase(const Params& p, LAS unsigned char* lds) {
    for (int u = blockIdx.x; u < 2 * NPT; u += gridDim.x) unit(p, lds, u >> 1, u & 1);
}
}

namespace sk {
typedef short bf16x8 __attribute__((ext_vector_type(8)));
typedef float f32x16 __attribute__((ext_vector_type(16)));
#define SK_MFMA(a, b, c) __builtin_amdgcn_mfma_f32_32x32x16_bf16((a), (b), (c), 0, 0, 0)
__device__ __forceinline__ int crow(int i, int h) { return (i & 3) + 8 * (i >> 2) + 4 * h; }
__device__ __forceinline__ f32x16 zero16() { f32x16 z; for (int i = 0; i < 16; ++i) z[i] = 0.f; return z; }
__device__ __forceinline__ f32x16 tile1(const unsigned short* A, const unsigned short* Bt, int K, long arow0, long brow0, int lane) {
    const int r = lane & 31, h = lane >> 5;
    const unsigned short* ap = A + (arow0 + r) * K + 8 * h; const unsigned short* bp = Bt + (brow0 + r) * K + 8 * h;
    f32x16 acc = zero16();
#pragma unroll 8
    for (int k0 = 0; k0 < K; k0 += 16) acc = SK_MFMA(*(const bf16x8*)(ap + k0), *(const bf16x8*)(bp + k0), acc);
    return acc;
}
#define SK_TASKS(ntask) for (int task = blockIdx.x * 8 + w; task < (ntask); task += gridDim.x * 8)
__device__ __forceinline__ void gu(const unsigned short* A, const unsigned short* Bt, const float* ss, unsigned short* Hb) {
    const int tid = opaque_tid(), lane = tid & 63, w = __builtin_amdgcn_readfirstlane(tid >> 6), r = lane & 31, h = lane >> 5;
    SK_TASKS((MS / 32) * (D_FF / 32)) {
        const int rb = task % (MS / 32), cb = task / (MS / 32), j0 = cb * 32, pn = j0 / 128, rr = j0 % 128;
        const long row0 = (long)MP + rb * 32;
        const unsigned short* ap = A + (row0 + r) * D_MODEL + 8 * h;
        const unsigned short* gp = Bt + ((long)pn * 256 + rr + r) * D_MODEL + 8 * h; const unsigned short* up = gp + 128L * D_MODEL;
        f32x16 ag = zero16(), au = zero16();
#pragma unroll 4
        for (int k0 = 0; k0 < D_MODEL; k0 += 16) { const bf16x8 a = *(const bf16x8*)(ap + k0); ag = SK_MFMA(a, *(const bf16x8*)(gp + k0), ag); au = SK_MFMA(a, *(const bf16x8*)(up + k0), au); }
#pragma unroll
        for (int i = 0; i < 16; ++i) {
            const long row = row0 + crow(i, h); const float rs = rs_of(ss[row], D_MODEL);
            Hb[row * D_FF + j0 + r] = f2bf(pg8::silu_fast(ag[i] * rs) * (au[i] * rs));
        }
    }
}
__device__ __forceinline__ void res(const unsigned short* A, const unsigned short* Bt, int K, const float* R32, const unsigned short* Rb, float* C32, unsigned short* Cb, float alpha, float* ss) {
    const int tid = opaque_tid(), lane = tid & 63, w = __builtin_amdgcn_readfirstlane(tid >> 6), r = lane & 31, h = lane >> 5;
    SK_TASKS((MS / 32) * (D_MODEL / 32)) {
        const int rb = task % (MS / 32), cb = task / (MS / 32);
        const long row0 = (long)MP + rb * 32;
        const f32x16 acc = tile1(A, Bt, K, row0, (long)cb * 32, lane);
#pragma unroll
        for (int i = 0; i < 16; ++i) {
            const long row = row0 + crow(i, h); const long o = row * D_MODEL + cb * 32 + r;
            const float rv = R32 ? R32[o] : bf2f(Rb[o]);
            const float v = rv + alpha * acc[i];
            if (C32) C32[o] = v;
            Cb[o] = f2bf(v);
            float sq = v * v;
            sq += __shfl_xor(sq, 1); sq += __shfl_xor(sq, 2); sq += __shfl_xor(sq, 4); sq += __shfl_xor(sq, 8); sq += __shfl_xor(sq, 16);
            if (r == 0) atomicAdd(ss + row, sq);
        }
    }
}
__device__ __forceinline__ void scale(const unsigned short* A, const unsigned short* Bt, int K, float* C, int ldc, const float* ss, long row_base, int nrb, int cb0, int ncb, int nvalid, int hp_rows = 0) {
    const int tid = opaque_tid(), lane = tid & 63, w = __builtin_amdgcn_readfirstlane(tid >> 6), r = lane & 31, h = lane >> 5;
    SK_TASKS(nrb * ncb) {
        const int rb = task % nrb, cb = cb0 + task / nrb;
        const long row0 = row_base + (long)rb * 32;
        const f32x16 acc = tile1(A, Bt, K, row0, (long)cb * 32, lane);
        int col = cb * 32 + r;
        if (col < hp_rows) col = hp_src(col);
        if (col < nvalid) {
#pragma unroll
            for (int i = 0; i < 16; ++i) {
                const long row = row0 + crow(i, h);
                C[row * ldc + col] = acc[i] * (ss ? rs_of(ss[row], D_MODEL) : 1.f);
            }
        }
    }
}
__device__ __forceinline__ void scale_b(const unsigned short* A, const unsigned short* Bt, int K, unsigned short* C, int ldc, const float* ss, long row_base, int nrb, int ncb) {
    const int tid = opaque_tid(), lane = tid & 63, w = __builtin_amdgcn_readfirstlane(tid >> 6), r = lane & 31, h = lane >> 5;
    SK_TASKS(nrb * ncb) {
        const int rb = task % nrb, cb = task / nrb;
        const long row0 = row_base + (long)rb * 32;
        const f32x16 acc = tile1(A, Bt, K, row0, (long)cb * 32, lane);
#pragma unroll
        for (int i = 0; i < 16; ++i) {
            const long row = row0 + crow(i, h);
            C[row * ldc + cb * 32 + r] = f2bf(acc[i] * (ss ? rs_of(ss[row], D_MODEL) : 1.f));
        }
    }
}
__device__ __forceinline__ void win_tail(const Params& p) {
    const int tid = opaque_tid(), lane = tid & 63, w = __builtin_amdgcn_readfirstlane(tid >> 6), r = lane & 31, h = lane >> 5;
    SK_TASKS(MP / 32) {
        const long row0 = (long)task * 32;
        const f32x16 acc = tile1(p.X1b, p.Win, D_MODEL, row0, 3072, lane);
        const int col = 3072 + r;
        if (col < IN_COLS) {
#pragma unroll
            for (int i = 0; i < 16; ++i) {
                const long row = row0 + crow(i, h);
                const float v = acc[i] * rs_of(p.RS1[row], D_MODEL);
                p.PRb[row * RWKV_COLS + col - NSA_COLS] = f2bf(v);
                if (row % SEQ == SEQ - 1) p.out[O_SH_P + (row / SEQ) * RWKV_COLS + col - NSA_COLS] = v;
            }
        }
    }
}
template <int NB>
__device__ __forceinline__ void wg_tile(LAS unsigned char* lds, const unsigned short* A, const unsigned short* Bt, int K, long arow0, const long (&brow0)[NB], int lane, int w, float (&r)[NB][2]) {
    const int rr = lane & 31, h = lane >> 5, kc = K >> 3;
    const unsigned short* ap = A + (arow0 + rr) * K + w * kc + 8 * h;
    f32x16 acc[NB];
#pragma unroll
    for (int nb = 0; nb < NB; ++nb) acc[nb] = zero16();
#pragma unroll 4
    for (int k0 = 0; k0 < kc; k0 += 16) {
        const bf16x8 a = *(const bf16x8*)(ap + k0);
#pragma unroll
        for (int nb = 0; nb < NB; ++nb) acc[nb] = SK_MFMA(a, *(const bf16x8*)(Bt + (brow0[nb] + rr) * K + w * kc + 8 * h + k0), acc[nb]);
    }
    LAS float* part = (LAS float*)lds;
#pragma unroll
    for (int nb = 0; nb < NB; ++nb)
#pragma unroll
        for (int i = 0; i < 16; ++i) part[((nb * 8 + w) * 16 + i) * 64 + lane] = acc[nb][i];
    __syncthreads();
#pragma unroll
    for (int nb = 0; nb < NB; ++nb)
#pragma unroll
        for (int e = 0; e < 2; ++e) {
            float s = 0.f;
#pragma unroll
            for (int ww = 0; ww < 8; ++ww) s += part[((nb * 8 + ww) * 16 + 2 * w + e) * 64 + lane];
            r[nb][e] = s;
        }
    __syncthreads();
}
#define SK_WGTASKS(ntask) for (int task = blockIdx.x; task < (ntask); task += gridDim.x)
__device__ __forceinline__ void gu_wg(LAS unsigned char* lds, const unsigned short* A, const unsigned short* Bt, const float* ss, unsigned short* Hb) {
    const int tid = opaque_tid(), lane = tid & 63, w = __builtin_amdgcn_readfirstlane(tid >> 6), rr = lane & 31, h = lane >> 5;
    SK_WGTASKS((MS / 32) * (D_FF / 32)) {
        const int rb = task % (MS / 32), cb = task / (MS / 32), j0 = cb * 32, pn = j0 / 128, r128 = j0 % 128;
        const long row0 = (long)MP + rb * 32;
        const long br[2] = {(long)pn * 256 + r128, (long)pn * 256 + 128 + r128};
        float r[2][2];
        wg_tile<2>(lds, A, Bt, D_MODEL, row0, br, lane, w, r);
#pragma unroll
        for (int e = 0; e < 2; ++e) {
            const long row = row0 + crow(2 * w + e, h); const float rs = rs_of(ss[row], D_MODEL);
            Hb[row * D_FF + j0 + rr] = f2bf(pg8::silu_fast(r[0][e] * rs) * (r[1][e] * rs));
        }
    }
}
__device__ __forceinline__ void res_wg(LAS unsigned char* lds, const unsigned short* A, const unsigned short* Bt, int K, const float* R32, const unsigned short* Rb, float* C32, unsigned short* Cb, float alpha, float* ss) {
    const int tid = opaque_tid(), lane = tid & 63, w = __builtin_amdgcn_readfirstlane(tid >> 6), rr = lane & 31, h = lane >> 5;
    SK_WGTASKS((MS / 32) * (D_MODEL / 32)) {
        const int rb = task % (MS / 32), cb = task / (MS / 32);
        const long row0 = (long)MP + rb * 32;
        const long br[1] = {(long)cb * 32};
        float r[1][2];
        wg_tile<1>(lds, A, Bt, K, row0, br, lane, w, r);
#pragma unroll
        for (int e = 0; e < 2; ++e) {
            const long row = row0 + crow(2 * w + e, h); const long o = row * D_MODEL + cb * 32 + rr;
            const float rv = R32 ? R32[o] : bf2f(Rb[o]);
            const float v = rv + alpha * r[0][e];
            if (C32) C32[o] = v;
            Cb[o] = f2bf(v);
            float sq = v * v;
            sq += __shfl_xor(sq, 1); sq += __shfl_xor(sq, 2); sq += __shfl_xor(sq, 4); sq += __shfl_xor(sq, 8); sq += __shfl_xor(sq, 16);
            if (rr == 0) atomicAdd(ss + row, sq);
        }
    }
}
__device__ __forceinline__ void scale_wg(LAS unsigned char* lds, const unsigned short* A, const unsigned short* Bt, int K, float* C32, unsigned short* Cb, int ldc, const float* ss, int ncb, int nvalid, int hp_rows) {
    const int tid = opaque_tid(), lane = tid & 63, w = __builtin_amdgcn_readfirstlane(tid >> 6), rr = lane & 31, h = lane >> 5;
    SK_WGTASKS((MS / 32) * ncb) {
        const int rb = task % (MS / 32), cb = task / (MS / 32);
        const long row0 = (long)MP + rb * 32;
        const long br[1] = {(long)cb * 32};
        float r[1][2];
        wg_tile<1>(lds, A, Bt, K, row0, br, lane, w, r);
        int col = cb * 32 + rr;
        if (col < hp_rows) col = hp_src(col);
        if (col < nvalid) {
#pragma unroll
            for (int e = 0; e < 2; ++e) {
                const long row = row0 + crow(2 * w + e, h);
                const float v = r[0][e] * (ss ? rs_of(ss[row], D_MODEL) : 1.f);
                if (C32) C32[row * ldc + col] = v; else Cb[row * ldc + col] = f2bf(v);
            }
        }
    }
}
__device__ __forceinline__ void win_tail_wg(const Params& p, LAS unsigned char* lds) {
    const int tid = opaque_tid(), lane = tid & 63, w = __builtin_amdgcn_readfirstlane(tid >> 6), rr = lane & 31, h = lane >> 5;
    SK_WGTASKS(MP / 32) {
        const long row0 = (long)task * 32;
        const long br[1] = {3072};
        float r[1][2];
        wg_tile<1>(lds, p.X1b, p.Win, D_MODEL, row0, br, lane, w, r);
        const int col = 3072 + rr;
        if (col < IN_COLS) {
#pragma unroll
            for (int e = 0; e < 2; ++e) {
                const long row = row0 + crow(2 * w + e, h);
                const float v = r[0][e] * rs_of(p.RS1[row], D_MODEL);
                p.PRb[row * RWKV_COLS + col - NSA_COLS] = f2bf(v);
                if (row % SEQ == SEQ - 1) p.out[O_SH_P + (row / SEQ) * RWKV_COLS + col - NSA_COLS] = v;
            }
        }
    }
}
}

__device__ __forceinline__ void wconv_tiled(LAS unsigned char* lds, const float* W, int ldw, const float* g, unsigned short* Bt, int K, int nrows, bool gu, int nvalid, int hp_rows = 0) {
    const int tid = opaque_tid(), lane = tid & 63, w = __builtin_amdgcn_readfirstlane(tid >> 6);
    LAS float* tile = (LAS float*)(lds + w * 16640);
    const int ntn = (nrows + 63) / 64, ntk = K / 64;
    for (int t = w * (int)gridDim.x + (int)blockIdx.x; t < ntn * ntk; t += gridDim.x * 8) {
        const int tn = t % ntn, tk = t / ntn;
        const int n4 = (lane & 15) * 4, n = tn * 64 + n4;
        int sc = n;
        if (gu) { const int pn = n / 256, bj = (n % 256) / 128, r = n % 128; sc = bj * D_FF + pn * 128 + r; }
        if (n < hp_rows) sc = hp_src(n);
        const bool okc = (n < nrows) && (sc < nvalid);
        float4 v[16];
#pragma unroll
        for (int q = 0; q < 16; ++q) {
            const int kk = q * 4 + (lane >> 4);
            v[q] = okc ? *(const float4*)(W + (long)(tk * 64 + kk) * ldw + sc) : make_float4(0.f, 0.f, 0.f, 0.f);
        }
#pragma unroll
        for (int q = 0; q < 16; ++q) {
            const int kk = q * 4 + (lane >> 4);
            const float gs = g ? g[tk * 64 + kk] : 1.f;
            LAS float* d = tile + kk * 65 + n4;
            d[0] = v[q].x * gs; d[1] = v[q].y * gs; d[2] = v[q].z * gs; d[3] = v[q].w * gs;
        }
        asm volatile("s_waitcnt lgkmcnt(0)" ::: "memory");
#pragma unroll
        for (int q = 0; q < 16; ++q) {
            const int nn = q * 4 + (lane >> 4), k4 = (lane & 15) * 4, nr = tn * 64 + nn;
            const unsigned lo = pg8::cvt_pk_bf16(tile[(k4 + 0) * 65 + nn], tile[(k4 + 1) * 65 + nn]), hi = pg8::cvt_pk_bf16(tile[(k4 + 2) * 65 + nn], tile[(k4 + 3) * 65 + nn]);
            if (nr < nrows) { pg8::u32x2 o; o[0] = lo; o[1] = hi; *(pg8::u32x2*)(Bt + (long)nr * K + tk * 64 + k4) = o; }
        }
        asm volatile("s_waitcnt lgkmcnt(0)" ::: "memory");
    }
}

#define NTHREADS 512
#define LDS_BYTES (159744)
#ifndef MFMA_ALL
#define MFMA_ALL 1
#endif
#ifndef NSA_MFMA_ON
#define NSA_MFMA_ON 1
#endif

__global__ void __launch_bounds__(NTHREADS, 2) k_mega(Params p) {
    extern __shared__ __attribute__((aligned(16))) unsigned char lds[];
    volatile LAS unsigned* xbw = (volatile LAS unsigned*)((LAS unsigned char*)lds + LDS_BYTES - 256);
    if (threadIdx.x < 4) xbw[threadIdx.x] = 0u;
    __syncthreads();
    XcdBarrier bar = xcd_barrier_post(p.bar, xbw);
    const long gsz = (long)gridDim.x * NTHREADS;
    PG8_LAS unsigned char* glds = (PG8_LAS unsigned char*)lds;
    const int G = (int)gridDim.x, bx = (int)blockIdx.x;
#define NAIVE(nunits, call) { const long n_ = (nunits); for (long u = (long)blockIdx.x * NTHREADS + opaque_tid(); u < n_; u += gsz) { call; } }
#ifndef PROBE_DBL
#define PROBE_DBL 0
#endif
#define PROBE_RUN(id, ...) { __VA_ARGS__ if (PROBE_DBL == (id)) { BAR __VA_ARGS__ } }
#define NAIVE_P(id, nunits, call) { NAIVE(nunits, call) if (PROBE_DBL == (id)) { BAR NAIVE(nunits, call) } }
#define BAR xcd_barrier(bar);
#define GEMM(Aptr, Bptr, Mr, Nc, Kd, EpiT, ...) { pg8::Gemm g_{Aptr, Bptr, Mr, Nc, Kd}; pg8::StaticOrder S_; S_.init(Mr, Nc, G, bx); \
        pg8::EpiT E_{__VA_ARGS__}; pg8::gemm_phase<pg8::EpiT, pg8::StaticOrder>(glds, g_, S_, E_); }
    PROBE_RUN(23, ew::copy_rows(p);)
    PROBE_RUN(7,
    wconv_tiled((LAS unsigned char*)lds, p.in[I_W_FFN1_GU], 2 * D_FF, p.in[I_G_FFN1], p.Wgu1, D_MODEL, 2 * D_FF, true, 1 << 30);
    wconv_tiled((LAS unsigned char*)lds, p.in[I_W_FFN2_GU], 2 * D_FF, p.in[I_G_FFN2], p.Wgu2, D_MODEL, 2 * D_FF, true, 1 << 30);
    wconv_tiled((LAS unsigned char*)lds, p.in[I_W_FFN1_DOWN], D_MODEL, (const float*)0, p.Wd1, D_FF, D_MODEL, false, 1 << 30);
    wconv_tiled((LAS unsigned char*)lds, p.in[I_W_FFN2_DOWN], D_MODEL, (const float*)0, p.Wd2, D_FF, D_MODEL, false, 1 << 30);
    wconv_tiled((LAS unsigned char*)lds, p.in[I_W_IN], IN_COLS, p.in[I_G_MIX], p.Win, D_MODEL, 3104, false, IN_COLS, 3072);
    wconv_tiled((LAS unsigned char*)lds, p.in[I_W_OUT], D_MODEL, (const float*)0, p.Wout, MIX_W, D_MODEL, false, 1 << 30);
    wconv_tiled((LAS unsigned char*)lds, p.in[I_W_XQ], XW, p.in[I_G_X], p.Wxq, D_MODEL, XW, false, 1 << 30);
    wconv_tiled((LAS unsigned char*)lds, p.in[I_W_XO], D_MODEL, (const float*)0, p.Wxo, XW, D_MODEL, false, 1 << 30);
    wconv_tiled((LAS unsigned char*)lds, p.in[I_W_XKV], 1024, p.in[I_G_MEM], p.Wxkv, D_MODEL, 1024, false, 1 << 30);
    wconv_tiled((LAS unsigned char*)lds, p.in[I_W_CK1], 128, (const float*)0, p.WC1, 4096, 128, false, 1 << 30);
    wconv_tiled((LAS unsigned char*)lds, p.in[I_W_CV1], 128, (const float*)0, p.WC1 + 128 * 4096, 4096, 128, false, 1 << 30);
    NAIVE((long)MEMROWS * D_MODEL / 4, u_cvt4(p.in[I_MEM_PROMPT], p.MEMb, u))
    NAIVE((long)1536 * 128, u_wconv_lora(p, u))
    NAIVE(256L, u_pebias(p, u))
    )
    NAIVE((long)MEMROWS, u_rowstat(p.in[I_MEM_PROMPT], D_MODEL, p.RSM, u))
    NAIVE((long)DEC_BATCH * (WBUF - DEC_SEQ) * 64, u_wincopy(p, u))
    ew::memkv_cache_cvt(p);
    BAR
    {
        pg8::Gemm g_{p.X0b, p.Wgu1, MP, 2 * D_FF, D_MODEL}; pg8::EpiGU E_{p.Hb, D_FF, p.RS0};
        pg8::StaticOrder S_; S_.init(MP, 2 * D_FF, G, bx);
        const int nrounds = (S_.nwg + G - 1) / G, rs_ = (bx * 5) % (nrounds > 1 ? nrounds : 1);
        pg8::RangeOrder R0{S_, 0, rs_}, R1{S_, rs_, nrounds};
        if (rs_ > 0) pg8::gemm_phase<pg8::EpiGU, pg8::RangeOrder>(glds, g_, R0, E_);
        __syncthreads();
        cmpk::sample_phase(p, (LAS unsigned char*)lds);
        __syncthreads();
        pg8::gemm_phase<pg8::EpiGU, pg8::RangeOrder>(glds, g_, R1, E_);
    }
    PROBE_RUN(30, GEMM(p.MEMb, p.Wxkv, MEMROWS, 1024, D_MODEL, EpiScale, p.out + O_MKV, 1024, p.RSM))
    PROBE_RUN(20, sk::gu_wg((LAS unsigned char*)lds, p.X0b, p.Wgu1, p.RS0, p.Hb);)
    BAR
    GEMM(p.Hb, p.Wd1, MP, D_MODEL, D_FF, EpiRes2, p.in[I_X_PROMPT], (const pg8::bf16_t*)0, (float*)0, p.X1b, D_MODEL, 0.5f, p.RS1)
    sk::res_wg((LAS unsigned char*)lds, p.Hb, p.Wd1, D_FF, p.X0, (const unsigned short*)0, (float*)0, p.X1b, 0.5f, p.RS1);
    ew::memkv_post(p);
    BAR
    PROBE_RUN(18, { pg8::Gemm g_{p.X1b, p.Win, MP, 3072, D_MODEL}; pg8::StaticOrder S_; S_.init(MP, 3072, G, bx); pg8::EpiIn E_{p.RS1, p.in[I_Q_G], p.in[I_KS_G], p.in[I_KW_G], p.in[I_GATE_B], p.out, p.QNb, p.KC32, p.KSb, p.VSb, p.KWb, p.VWb, p.GT, p.PRb}; pg8::gemm_phase<pg8::EpiIn, pg8::StaticOrder>(glds, g_, S_, E_); })
    sk::win_tail_wg(p, (LAS unsigned char*)lds);
    sk::scale_wg((LAS unsigned char*)lds, p.X1b, p.Win, D_MODEL, p.P, (unsigned short*)0, IN_COLS, p.RS1, 97, IN_COLS, 3072);
    BAR
    PROBE_RUN(13, ew::p_post(p, MP, MS);
    ew::lin_prep(p);)
    BAR
    PROBE_RUN(28, GEMM(p.LINb, p.Wlora, MP, 1536, 256, EpiScaleB, p.DWb, 1536, (const float*)0))
    sk::scale_wg((LAS unsigned char*)lds, p.LINb, p.Wlora, 256, (float*)0, p.DWb, 1536, (const float*)0, 48, 1536, 0);
    BAR
    PROBE_RUN(25, cmpk::prompt_phase(p, (LAS unsigned char*)lds);)
    PROBE_RUN(17, ew::prep2(p);)
    BAR
    PROBE_RUN(26, ew::cmp_out(p, (LAS unsigned char*)lds);)
    PROBE_RUN(8, rw::pass1(p, (LAS unsigned char*)lds);)
    BAR
    PROBE_RUN(16, rw::pass2(p, (LAS unsigned char*)lds);)
    PROBE_RUN(10, nsa::prompt_phase(p, (LAS unsigned char*)lds);)
    BAR
    PROBE_RUN(15, nsa::sample_phase(p, (LAS unsigned char*)lds);)
    rw::pass3(p, (LAS unsigned char*)lds);
    BAR
    PROBE_RUN(22, ew::rwkv_post(p, 0, M_TOK);)
    BAR
    GEMM(p.MIXb, p.Wout, MP, D_MODEL, MIX_W, EpiRes2, (const float*)0, p.X1b, (float*)0, p.X2b, D_MODEL, 1.0f, p.RS2)
    sk::res_wg((LAS unsigned char*)lds, p.MIXb, p.Wout, MIX_W, (const float*)0, p.X1b, (float*)0, p.X2b, 1.0f, p.RS2);
    BAR
    PROBE_RUN(29, GEMM(p.X2b, p.Wxq, MP, XW, D_MODEL, EpiScaleB, p.XQb, XW, p.RS2))
    sk::scale_wg((LAS unsigned char*)lds, p.X2b, p.Wxq, D_MODEL, (float*)0, p.XQb, XW, p.RS2, XW / 32, XW, 0);
    BAR
    PROBE_RUN(14, nsa::xattn_phase(p, (LAS unsigned char*)lds);)
    BAR
    GEMM(p.OXb, p.Wxo, MP, D_MODEL, XW, EpiRes2, (const float*)0, p.X2b, (float*)0, p.X3b, D_MODEL, 1.0f, p.RS3)
    sk::res_wg((LAS unsigned char*)lds, p.OXb, p.Wxo, XW, (const float*)0, p.X2b, (float*)0, p.X3b, 1.0f, p.RS3);
    BAR
    GEMM(p.X3b, p.Wgu2, MP, 2 * D_FF, D_MODEL, EpiGU, p.Hb, D_FF, p.RS3)
    sk::gu_wg((LAS unsigned char*)lds, p.X3b, p.Wgu2, p.RS3, p.Hb);
    BAR
    GEMM(p.Hb, p.Wd2, MP, D_MODEL, D_FF, EpiRes2, (const float*)0, p.X3b, (float*)0, p.X1b, D_MODEL, 0.5f, p.RS4)
    sk::res_wg((LAS unsigned char*)lds, p.Hb, p.Wd2, D_FF, (const float*)0, p.X3b, (float*)0, p.X1b, 0.5f, p.RS4);
    BAR
    PROBE_RUN(24, ew::final_rows(p);)
}

extern "C" void kernel_launch(void* const* d_in, const int* in_sizes, int n_in, void* d_out, int out_size, void* d_ws, size_t ws_size,
                              hipStream_t stream) {
    Params p;
    memset(&p, 0, sizeof(p));
    for (int i = 0; i < N_INPUTS; ++i) p.in[i] = (const float*)d_in[i];
    p.out = (float*)d_out;
    carve(p, d_ws);
    static int grid = 0;
    if (!grid) {
        int dev = 0, cus = 0;
        (void)hipGetDevice(&dev);
        (void)hipDeviceGetAttribute(&cus, hipDeviceAttributeMultiprocessorCount, dev);
        (void)hipFuncSetAttribute((const void*)k_mega, hipFuncAttributeMaxDynamicSharedMemorySize, LDS_BYTES);
        grid = cus > 0 ? cus : 256;
    }
    (void)hipMemsetAsync(p.bar, 0, XCD_BAR_WORDS * sizeof(unsigned), stream);
    hipLaunchKernelGGL(k_mega, dim3(grid), dim3(NTHREADS), LDS_BYTES, stream, p);
}
#endif
#if defined(PROBE_ATTN) && !defined(HOST_TEST)
__global__ void __launch_bounds__(NTHREADS, 2) k_probe_attn(Params p) {
    extern __shared__ __attribute__((aligned(16))) unsigned char lds[];
    PROBE_RUN(10, nsa::prompt_phase(p, (LAS unsigned char*)lds);)
}
#endif
#if defined(PROBE_RW) && !defined(HOST_TEST)
__global__ void __launch_bounds__(NTHREADS, 2) k_probe_rw1(Params p) { extern __shared__ __attribute__((aligned(16))) unsigned char lds[]; rw::pass1(p, (LAS unsigned char*)lds); }
__global__ void __launch_bounds__(NTHREADS, 2) k_probe_rw2(Params p) { extern __shared__ __attribute__((aligned(16))) unsigned char lds[]; rw::pass2(p, (LAS unsigned char*)lds); }
__global__ void __launch_bounds__(NTHREADS, 2) k_probe_rw3(Params p) { extern __shared__ __attribute__((aligned(16))) unsigned char lds[]; rw::pass3(p, (LAS unsigned char*)lds); }
#endif
```

```cpp
#ifndef HOST_TEST
#include <hip/hip_runtime.h>
#define HD __host__ __device__ __forceinline__
#else
#include <cmath>
#include <cstdio>
#include <cstdlib>
#define HD inline
#endif
#include <stdint.h>
#include <string.h>

#ifndef D_MODEL
#define D_MODEL 1024
#endif
#ifndef BATCH
#define BATCH 8
#endif
#ifndef SEQ
#define SEQ 4096
#endif
#ifndef DEC_BATCH
#define DEC_BATCH 32
#endif
#ifndef DEC_SEQ
#define DEC_SEQ 8
#endif
#ifndef PAST_LEN
#define PAST_LEN 16384
#endif
#ifndef PAGE_SIZE
#define PAGE_SIZE 128
#endif
#ifndef N_SEL
#define N_SEL 16
#endif
#ifndef WINDOW
#define WINDOW 512
#endif
#ifndef N_MEM
#define N_MEM 256
#endif
#ifndef D_FF
#define D_FF 2816
#endif
#define NSA_COLS 1304
#define RWKV_COLS 1792
#define IN_COLS 3096
#define MIX_W 1024
#define XW 512
#define MP (BATCH * SEQ)
#define MS (DEC_BATCH * DEC_SEQ)
#define M_TOK (MP + MS)
#define NBP (SEQ / 64)
#define NBS (PAST_LEN / 64)
#define NBMAX ((NBP > NBS + 1) ? NBP : (NBS + 1))
#define WBUF ((WINDOW < PAST_LEN) ? WINDOW : PAST_LEN)
#define WP ((WINDOW < SEQ) ? WINDOW : SEQ)
#define NPAGES (PAST_LEN / PAGE_SIZE)
#define BPP (PAGE_SIZE / 64)
#define MEMROWS (BATCH * N_MEM)
#define RC 256
#define NCH (SEQ / RC)
#define RMS_EPS 1e-6f
#define LNX_EPS 64e-5f

#define O_Y_P 0L
#define O_Y_S (O_Y_P + (long)MP * D_MODEL)
#define O_KV_P (O_Y_S + (long)MS * D_MODEL)
#define O_KV_S (O_KV_P + (long)MP * 512)
#define O_WIN_P (O_KV_S + (long)MS * 512)
#define O_WIN_S (O_WIN_P + (long)BATCH * WP * 256)
#define O_RS_P (O_WIN_S + (long)DEC_BATCH * WBUF * 256)
#define O_RS_S (O_RS_P + (long)BATCH * 8 * 4096)
#define O_SH_P (O_RS_S + (long)DEC_BATCH * 8 * 4096)
#define O_SH_S (O_SH_P + (long)BATCH * RWKV_COLS)
#define O_MKV (O_SH_S + (long)DEC_BATCH * RWKV_COLS)
#define O_TOTAL (O_MKV + (long)MEMROWS * 1024)

enum {
    I_X_PROMPT = 0, I_X_SAMPLE, I_CACHE_KV, I_CACHE_WIN, I_STATE_S, I_STATE_SHIFT, I_CACHE_MEM, I_PAGE_TABLE, I_MEM_PROMPT,
    I_G_FFN1, I_W_FFN1_GU, I_W_FFN1_DOWN, I_G_MIX, I_W_IN, I_W_OUT, I_Q_G, I_KC_G, I_KS_G, I_KW_G, I_GATE_B, I_PE_K, I_PE_V,
    I_W_CK1, I_W_CK2, I_W_CV1, I_W_CV2, I_MU, I_W0, I_W_DECAY2, I_A0, I_W_ICLR2, I_W_GATE2, I_K_K, I_K_A, I_R_K, I_LNX_G, I_LNX_B,
    I_G_X, I_G_MEM, I_W_XQ, I_W_XKV, I_XQ_G, I_XK_G, I_W_XO, I_G_FFN2, I_W_FFN2_GU, I_W_FFN2_DOWN, I_G_OUT, N_INPUTS
};

struct Params {
    const float* in[N_INPUTS];
    float* out;
    float *X0, *X1, *X2, *X3, *X4, *H, *P, *QN, *KVW, *GT, *KCP, *VCP, *KCS, *VCS, *CH, *PC, *OC, *SC, *RWB, *GG, *RO, *MIX, *XQ,
        *OX, *LIN, *RS0, *RS1, *RS2, *RS3, *RS4, *RSM;
    int* IDX;
    unsigned* bar;
    unsigned short *X0b, *Hb, *X1b, *X2b, *X3b, *MIXb, *OXb, *MEMb;
    unsigned short *Wgu1, *Wd1, *Wgu2, *Wd2, *Win, *Wout, *Wxq, *Wxo, *Wxkv;
    unsigned short *QNb, *KSb, *KWb, *VSt, *VWt, *KCb, *VCt, *VSb, *VWb;
    unsigned short* RWH;
    unsigned short *XQb, *DWb, *GGb; float* BON;
    float* KC32; unsigned short* PRb;
    float *RPC, *RLC, *RSS, *RHO;
    unsigned short *XKb, *XVb, *XKSb, *XVSb;
    unsigned short *ACK, *ACV, *WC1; float* PEB;
    float* DWAG; unsigned short *LINb, *Wlora;
};
HD unsigned short f2bf(float f) {
    unsigned u;
#ifndef HOST_TEST
    u = __float_as_uint(f);
#else
    memcpy(&u, &f, 4);
#endif
    u += 0x7FFFu + ((u >> 16) & 1u);
    return (unsigned short)(u >> 16);
}
HD float rs_of(float ss, int K) { return 1.f / sqrtf(ss / (float)K + RMS_EPS); }

struct f4 { float x, y, z, w; };
HD f4 ld4(const float* p) {
#ifndef HOST_TEST
    float4 v = *(const float4*)p; f4 r; r.x = v.x; r.y = v.y; r.z = v.z; r.w = v.w; return r;
#else
    f4 r; r.x = p[0]; r.y = p[1]; r.z = p[2]; r.w = p[3]; return r;
#endif
}
HD void st4(float* p, f4 v) {
#ifndef HOST_TEST
    *(float4*)p = make_float4(v.x, v.y, v.z, v.w);
#else
    p[0] = v.x; p[1] = v.y; p[2] = v.z; p[3] = v.w;
#endif
}
HD float sigmoidf_(float x) { return 1.f / (1.f + expf(-x)); }
HD float siluf_(float x) { return x / (1.f + expf(-x)); }
HD float geluf_(float x) { return 0.5f * x * (1.f + tanhf(0.7978845608028654f * (x + 0.044715f * x * x * x))); }
HD float softplusf_(float x) { return (x > 20.f) ? x : log1pf(expf(x)); }

HD bool tok_sample(long m) { return m >= MP; }
HD int tok_seq(long m) { return m < MP ? (int)(m / SEQ) : (int)((m - MP) / DEC_SEQ); }
HD int tok_i(long m) { return m < MP ? (int)(m % SEQ) : (int)((m - MP) % DEC_SEQ); }
HD int tok_pos(long m) { return m < MP ? (int)(m % SEQ) : PAST_LEN + (int)((m - MP) % DEC_SEQ); }

HD void u_copyx(const Params& p, long u) {
    long m = u / (D_MODEL / 4); int k = (int)(u % (D_MODEL / 4)) * 4;
    const float* src = m < MP ? p.in[I_X_PROMPT] + m * D_MODEL : p.in[I_X_SAMPLE] + (m - MP) * D_MODEL;
    f4 v = ld4(src + k);
    st4(p.X0 + m * D_MODEL + k, v);
    unsigned short* b = p.X0b + m * D_MODEL + k;
    b[0] = f2bf(v.x); b[1] = f2bf(v.y); b[2] = f2bf(v.z); b[3] = f2bf(v.w);
}
HD void u_rowstat(const float* x, int K, float* ss_out, long m) {
    const float* r = x + m * K; float ss = 0.f;
    for (int k = 0; k < K; k += 4) { f4 v = ld4(r + k); ss += v.x * v.x + v.y * v.y + v.z * v.z + v.w * v.w; }
    ss_out[m] = ss;
}
HD void u_wconv(const float* W, int ldw, const float* g, unsigned short* Bt, int K, int nrows, bool gu, long u, int nvalid = 1 << 30) {
    int n = (int)(u % nrows); int k = (int)(u / nrows) * 2;
    int sc = n;
    if (gu) { int pn = n / 256, bj = (n % 256) / 128, r = n % 128; sc = bj * D_FF + pn * 128 + r; }
    float a = 0.f, b = 0.f;
    if (sc < nvalid) { a = W[(long)k * ldw + sc]; b = W[(long)(k + 1) * ldw + sc]; }
    if (g) { a *= g[k]; b *= g[k + 1]; }
    Bt[(long)n * K + k] = f2bf(a); Bt[(long)n * K + k + 1] = f2bf(b);
}
HD void u_cvt4(const float* src, unsigned short* dst, long u) {
    f4 v = ld4(src + u * 4); unsigned short* b = dst + u * 4;
    b[0] = f2bf(v.x); b[1] = f2bf(v.y); b[2] = f2bf(v.z); b[3] = f2bf(v.w);
}

template <class Epi>
HD void gemm_unit(const float* A, int lda, const float* gk, const float* W, int ldw, int K, int Nc, long u, Epi epi, long row_base = 0,
                  int col_base = 0) {
    int ncg = Nc / 4; long rg = u / ncg; int cg = (int)(u % ncg);
    long m0 = row_base + rg * 4; int n0 = col_base + cg * 4;
    float acc[4][4];
#pragma unroll
    for (int i = 0; i < 4; ++i)
#pragma unroll
        for (int j = 0; j < 4; ++j) acc[i][j] = 0.f;
    for (int k = 0; k < K; k += 4) {
        f4 a[4];
#pragma unroll
        for (int i = 0; i < 4; ++i) a[i] = ld4(A + (m0 + i) * lda + k);
        if (gk) {
            f4 g = ld4(gk + k);
#pragma unroll
            for (int i = 0; i < 4; ++i) { a[i].x *= g.x; a[i].y *= g.y; a[i].z *= g.z; a[i].w *= g.w; }
        }
        f4 w0 = ld4(W + (long)(k + 0) * ldw + n0), w1 = ld4(W + (long)(k + 1) * ldw + n0), w2 = ld4(W + (long)(k + 2) * ldw + n0),
           w3 = ld4(W + (long)(k + 3) * ldw + n0);
#pragma unroll
        for (int i = 0; i < 4; ++i) {
            acc[i][0] += a[i].x * w0.x + a[i].y * w1.x + a[i].z * w2.x + a[i].w * w3.x;
            acc[i][1] += a[i].x * w0.y + a[i].y * w1.y + a[i].z * w2.y + a[i].w * w3.y;
            acc[i][2] += a[i].x * w0.z + a[i].y * w1.z + a[i].z * w2.z + a[i].w * w3.z;
            acc[i][3] += a[i].x * w0.w + a[i].y * w1.w + a[i].z * w2.w + a[i].w * w3.w;
        }
    }
#pragma unroll
    for (int i = 0; i < 4; ++i) epi(m0 + i, n0, acc[i]);
}
struct EpiScaleStore {
    float* C; int ldc; const float* ss; int K;
    HD void operator()(long m, int n0, const float* a) const {
        float s = rs_of(ss[m], K); f4 v; v.x = a[0] * s; v.y = a[1] * s; v.z = a[2] * s; v.w = a[3] * s; st4(C + m * ldc + n0, v);
    }
};
struct EpiResidual {
    float* C; const float* R; int ldc; float alpha; unsigned short* Cb;
    HD void operator()(long m, int n0, const float* a) const {
        f4 r = ld4(R + m * ldc + n0); r.x += alpha * a[0]; r.y += alpha * a[1]; r.z += alpha * a[2]; r.w += alpha * a[3];
        st4(C + m * ldc + n0, r);
        unsigned short* b = Cb + m * ldc + n0; b[0] = f2bf(r.x); b[1] = f2bf(r.y); b[2] = f2bf(r.z); b[3] = f2bf(r.w);
    }
};
HD void u_gu(const float* A, const float* gk, const float* W, const float* ssq, float* H, long u, long row_base = 0) {
    int ncg = D_FF / 4; long rg = u / ncg; int cg = (int)(u % ncg);
    long m0 = row_base + rg * 4; int n0 = cg * 4;
    float ag[4][4], au[4][4];
#pragma unroll
    for (int i = 0; i < 4; ++i)
#pragma unroll
        for (int j = 0; j < 4; ++j) { ag[i][j] = 0.f; au[i][j] = 0.f; }
    for (int k = 0; k < D_MODEL; ++k) {
        float g = gk[k];
        f4 wg = ld4(W + (long)k * (2 * D_FF) + n0), wu = ld4(W + (long)k * (2 * D_FF) + D_FF + n0);
#pragma unroll
        for (int i = 0; i < 4; ++i) {
            float a = A[(m0 + i) * D_MODEL + k] * g;
            ag[i][0] += a * wg.x; ag[i][1] += a * wg.y; ag[i][2] += a * wg.z; ag[i][3] += a * wg.w;
            au[i][0] += a * wu.x; au[i][1] += a * wu.y; au[i][2] += a * wu.z; au[i][3] += a * wu.w;
        }
    }
#pragma unroll
    for (int i = 0; i < 4; ++i) {
        float s = rs_of(ssq[m0 + i], D_MODEL); f4 v;
        v.x = siluf_(ag[i][0] * s) * (au[i][0] * s); v.y = siluf_(ag[i][1] * s) * (au[i][1] * s);
        v.z = siluf_(ag[i][2] * s) * (au[i][2] * s); v.w = siluf_(ag[i][3] * s) * (au[i][3] * s);
        st4(H + (m0 + i) * D_FF + n0, v);
    }
}

HD void u_nsa_post(const Params& p, long m) {
    const float* row = p.P + m * IN_COLS;
    const float* qg = p.in[I_Q_G]; const float* ksg = p.in[I_KS_G]; const float* kwg = p.in[I_KW_G];
    for (int h = 0; h < 8; ++h) {
        float ss = 0.f;
        for (int d = 0; d < 64; ++d) { float v = row[h * 64 + d]; ss += v * v; }
        float r = 1.f / sqrtf(ss / 64.f + RMS_EPS);
        for (int d = 0; d < 64; ++d) p.QN[m * 512 + h * 64 + d] = row[h * 64 + d] * r * qg[d];
    }
    float* kv = p.KVW + m * 768;
    for (int c = 0; c < 6; ++c)
        for (int g = 0; g < 2; ++g) {
            const float* s = row + 512 + c * 128 + g * 64;
            if (c == 2 || c == 4) {
                const float* gg = (c == 2) ? ksg : kwg;
                float ss = 0.f;
                for (int d = 0; d < 64; ++d) ss += s[d] * s[d];
                float r = 1.f / sqrtf(ss / 64.f + RMS_EPS);
                for (int d = 0; d < 64; ++d) kv[c * 128 + g * 64 + d] = s[d] * r * gg[d];
            } else {
                for (int d = 0; d < 64; ++d) kv[c * 128 + g * 64 + d] = s[d];
            }
        }
    for (int j = 0; j < 24; ++j) p.GT[m * 24 + j] = sigmoidf_(row[1280 + j] + p.in[I_GATE_B][j]);
    int n = tok_seq(m), i = tok_i(m);
    if (!tok_sample(m)) {
        for (int c = 0; c < 512; ++c) p.QNb[m * 512 + c] = f2bf(p.QN[m * 512 + c] * 0.125f);
        for (int g = 0; g < 2; ++g)
            for (int d = 0; d < 64; ++d) {
                long kr = (((long)n * 2 + g) * SEQ + i) * 64 + d, vt = (((long)n * 2 + g) * 64 + d) * SEQ + i;
                p.KSb[kr] = f2bf(kv[256 + g * 64 + d]); p.VSt[vt] = f2bf(kv[384 + g * 64 + d]);
                p.KWb[kr] = f2bf(kv[512 + g * 64 + d]); p.VWt[vt] = f2bf(kv[640 + g * 64 + d]);
            }
        for (int c = 0; c < 512; ++c) p.out[O_KV_P + m * 512 + c] = kv[c];
        if (i >= SEQ - WP) {
            long j = i - (SEQ - WP);
            for (int c = 0; c < 256; ++c) p.out[O_WIN_P + ((long)n * WP + j) * 256 + c] = kv[512 + c];
        }
        if (i == SEQ - 1)
            for (int c = 0; c < RWKV_COLS; ++c) p.out[O_SH_P + (long)n * RWKV_COLS + c] = row[NSA_COLS + c];
    } else {
        for (int c = 0; c < 512; ++c) p.out[O_KV_S + (m - MP) * 512 + c] = kv[c];
        long j = WBUF - DEC_SEQ + i;
        for (int c = 0; c < 256; ++c) p.out[O_WIN_S + ((long)n * WBUF + j) * 256 + c] = kv[512 + c];
        if (i == DEC_SEQ - 1)
            for (int c = 0; c < RWKV_COLS; ++c) p.out[O_SH_S + (long)n * RWKV_COLS + c] = row[NSA_COLS + c];
    }
}
HD void u_wincopy(const Params& p, long u) {
    long n = u / ((WBUF - DEC_SEQ) * 64L); long r = u % ((WBUF - DEC_SEQ) * 64L);
    long j = r / 64; int c4 = (int)(r % 64) * 4;
    st4(p.out + O_WIN_S + (n * WBUF + j) * 256 + c4, ld4(p.in[I_CACHE_WIN] + (n * WBUF + j + DEC_SEQ) * 256 + c4));
}

#define N_CBLK (BATCH * NBP + DEC_BATCH * NBS)
#define N_CROWS (((N_CBLK * 2 + 255) / 256) * 256)
HD const float* cmp_row(const Params& p, long bu, int j, int c, int g) {
    if (bu < (long)BATCH * NBP) {
        long n = bu / NBP, b = bu % NBP;
        return p.KVW + (n * SEQ + b * 64 + j) * 768 + c * 128 + g * 64;
    }
    bu -= (long)BATCH * NBP;
    long n = bu / NBS, b = bu % NBS;
    long phys = ((const int*)p.in[I_PAGE_TABLE])[n * NPAGES + b / BPP];
    long prow = (b % BPP) * 64 + j;
    return p.in[I_CACHE_KV] + (((phys * PAGE_SIZE + prow) * 4 + c) * 2 + g) * 64;
}
HD void u_cmp_hidden(const Params& p, long u) {
    int hc = (int)(u % 128); long r = u / 128;
    int c = (int)(r % 2); r /= 2; int g = (int)(r % 2); long bu = r / 2;
    const float* pe = c == 0 ? p.in[I_PE_K] : p.in[I_PE_V];
    const float* w1 = c == 0 ? p.in[I_W_CK1] : p.in[I_W_CV1];
    float acc = 0.f;
    for (int j = 0; j < 64; ++j) {
        const float* row = cmp_row(p, bu, j, c, g);
        for (int d = 0; d < 64; ++d) acc += (row[d] + pe[j * 64 + d]) * w1[(long)(j * 64 + d) * 128 + hc];
    }
    p.CH[((bu * 2 + g) * 2 + c) * 128 + hc] = geluf_(acc);
}

HD float bf2f(unsigned short b) {
    unsigned u = ((unsigned)b) << 16; float f;
#ifndef HOST_TEST
    f = __uint_as_float(u);
#else
    memcpy(&f, &u, 4);
#endif
    return f;
}
HD void u_cmp_gather(const Params& p, long u) {
    int q = (int)(u % 16); long r = u / 16; int j = (int)(r % 64); r /= 64; int c = (int)(r % 2); long R = r / 2;
    unsigned short* dst = (c == 0 ? p.ACK : p.ACV) + R * 4096 + j * 64 + q * 4;
    if (R >= (long)N_CBLK * 2) { dst[0] = 0; dst[1] = 0; dst[2] = 0; dst[3] = 0; return; }
    const float* row = cmp_row(p, R / 2, j, c, (int)(R % 2));
    f4 v = ld4(row + q * 4);
    dst[0] = f2bf(v.x); dst[1] = f2bf(v.y); dst[2] = f2bf(v.z); dst[3] = f2bf(v.w);
}
HD void u_pebias(const Params& p, long u) {
    int c = (int)(u / 128), h = (int)(u % 128);
    const float* pe = c == 0 ? p.in[I_PE_K] : p.in[I_PE_V];
    const float* w1 = c == 0 ? p.in[I_W_CK1] : p.in[I_W_CV1];
    float acc = 0.f;
    for (int k = 0; k < 4096; ++k) acc += pe[k] * w1[(long)k * 128 + h];
    p.PEB[u] = acc;
}
HD void u_cmp_hidden2(const Params& p, long u) {
    int hc = (int)(u % 128); long r = u / 128; int c = (int)(r % 2); long R = r / 2;
    const unsigned short* a = (c == 0 ? p.ACK : p.ACV) + R * 4096;
    const float* w1 = c == 0 ? p.in[I_W_CK1] : p.in[I_W_CV1];
    float acc = p.PEB[c * 128 + hc];
    for (int k = 0; k < 4096; ++k) acc += bf2f(a[k]) * w1[(long)k * 128 + hc];
    p.CH[(R * 2 + c) * 128 + hc] = geluf_(acc);
}
HD void u_cmp_out(const Params& p, long u) {
    int c = (int)(u % 2); long r = u / 2; int g = (int)(r % 2); long bu = r / 2;
    const float* w2 = c == 0 ? p.in[I_W_CK2] : p.in[I_W_CV2];
    const float* h = p.CH + ((bu * 2 + g) * 2 + c) * 128;
    float o[64];
#pragma unroll
    for (int d = 0; d < 64; ++d) o[d] = 0.f;
    for (int k = 0; k < 128; ++k) {
        float hv = h[k];
#pragma unroll
        for (int d = 0; d < 64; ++d) o[d] += hv * w2[k * 64 + d];
    }
    float* dst;
    if (bu < (long)BATCH * NBP) dst = (c == 0 ? p.KCP : p.VCP) + (bu * 2 + g) * 64;
    else dst = (c == 0 ? p.KCS : p.VCS) + ((bu - (long)BATCH * NBP) * 2 + g) * 64;
    bool prm = bu < (long)BATCH * NBP; long nn = bu / NBP, bb = bu % NBP;
    if (c == 0) {
        float ss = 0.f;
#pragma unroll
        for (int d = 0; d < 64; ++d) ss += o[d] * o[d];
        float rr = 1.f / sqrtf(ss / 64.f + RMS_EPS);
#pragma unroll
        for (int d = 0; d < 64; ++d) {
            float v = o[d] * rr * p.in[I_KC_G][d]; dst[d] = v;
            if (prm) p.KCb[((nn * 2 + g) * NBP + bb) * 64 + d] = f2bf(v);
        }
    } else {
#pragma unroll
        for (int d = 0; d < 64; ++d) {
            dst[d] = o[d];
            if (prm) p.VCt[((nn * 2 + g) * 64 + d) * NBP + bb] = f2bf(o[d]);
        }
    }
}
HD void u_cmp_attn(const Params& p, long u) {
    long m = u / 8; int h = (int)(u % 8); int g = h / 4;
    int n = tok_seq(m), t = tok_pos(m);
    bool smp = tok_sample(m);
    int nbtot = smp ? NBS + 1 : NBP;
    int nvalid = smp ? NBS : (t + 1) / 64;
    const float* kc = smp ? p.KCS + (long)n * NBS * 128 : p.KCP + (long)n * NBP * 128;
    const float* vc = smp ? p.VCS + (long)n * NBS * 128 : p.VCP + (long)n * NBP * 128;
    float slope = exp2f(-(float)(h + 1));
    float q[64];
#pragma unroll
    for (int d = 0; d < 64; ++d) q[d] = p.QN[m * 512 + h * 64 + d];
    float* pc = p.PC + (m * 8 + h) * NBMAX;
    float mx = -INFINITY;
    for (int b = 0; b < nvalid; ++b) {
        const float* k = kc + (b * 2 + g) * 64;
        float s = 0.f;
#pragma unroll
        for (int d = 0; d < 64; ++d) s += q[d] * k[d];
        s = s * 0.125f - slope * (float)(t - ((b + 1) * 64 - 1));
        pc[b] = s; mx = fmaxf(mx, s);
    }
    float acc[64];
#pragma unroll
    for (int d = 0; d < 64; ++d) acc[d] = 0.f;
    float l = 0.f;
    for (int b = 0; b < nvalid; ++b) {
        float e = expf(pc[b] - mx); l += e; pc[b] = e;
        const float* v = vc + (b * 2 + g) * 64;
#pragma unroll
        for (int d = 0; d < 64; ++d) acc[d] += e * v[d];
    }
    float inv = nvalid > 0 ? 1.f / l : 0.f;
    for (int b = 0; b < nvalid; ++b) pc[b] *= inv;
    for (int b = nvalid; b < nbtot; ++b) pc[b] = 0.f;
#pragma unroll
    for (int d = 0; d < 64; ++d) p.OC[m * 512 + h * 64 + d] = acc[d] * inv;
}
HD void u_select(const Params& p, long u) {
    long m = u / 2; int g = (int)(u % 2);
    int t = tok_pos(m); bool smp = tok_sample(m);
    int nb = smp ? NBS + 1 : NBP;
    int cur = t / 64;
    float* sc = p.SC + (m * 2 + g) * NBMAX;
    for (int b = 0; b < nb; ++b) {
        bool forced = (b == 0) || (b == cur) || (b == cur - 1);
        float v;
        if (forced) v = 1e9f;
        else if (b <= cur) { v = 0.f; for (int r = 0; r < 4; ++r) v += p.PC[(m * 8 + g * 4 + r) * NBMAX + b]; }
        else v = -1e9f;
        sc[b] = v;
    }
    int K = N_SEL < nb ? N_SEL : nb;
    for (int k = 0; k < K; ++k) {
        int best = 0; float bv = sc[0];
        for (int b = 1; b < nb; ++b) { float v = sc[b]; if (v > bv) { bv = v; best = b; } }
        p.IDX[(m * 2 + g) * N_SEL + k] = best; sc[best] = -3e38f;
    }
    for (int k = K; k < N_SEL; ++k) p.IDX[(m * 2 + g) * N_SEL + k] = -1;
}
#define ONLINE_STEP(sval, vptr)                                                            \
    {                                                                                      \
        float s_ = (sval);                                                                 \
        if (s_ > mx) {                                                                     \
            float sc_ = expf(mx - s_); l = l * sc_ + 1.f; mx = s_;                         \
            _Pragma("unroll") for (int d = 0; d < 64; ++d) acc[d] = acc[d] * sc_ + (vptr)[d]; \
        } else {                                                                           \
            float e_ = expf(s_ - mx); l += e_;                                             \
            _Pragma("unroll") for (int d = 0; d < 64; ++d) acc[d] += e_ * (vptr)[d];       \
        }                                                                                  \
    }
HD void u_selwin(const Params& p, long u) {
    long m = u / 8; int h = (int)(u % 8); int g = h / 4;
    int n = tok_seq(m), t = tok_pos(m); bool smp = tok_sample(m);
    float slope = exp2f(-(float)(h + 1));
    float q[64], acc[64];
#pragma unroll
    for (int d = 0; d < 64; ++d) { q[d] = p.QN[m * 512 + h * 64 + d]; acc[d] = 0.f; }
    float g0 = p.GT[m * 24 + h * 3 + 0], g1 = p.GT[m * 24 + h * 3 + 1], g2 = p.GT[m * 24 + h * 3 + 2];
    float mx = -INFINITY, l = 0.f;
    const int* pt = (const int*)p.in[I_PAGE_TABLE];
    for (int k = 0; k < N_SEL; ++k) {
        int blk = p.IDX[(m * 2 + g) * N_SEL + k];
        if (blk < 0) continue;
        for (int s = 0; s < 64; ++s) {
            int pos = blk * 64 + s;
            if (pos > t) break;
            const float *kp, *vp;
            if (!smp) {
                const float* r = p.KVW + ((long)n * SEQ + pos) * 768; kp = r + 256 + g * 64; vp = r + 384 + g * 64;
            } else if (blk >= NBS) {
                const float* r = p.KVW + ((long)MP + (long)n * DEC_SEQ + (pos - PAST_LEN)) * 768; kp = r + 256 + g * 64; vp = r + 384 + g * 64;
            } else {
                long phys = pt[n * NPAGES + blk / BPP]; long prow = (blk % BPP) * 64 + s;
                const float* r = p.in[I_CACHE_KV] + (phys * PAGE_SIZE + prow) * 512; kp = r + (2 * 2 + g) * 64; vp = r + (3 * 2 + g) * 64;
            }
            float sv = 0.f;
#pragma unroll
            for (int d = 0; d < 64; ++d) sv += q[d] * kp[d];
            sv = sv * 0.125f - slope * (float)(t - pos);
            ONLINE_STEP(sv, vp)
        }
    }
    {
        float inv = l > 0.f ? 1.f / l : 0.f;
#pragma unroll
        for (int d = 0; d < 64; ++d) { p.MIX[m * MIX_W + h * 64 + d] = g0 * p.OC[m * 512 + h * 64 + d] + g1 * acc[d] * inv; acc[d] = 0.f; }
    }
    mx = -INFINITY; l = 0.f;
    int lo = t - WINDOW + 1;
    if (!smp) { if (lo < 0) lo = 0; } else { if (lo < PAST_LEN - WBUF) lo = PAST_LEN - WBUF; }
    for (int pos = lo; pos <= t; ++pos) {
        const float *kp, *vp;
        if (!smp) {
            const float* r = p.KVW + ((long)n * SEQ + pos) * 768; kp = r + 512 + g * 64; vp = r + 640 + g * 64;
        } else if (pos >= PAST_LEN) {
            const float* r = p.KVW + ((long)MP + (long)n * DEC_SEQ + (pos - PAST_LEN)) * 768; kp = r + 512 + g * 64; vp = r + 640 + g * 64;
        } else {
            const float* r = p.in[I_CACHE_WIN] + ((long)n * WBUF + (pos - (PAST_LEN - WBUF))) * 256; kp = r + g * 64; vp = r + 128 + g * 64;
        }
        float sv = 0.f;
#pragma unroll
        for (int d = 0; d < 64; ++d) sv += q[d] * kp[d];
        sv = sv * 0.125f - slope * (float)(t - pos);
        ONLINE_STEP(sv, vp)
    }
    float inv = l > 0.f ? 1.f / l : 0.f;
#pragma unroll
    for (int d = 0; d < 64; ++d) {
        float o = p.MIX[m * MIX_W + h * 64 + d] + g2 * acc[d] * inv;
        p.MIX[m * MIX_W + h * 64 + d] = o; p.MIXb[m * MIX_W + h * 64 + d] = f2bf(o);
    }
}

HD float rwkv_xs(const Params& p, long m, int c) {
    float cur = p.P[m * IN_COLS + NSA_COLS + c];
    int i = tok_i(m); float prev;
    if (i > 0) prev = p.P[(m - 1) * IN_COLS + NSA_COLS + c];
    else prev = tok_sample(m) ? p.in[I_STATE_SHIFT][(long)tok_seq(m) * RWKV_COLS + c] : 0.f;
    return cur + (prev - cur) * p.in[I_MU][c];
}
HD void u_lora_in(const Params& p, long u) {
    long m = u / 256; int j = (int)(u % 256);
    float x = rwkv_xs(p, m, 1536 + j);
    float v = (j < 64) ? tanhf(x) : (j < 128 ? x : sigmoidf_(x));
    p.LIN[m * 256 + j] = v; p.LINb[m * 256 + j] = f2bf(v);
}
HD void u_rwkv_prep(const Params& p, long u) {
    long m = u / 8; int h = (int)(u % 8);
    const float* lin = p.LIN + m * 256;
    float* rb = p.RWB + m * 6 * 512;
    float ss = 0.f;
    for (int d = 0; d < 64; ++d) {
        int c = h * 64 + d;
        float dw = p.in[I_W0][c], da = p.in[I_A0][c], dg = 0.f;
        for (int j = 0; j < 64; ++j) { dw += lin[j] * p.in[I_W_DECAY2][j * 512 + c]; da += lin[64 + j] * p.in[I_W_ICLR2][j * 512 + c]; }
        for (int j = 0; j < 128; ++j) dg += lin[128 + j] * p.in[I_W_GATE2][j * 512 + c];
        float wlog = -softplusf_(-dw) - 0.5f;
        float decay = expf(-expf(wlog));
        float a = sigmoidf_(da);
        float r = rwkv_xs(p, m, c), k = rwkv_xs(p, m, 512 + c), v = rwkv_xs(p, m, 1024 + c);
        float kkr = k * p.in[I_K_K][c];
        float kh = k * (1.f + (a - 1.f) * p.in[I_K_A][c]);
        ss += kkr * kkr;
        rb[0 * 512 + c] = r; rb[1 * 512 + c] = kh; rb[2 * 512 + c] = v; rb[3 * 512 + c] = kkr; rb[4 * 512 + c] = a; rb[5 * 512 + c] = decay;
        p.GG[m * 512 + c] = dg;
    }
    float inv = 1.f / sqrtf(fmaxf(ss, 1e-24f));
    for (int d = 0; d < 64; ++d) {
        int c = h * 64 + d;
        float kk = rb[3 * 512 + c] * inv; float a = rb[4 * 512 + c];
        rb[3 * 512 + c] = kk; rb[4 * 512 + c] = kk * a;
    }
}

HD void u_wconv_lora(const Params& p, long u) {
    int n = (int)(u % 1536); int k = (int)(u / 1536) * 2;
    float a = 0.f, b = 0.f;
    if (n < 512) { if (k < 64) { a = p.in[I_W_DECAY2][k * 512 + n]; b = p.in[I_W_DECAY2][(k + 1) * 512 + n]; } }
    else if (n < 1024) { if (k >= 64 && k < 128) { a = p.in[I_W_ICLR2][(k - 64) * 512 + n - 512]; b = p.in[I_W_ICLR2][(k - 63) * 512 + n - 512]; } }
    else { if (k >= 128) { a = p.in[I_W_GATE2][(k - 128) * 512 + n - 1024]; b = p.in[I_W_GATE2][(k - 127) * 512 + n - 1024]; } }
    p.Wlora[(long)n * 256 + k] = f2bf(a); p.Wlora[(long)n * 256 + k + 1] = f2bf(b);
}
struct EpiStoreOff {
    float* C; int ldc; int coff;
    HD void operator()(long m, int n0, const float* a) const { f4 v; v.x = a[0]; v.y = a[1]; v.z = a[2]; v.w = a[3]; st4(C + m * ldc + coff + n0, v); }
};
HD void u_rwkv_prep2(const Params& p, long u) {
    long m = u / 8; int h = (int)(u % 8);
    const float* dq = p.DWAG + m * 1536;
    float* rb = p.RWB + m * 6 * 512;
    float ss = 0.f;
    for (int d = 0; d < 64; ++d) {
        int c = h * 64 + d;
        float dw = p.in[I_W0][c] + dq[c], da = p.in[I_A0][c] + dq[512 + c], dg = dq[1024 + c];
        float wlog = -softplusf_(-dw) - 0.5f;
        float decay = expf(-expf(wlog));
        float a = sigmoidf_(da);
        float r = rwkv_xs(p, m, c), k = rwkv_xs(p, m, 512 + c), v = rwkv_xs(p, m, 1024 + c);
        float kkr = k * p.in[I_K_K][c];
        float kh = k * (1.f + (a - 1.f) * p.in[I_K_A][c]);
        ss += kkr * kkr;
        rb[0 * 512 + c] = r; rb[1 * 512 + c] = kh; rb[2 * 512 + c] = v; rb[3 * 512 + c] = kkr; rb[4 * 512 + c] = a; rb[5 * 512 + c] = decay;
        p.GG[m * 512 + c] = dg;
    }
    float inv = 1.f / sqrtf(fmaxf(ss, 1e-24f));
    for (int d = 0; d < 64; ++d) {
        int c = h * 64 + d;
        float kk = rb[3 * 512 + c] * inv; float a = rb[4 * 512 + c];
        rb[3 * 512 + c] = kk; rb[4 * 512 + c] = kk * a;
    }
}
HD void u_rwkv_scan(const Params& p, long u) {
    int i = (int)(u % 64); long r = u / 64; int h = (int)(r % 8); int sq = (int)(r / 8);
    bool smp = sq >= BATCH; int n = smp ? sq - BATCH : sq;
    int T = smp ? DEC_SEQ : SEQ;
    long m0 = smp ? (long)MP + (long)n * DEC_SEQ : (long)n * SEQ;
    float S[64];
    if (smp) {
        const float* s0 = p.in[I_STATE_S] + (((long)n * 8 + h) * 64 + i) * 64;
#pragma unroll
        for (int j = 0; j < 64; ++j) S[j] = s0[j];
    } else {
#pragma unroll
        for (int j = 0; j < 64; ++j) S[j] = 0.f;
    }
    for (int t = 0; t < T; ++t) {
        const float* rb = p.RWB + (m0 + t) * 6 * 512 + h * 64;
        float v = rb[2 * 512 + i];
        float sa = 0.f;
#pragma unroll
        for (int j = 0; j < 64; ++j) sa -= S[j] * rb[3 * 512 + j];
        float o = 0.f;
#pragma unroll
        for (int j = 0; j < 64; ++j) {
            S[j] = S[j] * rb[5 * 512 + j] + sa * rb[4 * 512 + j] + v * rb[1 * 512 + j];
            o += S[j] * rb[0 * 512 + j];
        }
        p.RO[(m0 + t) * 512 + h * 64 + i] = o;
    }
    float* dst = p.out + (smp ? O_RS_S : O_RS_P) + (((long)n * 8 + h) * 64 + i) * 64;
#pragma unroll
    for (int j = 0; j < 64; ++j) dst[j] = S[j];
}

HD void u_rwkv_r1(const Params& p, long u) {
    int i = (int)(u % 64); long r = u / 64; int kind = (int)(r % 2); long ct = r / 2;
    int c = (int)(ct % NCH); long sh = ct / NCH; int h = (int)(sh % 8); int sq = (int)(sh / 8);
    long m0 = (long)sq * SEQ + (long)c * RC;
    float S[64];
#pragma unroll
    for (int j = 0; j < 64; ++j) S[j] = (kind == 1 && j == i) ? 1.f : 0.f;
    for (int t = 0; t < RC; ++t) {
        const float* rb = p.RWB + (m0 + t) * 6 * 512 + h * 64;
        float v = kind == 0 ? rb[2 * 512 + i] : 0.f;
        float sa = 0.f;
#pragma unroll
        for (int j = 0; j < 64; ++j) sa -= S[j] * rb[3 * 512 + j];
        float o = 0.f;
#pragma unroll
        for (int j = 0; j < 64; ++j) { S[j] = S[j] * rb[5 * 512 + j] + sa * rb[4 * 512 + j] + v * rb[1 * 512 + j]; o += S[j] * rb[0 * 512 + j]; }
        (kind == 0 ? p.RO : p.RHO)[(m0 + t) * 512 + h * 64 + i] = o;
    }
    float* dst = (kind == 0 ? p.RLC : p.RPC) + (ct * 64 + i) * 64;
#pragma unroll
    for (int j = 0; j < 64; ++j) dst[j] = S[j];
}
HD void u_rwkv_r2(const Params& p, long u) {
    int i = (int)(u % 64); long sh = u / 64;
    float S[64], T[64];
#pragma unroll
    for (int j = 0; j < 64; ++j) S[j] = 0.f;
    for (int c = 0; c < NCH; ++c) {
        long ct = sh * NCH + c;
        float* ss = p.RSS + (ct * 64 + i) * 64;
#pragma unroll
        for (int j = 0; j < 64; ++j) ss[j] = S[j];
        const float* P = p.RPC + ct * 4096; const float* L = p.RLC + (ct * 64 + i) * 64;
#pragma unroll
        for (int j = 0; j < 64; ++j) T[j] = L[j];
        for (int k = 0; k < 64; ++k) {
            float s = S[k];
#pragma unroll
            for (int j = 0; j < 64; ++j) T[j] += s * P[k * 64 + j];
        }
#pragma unroll
        for (int j = 0; j < 64; ++j) S[j] = T[j];
    }
    float* dst = p.out + O_RS_P + (sh * 64 + i) * 64;
#pragma unroll
    for (int j = 0; j < 64; ++j) dst[j] = S[j];
}
HD void u_rwkv_r3(const Params& p, long u) {
    int i = (int)(u % 64); long ct = u / 64;
    int c = (int)(ct % NCH); long sh = ct / NCH; int h = (int)(sh % 8); int sq = (int)(sh / 8);
    long m0 = (long)sq * SEQ + (long)c * RC;
    const float* ss = p.RSS + (ct * 64 + i) * 64;
    for (int t = 0; t < RC; ++t) {
        const float* rho = p.RHO + (m0 + t) * 512 + h * 64;
        float o = p.RO[(m0 + t) * 512 + h * 64 + i];
        for (int k = 0; k < 64; ++k) o += ss[k] * rho[k];
        p.RO[(m0 + t) * 512 + h * 64 + i] = o;
    }
}
HD void u_rwkv_post(const Params& p, long u) {
    long m = u / 8; int h = (int)(u % 8);
    const float* ro = p.RO + m * 512 + h * 64;
    const float* rb = p.RWB + m * 6 * 512 + h * 64;
    float mean = 0.f;
    for (int i = 0; i < 64; ++i) mean += ro[i];
    mean *= (1.f / 64.f);
    float var = 0.f;
    for (int i = 0; i < 64; ++i) { float d = ro[i] - mean; var += d * d; }
    var *= (1.f / 64.f);
    float rstd = 1.f / sqrtf(var + LNX_EPS);
    float bonus = 0.f;
    for (int j = 0; j < 64; ++j) bonus += rb[0 * 512 + j] * rb[1 * 512 + j] * p.in[I_R_K][h * 64 + j];
    for (int i = 0; i < 64; ++i) {
        int c = h * 64 + i;
        float o = (ro[i] - mean) * rstd * p.in[I_LNX_G][c] + p.in[I_LNX_B][c] + bonus * rb[2 * 512 + i];
        o *= p.GG[m * 512 + c];
        p.MIX[m * MIX_W + 512 + c] = o; p.MIXb[m * MIX_W + 512 + c] = f2bf(o);
    }
}
HD void u_headnorm128(float* base, long rowstride, const float* g, long u) {
    long m = u / 4; int h = (int)(u % 4);
    float* x = base + m * rowstride + h * 128;
    float ss = 0.f;
    for (int d = 0; d < 128; ++d) ss += x[d] * x[d];
    float r = 1.f / sqrtf(ss / 128.f + RMS_EPS);
    for (int d = 0; d < 128; ++d) x[d] = x[d] * r * g[d];
}
HD void u_xattn(const Params& p, long u) {
    int half = (int)(u % 4); long r = u / 4; int h = (int)(r % 4); long m = r / 4;
    int n = tok_seq(m);
    const float* kvb = tok_sample(m) ? p.in[I_CACHE_MEM] + (long)n * N_MEM * 1024 : p.out + O_MKV + (long)n * N_MEM * 1024;
    float acc[32];
    const float* q = p.XQ + m * XW + h * 128;
#pragma unroll
    for (int d = 0; d < 32; ++d) acc[d] = 0.f;
    float mx = -INFINITY, l = 0.f;
    for (int j = 0; j < N_MEM; ++j) {
        const float* kp = kvb + (long)j * 1024 + h * 128;
        const float* vp = kvb + (long)j * 1024 + 512 + h * 128 + half * 32;
        float sv = 0.f;
#pragma unroll
        for (int d = 0; d < 128; ++d) sv += q[d] * kp[d];
        sv *= 0.08838834764831845f;
        if (sv > mx) {
            float sc_ = expf(mx - sv); l = l * sc_ + 1.f; mx = sv;
#pragma unroll
            for (int d = 0; d < 32; ++d) acc[d] = acc[d] * sc_ + vp[d];
        } else {
            float e_ = expf(sv - mx); l += e_;
#pragma unroll
            for (int d = 0; d < 32; ++d) acc[d] += e_ * vp[d];
        }
    }
    float inv = 1.f / l;
#pragma unroll
    for (int d = 0; d < 32; ++d) {
        float o = acc[d] * inv; p.OX[m * XW + h * 128 + half * 32 + d] = o; p.OXb[m * XW + h * 128 + half * 32 + d] = f2bf(o);
    }
}
HD void u_final(const Params& p, long u) {
    long m = u / (D_MODEL / 4); int k = (int)(u % (D_MODEL / 4)) * 4;
    f4 v = ld4(p.X4 + m * D_MODEL + k); f4 g = ld4(p.in[I_G_OUT] + k); float s = rs_of(p.RS4[m], D_MODEL);
    v.x *= s * g.x; v.y *= s * g.y; v.z *= s * g.z; v.w *= s * g.w;
    st4(p.out + (m < MP ? O_Y_P + m * D_MODEL : O_Y_S + (m - MP) * D_MODEL) + k, v);
}

#ifdef HOST_CMP2
#define HOST_CMP_HIDDEN u_cmp_hidden2(p, u)
#else
#define HOST_CMP_HIDDEN u_cmp_hidden(p, u)
#endif
#define GEMM_UNITS(rows, cols) ((long)(rows) / 4 * ((cols) / 4))
#define PHASES(X)                                                                                                              \
    X(copyx, (long)M_TOK * (D_MODEL / 4), u_copyx(p, u))                                                                       \
    X(rs0, (long)M_TOK, u_rowstat(p.X0, D_MODEL, p.RS0, u))                                                                    \
    X(gu1, GEMM_UNITS(M_TOK, D_FF), u_gu(p.X0, p.in[I_G_FFN1], p.in[I_W_FFN1_GU], p.RS0, p.H, u))                               \
    X(down1, GEMM_UNITS(M_TOK, D_MODEL),                                                                                       \
      gemm_unit(p.H, D_FF, (const float*)0, p.in[I_W_FFN1_DOWN], D_MODEL, D_FF, D_MODEL, u, EpiResidual{p.X1, p.X0, D_MODEL, 0.5f, p.X1b})) \
    X(rs1, (long)M_TOK, u_rowstat(p.X1, D_MODEL, p.RS1, u))                                                                    \
    X(win, GEMM_UNITS(M_TOK, IN_COLS),                                                                                         \
      gemm_unit(p.X1, D_MODEL, p.in[I_G_MIX], p.in[I_W_IN], IN_COLS, D_MODEL, IN_COLS, u, EpiScaleStore{p.P, IN_COLS, p.RS1, D_MODEL}))  \
    X(nsa_post, (long)M_TOK, u_nsa_post(p, u))                                                                                 \
    X(wincopy, (long)DEC_BATCH * (WBUF - DEC_SEQ) * 64, u_wincopy(p, u))                                                       \
    X(pebias, 256L, u_pebias(p, u))                                                                                            \
    X(cmp_gather, (long)N_CROWS * 2 * 64 * 16, u_cmp_gather(p, u))                                                             \
    X(cmp_hidden, (long)N_CBLK * 2 * 2 * 128, HOST_CMP_HIDDEN)                                                                 \
    X(cmp_out, (long)N_CBLK * 2 * 2, u_cmp_out(p, u))                                                                          \
    X(cmp_attn, (long)M_TOK * 8, u_cmp_attn(p, u))                                                                             \
    X(select, (long)M_TOK * 2, u_select(p, u))                                                                                 \
    X(selwin, (long)M_TOK * 8, u_selwin(p, u))                                                                                 \
    X(lora_in, (long)M_TOK * 256, u_lora_in(p, u))                                                                             \
    X(lora_d, GEMM_UNITS(M_TOK, 512), gemm_unit(p.LIN, 256, (const float*)0, p.in[I_W_DECAY2], 512, 64, 512, u, EpiStoreOff{p.DWAG, 1536, 0}))  \
    X(lora_a, GEMM_UNITS(M_TOK, 512), gemm_unit(p.LIN + 64, 256, (const float*)0, p.in[I_W_ICLR2], 512, 64, 512, u, EpiStoreOff{p.DWAG, 1536, 512}))  \
    X(lora_g, GEMM_UNITS(M_TOK, 512), gemm_unit(p.LIN + 128, 256, (const float*)0, p.in[I_W_GATE2], 512, 128, 512, u, EpiStoreOff{p.DWAG, 1536, 1024}))  \
    X(rwkv_prep2, (long)M_TOK * 8, u_rwkv_prep2(p, u))                                                                         \
    X(rwkv_r1, (long)BATCH * 8 * NCH * 2 * 64, u_rwkv_r1(p, u))                                                                \
    X(rwkv_r2, (long)BATCH * 8 * 64, u_rwkv_r2(p, u))                                                                          \
    X(rwkv_r3, (long)BATCH * 8 * NCH * 64, u_rwkv_r3(p, u))                                                                    \
    X(rwkv_scan_s, (long)DEC_BATCH * 8 * 64, u_rwkv_scan(p, (long)BATCH * 8 * 64 + u))                                         \
    X(rwkv_post, (long)M_TOK * 8, u_rwkv_post(p, u))                                                                           \
    X(wout, GEMM_UNITS(M_TOK, D_MODEL),                                                                                        \
      gemm_unit(p.MIX, MIX_W, (const float*)0, p.in[I_W_OUT], D_MODEL, MIX_W, D_MODEL, u, EpiResidual{p.X2, p.X1, D_MODEL, 1.0f, p.X2b})) \
    X(rs2, (long)M_TOK, u_rowstat(p.X2, D_MODEL, p.RS2, u))                                                                    \
    X(xq, GEMM_UNITS(M_TOK, XW),                                                                                               \
      gemm_unit(p.X2, D_MODEL, p.in[I_G_X], p.in[I_W_XQ], XW, D_MODEL, XW, u, EpiScaleStore{p.XQ, XW, p.RS2, D_MODEL}))                  \
    X(xq_norm, (long)M_TOK * 4, u_headnorm128(p.XQ, XW, p.in[I_XQ_G], u))                                                      \
    X(rsm, (long)MEMROWS, u_rowstat(p.in[I_MEM_PROMPT], D_MODEL, p.RSM, u))                                                    \
    X(memkv, GEMM_UNITS(MEMROWS, 1024),                                                                                        \
      gemm_unit(p.in[I_MEM_PROMPT], D_MODEL, p.in[I_G_MEM], p.in[I_W_XKV], 1024, D_MODEL, 1024, u,                             \
                EpiScaleStore{p.out + O_MKV, 1024, p.RSM, D_MODEL}))                                                                    \
    X(memk_norm, (long)MEMROWS * 4, u_headnorm128(p.out + O_MKV, 1024, p.in[I_XK_G], u))                                       \
    X(xattn, (long)M_TOK * 4 * 4, u_xattn(p, u))                                                                               \
    X(xo, GEMM_UNITS(M_TOK, D_MODEL),                                                                                          \
      gemm_unit(p.OX, XW, (const float*)0, p.in[I_W_XO], D_MODEL, XW, D_MODEL, u, EpiResidual{p.X3, p.X2, D_MODEL, 1.0f, p.X3b}))      \
    X(rs3, (long)M_TOK, u_rowstat(p.X3, D_MODEL, p.RS3, u))                                                                    \
    X(gu2, GEMM_UNITS(M_TOK, D_FF), u_gu(p.X3, p.in[I_G_FFN2], p.in[I_W_FFN2_GU], p.RS3, p.H, u))                               \
    X(down2, GEMM_UNITS(M_TOK, D_MODEL),                                                                                       \
      gemm_unit(p.H, D_FF, (const float*)0, p.in[I_W_FFN2_DOWN], D_MODEL, D_FF, D_MODEL, u, EpiResidual{p.X4, p.X3, D_MODEL, 0.5f, p.X1b})) \
    X(rs4, (long)M_TOK, u_rowstat(p.X4, D_MODEL, p.RS4, u))                                                                    \
    X(final, (long)M_TOK * (D_MODEL / 4), u_final(p, u))

struct WsAlloc {
    char* base; size_t off;
    float* take(size_t nfloats) { float* r = (float*)(base + off); off += ((nfloats * 4 + 255) / 256) * 256; return r; }
};
static size_t carve(Params& p, void* ws) {
    WsAlloc a{(char*)ws, 0};
    p.bar = (unsigned*)a.take(4096);
    p.X0 = a.take((size_t)M_TOK * D_MODEL); p.X1 = a.take((size_t)M_TOK * D_MODEL); p.X2 = a.take((size_t)M_TOK * D_MODEL);
    p.X3 = a.take((size_t)M_TOK * D_MODEL); p.X4 = a.take((size_t)M_TOK * D_MODEL);
    p.H = a.take((size_t)M_TOK * D_FF); p.P = a.take((size_t)M_TOK * IN_COLS);
    p.QN = a.take((size_t)M_TOK * 512); p.KVW = a.take((size_t)M_TOK * 768); p.GT = a.take((size_t)M_TOK * 24);
    p.KCP = a.take((size_t)BATCH * NBP * 128); p.VCP = a.take((size_t)BATCH * NBP * 128);
    p.KCS = a.take((size_t)DEC_BATCH * NBS * 128); p.VCS = a.take((size_t)DEC_BATCH * NBS * 128);
    p.CH = a.take((size_t)N_CBLK * 4 * 128);
    p.PC = a.take((size_t)M_TOK * 8 * NBMAX); p.OC = a.take((size_t)M_TOK * 512); p.SC = a.take((size_t)M_TOK * 2 * NBMAX);
    p.IDX = (int*)a.take((size_t)M_TOK * 2 * N_SEL);
    p.RWB = a.take((size_t)M_TOK * 6 * 512); p.GG = a.take((size_t)M_TOK * 512); p.RO = a.take((size_t)M_TOK * 512);
    p.MIX = a.take((size_t)M_TOK * MIX_W); p.XQ = a.take((size_t)M_TOK * XW); p.OX = a.take((size_t)M_TOK * XW);
    p.LIN = a.take((size_t)M_TOK * 256);
    p.RS0 = a.take(M_TOK); p.RS1 = a.take(M_TOK); p.RS2 = a.take(M_TOK); p.RS3 = a.take(M_TOK); p.RS4 = a.take(M_TOK);
    p.RSM = a.take(MEMROWS);
    p.X0b = (unsigned short*)a.take((size_t)M_TOK * D_MODEL / 2); p.X1b = (unsigned short*)a.take((size_t)M_TOK * D_MODEL / 2);
    p.X2b = (unsigned short*)a.take((size_t)M_TOK * D_MODEL / 2); p.X3b = (unsigned short*)a.take((size_t)M_TOK * D_MODEL / 2);
    p.Hb = (unsigned short*)a.take((size_t)M_TOK * D_FF / 2); p.MIXb = (unsigned short*)a.take((size_t)M_TOK * MIX_W / 2);
    p.OXb = (unsigned short*)a.take((size_t)M_TOK * XW / 2); p.MEMb = (unsigned short*)a.take((size_t)MEMROWS * D_MODEL / 2);
    p.Wgu1 = (unsigned short*)a.take((size_t)D_MODEL * D_FF); p.Wgu2 = (unsigned short*)a.take((size_t)D_MODEL * D_FF);
    p.Wd1 = (unsigned short*)a.take((size_t)D_MODEL * D_FF / 2); p.Wd2 = (unsigned short*)a.take((size_t)D_MODEL * D_FF / 2);
    p.Win = (unsigned short*)a.take((size_t)D_MODEL * 3104 / 2); p.Wout = (unsigned short*)a.take((size_t)MIX_W * D_MODEL / 2);
    p.Wxq = (unsigned short*)a.take((size_t)D_MODEL * XW / 2); p.Wxo = (unsigned short*)a.take((size_t)XW * D_MODEL / 2);
    p.Wxkv = (unsigned short*)a.take((size_t)D_MODEL * 1024 / 2);
    p.QNb = (unsigned short*)a.take((size_t)M_TOK * 512 / 2);
    p.KSb = (unsigned short*)a.take((size_t)MP * 128 / 2); p.KWb = (unsigned short*)a.take((size_t)MP * 128 / 2);
    p.VSt = (unsigned short*)a.take((size_t)MP * 128 / 2); p.VWt = (unsigned short*)a.take((size_t)MP * 128 / 2);
    p.VSb = (unsigned short*)a.take((size_t)MP * 128 / 2); p.VWb = (unsigned short*)a.take((size_t)MP * 128 / 2);
    p.KCb = (unsigned short*)a.take((size_t)BATCH * NBP * 128 / 2); p.VCt = (unsigned short*)a.take((size_t)BATCH * NBP * 128 / 2);
    p.XKb = (unsigned short*)a.take((size_t)BATCH * N_MEM * 512 / 2); p.XVb = (unsigned short*)a.take((size_t)BATCH * N_MEM * 512 / 2);
    p.XKSb = (unsigned short*)a.take((size_t)DEC_BATCH * N_MEM * 512 / 2); p.XVSb = (unsigned short*)a.take((size_t)DEC_BATCH * N_MEM * 512 / 2);
    p.ACK = (unsigned short*)a.take((size_t)N_CROWS * 4096 / 2); p.ACV = (unsigned short*)a.take((size_t)N_CROWS * 4096 / 2);
    p.WC1 = (unsigned short*)a.take((size_t)256 * 4096 / 2); (void)a.take(256); p.PEB = (float*)(p.bar + 3700);
    p.DWAG = a.take((size_t)M_TOK * 1536); p.LINb = (unsigned short*)a.take((size_t)M_TOK * 256 / 2); p.Wlora = (unsigned short*)a.take((size_t)1536 * 256 / 2);
    p.RWH = (unsigned short*)a.take((size_t)M_TOK * 3 * 512 / 2);
    p.XQb = (unsigned short*)a.take((size_t)M_TOK * XW / 2); p.DWb = (unsigned short*)a.take((size_t)M_TOK * 1536 / 2); p.GGb = (unsigned short*)a.take((size_t)M_TOK * 512 / 2); p.BON = a.take((size_t)M_TOK * 8);
    p.KC32 = a.take((size_t)MP * 256); p.PRb = (unsigned short*)a.take((size_t)M_TOK * 1792 / 2);
    p.RHO = a.take((size_t)MP * 512);
    p.RPC = a.take((size_t)BATCH * 8 * NCH * 4096); p.RLC = a.take((size_t)BATCH * 8 * NCH * 4096); p.RSS = a.take((size_t)BATCH * 8 * NCH * 4096);
    return a.off;
}

#ifndef HOST_TEST
#define XB_TMO      128
#define XB_XCNT(j)  (256  + 64 * (j))
#define XB_XSUB(j)  (1280 + 64 * (j))
#define XB_XGEN(j)  (2304 + 64 * (j))
#define XB_TOP      3328
#define XB_TOPGEN   3392
#define XCD_BAR_WORDS 3456
#define XB_SPIN_CAP (1u << 28)
#define LAS __attribute__((address_space(3)))
__device__ __forceinline__ unsigned xb_ld(unsigned* p)              { return __hip_atomic_load(p, __ATOMIC_RELAXED, __HIP_MEMORY_SCOPE_AGENT); }
__device__ __forceinline__ unsigned xb_add(unsigned* p, unsigned v) { return __hip_atomic_fetch_add(p, v, __ATOMIC_RELAXED, __HIP_MEMORY_SCOPE_AGENT); }
__device__ __forceinline__ unsigned xb_xcc_id() { return (unsigned)__builtin_amdgcn_s_getreg((3 << 11) | 20) & 0xFu; }
#define XB_SPIN(cond, bar) do { unsigned _sp = 0; while (cond) { __builtin_amdgcn_s_sleep(1); \
    if ((++_sp & 255u) == 0u) { if (xb_ld(&(bar)[XB_TMO])) break; if (_sp > XB_SPIN_CAP) { atomicAdd(&(bar)[XB_TMO], 1u); break; } } } } while (0)
struct XcdBarrier { unsigned* bar; unsigned x; volatile LAS unsigned* st; };
__device__ __forceinline__ XcdBarrier xcd_barrier_post(unsigned* bar, volatile LAS unsigned* st) {
    XcdBarrier b; b.bar = bar; b.x = xb_xcc_id(); b.st = st;
    if (threadIdx.x == 0) (void)xb_add(&bar[XB_XCNT(b.x)], 1u);
    return b;
}
__device__ __forceinline__ void xcd_barrier_complete(unsigned* bar, unsigned x, unsigned& nloc, unsigned& nx) {
    const unsigned G = gridDim.x * gridDim.y * gridDim.z;
    unsigned sum, cnt, mine, sp = 0u;
    for (;;) {
        sum = 0u; cnt = 0u; mine = 0u;
#pragma unroll
        for (unsigned j = 0; j < 16; ++j) { const unsigned c = xb_ld(&bar[XB_XCNT(j)]); sum += c; cnt += (c > 0u) ? 1u : 0u; mine = (j == x) ? c : mine; }
        if (sum == G) break;
        __builtin_amdgcn_s_sleep(1);
        if ((++sp & 255u) == 0u) { if (xb_ld(&bar[XB_TMO])) break; if (sp > XB_SPIN_CAP) { atomicAdd(&bar[XB_TMO], 1u); break; } }
    }
    nloc = mine > 0u ? mine : 1u; nx = cnt > 0u ? cnt : 1u;
}
__device__ __forceinline__ void xcd_barrier(const XcdBarrier& b) {
    asm volatile("s_waitcnt vmcnt(0)" ::: "memory");
    __syncthreads();
    if (threadIdx.x == 0) {
        unsigned* bar = b.bar;
        __builtin_amdgcn_s_waitcnt(0);
        unsigned nloc = b.st[0], nx = b.st[1];
        if (nloc == 0u) { xcd_barrier_complete(bar, b.x, nloc, nx); b.st[0] = nloc; b.st[1] = nx; }
        const unsigned old = xb_add(&bar[XB_XSUB(b.x)], 1u);
        const unsigned gen = old / nloc;
        if (old + 1u == (gen + 1u) * nloc) {
            __builtin_amdgcn_fence(__ATOMIC_RELEASE, "agent");
            asm volatile("s_waitcnt vmcnt(0)" ::: "memory");
            const unsigned og = xb_add(&bar[XB_TOP], 1u);
            const unsigned tg = og / nx;
            if (og + 1u == (tg + 1u) * nx) xb_add(&bar[XB_TOPGEN], 1u);
            else XB_SPIN(xb_ld(&bar[XB_TOPGEN]) == tg, bar);
            __builtin_amdgcn_fence(__ATOMIC_ACQUIRE, "agent");
            xb_add(&bar[XB_XGEN(b.x)], 1u);
            asm volatile("s_waitcnt vmcnt(0)" ::: "memory");
        } else {
            XB_SPIN(xb_ld(&bar[XB_XGEN(b.x)]) == gen, bar);
            __builtin_amdgcn_fence(__ATOMIC_ACQUIRE, "agent");
            asm volatile("s_waitcnt vmcnt(0)" ::: "memory");
        }
    }
    __syncthreads();
}

__device__ __forceinline__ float xhalf_sum(float x) { const unsigned u = __float_as_uint(x); const auto r = __builtin_amdgcn_permlane32_swap(u, u, false, false); return __uint_as_float(r[0]) + __uint_as_float(r[1]); }
__device__ __forceinline__ float xhalf_max(float x) { const unsigned u = __float_as_uint(x); const auto r = __builtin_amdgcn_permlane32_swap(u, u, false, false); return fmaxf(__uint_as_float(r[0]), __uint_as_float(r[1])); }
__device__ __forceinline__ int hp_src(int n) { const int pn = n >> 8, t = n & 255; return (pn << 8) + 64 * ((t & 127) >> 5) + 32 * (t >> 7) + (t & 31); }
__device__ __forceinline__ float fast_sigmoid(float x) { return __builtin_amdgcn_rcpf(1.f + __expf(-x)); }
__device__ __forceinline__ float fast_tanh(float x) { return 1.f - 2.f * __builtin_amdgcn_rcpf(1.f + __expf(2.f * x)); }
__device__ __forceinline__ float dpp_wsum(float v) {
    int x = __float_as_int(v);
    x = __float_as_int(__int_as_float(x) + __int_as_float(__builtin_amdgcn_update_dpp(0, x, 0xB1, 0xf, 0xf, false)));
    x = __float_as_int(__int_as_float(x) + __int_as_float(__builtin_amdgcn_update_dpp(0, x, 0x4E, 0xf, 0xf, false)));
    x = __float_as_int(__int_as_float(x) + __int_as_float(__builtin_amdgcn_update_dpp(0, x, 0x141, 0xf, 0xf, false)));
    x = __float_as_int(__int_as_float(x) + __int_as_float(__builtin_amdgcn_update_dpp(0, x, 0x140, 0xf, 0xf, false)));
    return (__int_as_float(__builtin_amdgcn_readlane(x, 0)) + __int_as_float(__builtin_amdgcn_readlane(x, 16))) +
           (__int_as_float(__builtin_amdgcn_readlane(x, 32)) + __int_as_float(__builtin_amdgcn_readlane(x, 48)));
}
__device__ __forceinline__ int opaque_tid() { int t = threadIdx.x; asm volatile("" : "+v"(t)); return t; }
namespace pg8 {
#define PG8_LAS __attribute__((address_space(3)))
typedef unsigned short bf16_t;
typedef short bf16x8 __attribute__((ext_vector_type(8)));
typedef float f32x4 __attribute__((ext_vector_type(4)));
typedef unsigned u32x4 __attribute__((ext_vector_type(4)));
typedef unsigned u32x2 __attribute__((ext_vector_type(2)));
constexpr int BM = 256, BK = 64, HALF = 128, HTB = HALF * BK * 2, STAGE_BYTES = 8 * HTB, NXCD = 8, WGM = 8;
__host__ __device__ __forceinline__ int lds_byte(int r, int c) { const int st = (r >> 4) * 2 + (c >> 5), rr = r & 15, cc = c & 31, ob = rr * 64 + cc * 2; return st * 1024 + (ob ^ (((ob >> 9) & 1) << 5)); }
__host__ __device__ __forceinline__ void stage_rc(int b, int& R, int& C) { const int st = b / 1024, sb = b % 1024, swz = sb ^ (((sb >> 9) & 1) << 5); R = (st >> 1) * 16 + swz / 64; C = (st & 1) * 32 + (swz % 64) / 2; }
__host__ __device__ __forceinline__ int perm32(int rho) { const int n = rho >> 4, i = rho & 15; return 8 * (i >> 2) + 4 * n + (i & 3); }
struct Unit { int pm, pn; };
struct Gemm { const bf16_t* A; const bf16_t* Bt; int M, N, K; };
struct StaticOrder {
    int nM, nN, nwg, G, c;
    __host__ __device__ void init(int M, int N, int G_, int c_) { nM = M / BM; nN = N / BM; nwg = nM * nN; G = G_; c = c_; }
    __host__ __device__ bool next(int i, Unit& u) const {
        const long L = (long)i * G + c; if (L >= nwg) return false;
        int wgid = (int)L; { const int q = nwg / NXCD, r = nwg % NXCD, xcd = wgid % NXCD, off = wgid / NXCD; wgid = (xcd < r ? xcd * (q + 1) : r * (q + 1) + (xcd - r) * q) + off; }
        const int nig = WGM * nN, gid = wgid / nig, fm = gid * WGM, gsz = (nM - fm) < WGM ? (nM - fm) : WGM;
        u.pm = fm + ((wgid % nig) % gsz); u.pn = (wgid % nig) / gsz; return true;
    }
    __device__ __forceinline__ void a_ready(const Unit&) const {}
    __device__ __forceinline__ void done(const Unit&) const {}
};
struct RangeOrder {
    StaticOrder S; int i0, i1;
    __host__ __device__ bool next(int i, Unit& u) const { return (i0 + i < i1) && S.next(i0 + i, u); }
    __device__ __forceinline__ void a_ready(const Unit&) const {}
    __device__ __forceinline__ void done(const Unit&) const {}
};
__device__ __forceinline__ unsigned cvt_pk_bf16(float lo, float hi) { unsigned r; asm volatile("v_cvt_pk_bf16_f32 %0, %1, %2" : "=v"(r) : "v"(lo), "v"(hi)); return r; }

__device__ __forceinline__ float silu_fast(float x) { return x * __builtin_amdgcn_rcpf(1.f + __expf(-x)); }
struct EpiGU {
    static constexpr bool PERM = true, AFTER_DRAIN = false;
    bf16_t* H; int ldh; const float* ss;
    __device__ __forceinline__ void operator()(const f32x4 (&acc)[2][2][4][2], const Unit& u, int wr, int wc, int fr, int fq) const {
        const int row0 = u.pm * BM + wr * 64 + fr, col0 = u.pn * HALF + wc * 32 + 8 * fq;
#pragma unroll
        for (int ai = 0; ai < 2; ++ai)
#pragma unroll
            for (int m = 0; m < 4; ++m) {
                const int row = row0 + ai * HALF + m * 16;
                const float rs = rs_of(ss[row], D_MODEL);
                u32x4 o;
#pragma unroll
                for (int n = 0; n < 2; ++n) {
                    const f32x4 g = acc[ai][0][m][n] * rs, up = acc[ai][1][m][n] * rs;
                    o[2 * n] = cvt_pk_bf16(silu_fast(g[0]) * up[0], silu_fast(g[1]) * up[1]);
                    o[2 * n + 1] = cvt_pk_bf16(silu_fast(g[2]) * up[2], silu_fast(g[3]) * up[3]);
                }
                *(u32x4*)(H + (size_t)row * ldh + col0) = o;
            }
    }
};
struct EpiRes {
    static constexpr bool PERM = false, AFTER_DRAIN = false;
    float* C; const float* R; bf16_t* Cb; int ldc; float alpha; float* ss;
    __device__ __forceinline__ void operator()(const f32x4 (&acc)[2][2][4][2], const Unit& u, int wr, int wc, int fr, int fq) const {
        const int row0 = u.pm * BM + wr * 64 + fr, col0 = u.pn * BM + wc * 32 + 4 * fq;
#pragma unroll
        for (int ai = 0; ai < 2; ++ai)
#pragma unroll
            for (int m = 0; m < 4; ++m) {
                const int row = row0 + ai * HALF + m * 16;
                const size_t ro = (size_t)row * ldc + col0;
                float sq = 0.f;
#pragma unroll
                for (int bj = 0; bj < 2; ++bj)
#pragma unroll
                    for (int n = 0; n < 2; ++n) {
                        const size_t o = ro + bj * HALF + n * 16;
                        f32x4 v = *(const f32x4*)(R + o) + acc[ai][bj][m][n] * alpha;
                        *(f32x4*)(C + o) = v;
                        u32x2 b; b[0] = cvt_pk_bf16(v[0], v[1]); b[1] = cvt_pk_bf16(v[2], v[3]);
                        *(u32x2*)(Cb + o) = b;
                        sq += v[0] * v[0] + v[1] * v[1] + v[2] * v[2] + v[3] * v[3];
                    }
                sq += __shfl_xor(sq, 16); sq += __shfl_xor(sq, 32);
                if (fq == 0) atomicAdd(ss + row, sq);
            }
    }
};
struct EpiRes2 {
    static constexpr bool PERM = true, AFTER_DRAIN = false;
    const float* R32; const bf16_t* Rb; float* C32; bf16_t* Cb; int ldc; float alpha; float* ss;
    __device__ __forceinline__ void operator()(const f32x4 (&acc)[2][2][4][2], const Unit& u, int wr, int wc, int fr, int fq) const {
        const int row0 = u.pm * BM + wr * 64 + fr, col0 = u.pn * BM + wc * 32 + 8 * fq;
#pragma unroll
        for (int ai = 0; ai < 2; ++ai)
#pragma unroll
            for (int m = 0; m < 4; ++m) {
                const int row = row0 + ai * HALF + m * 16;
                const size_t ro = (size_t)row * ldc + col0;
                float sq = 0.f;
#pragma unroll
                for (int bj = 0; bj < 2; ++bj) {
                    const size_t o = ro + bj * HALF;
                    f32x4 r0, r1;
                    if (R32) { r0 = *(const f32x4*)(R32 + o); r1 = *(const f32x4*)(R32 + o + 4); }
                    else {
                        const u32x4 rb = *(const u32x4*)(Rb + o);
                        r0[0] = __uint_as_float(rb[0] << 16); r0[1] = __uint_as_float(rb[0] & 0xffff0000u); r0[2] = __uint_as_float(rb[1] << 16); r0[3] = __uint_as_float(rb[1] & 0xffff0000u);
                        r1[0] = __uint_as_float(rb[2] << 16); r1[1] = __uint_as_float(rb[2] & 0xffff0000u); r1[2] = __uint_as_float(rb[3] << 16); r1[3] = __uint_as_float(rb[3] & 0xffff0000u);
                    }
                    const f32x4 v0 = r0 + acc[ai][bj][m][0] * alpha, v1 = r1 + acc[ai][bj][m][1] * alpha;
                    if (C32) { *(f32x4*)(C32 + o) = v0; *(f32x4*)(C32 + o + 4) = v1; }
                    u32x4 b; b[0] = cvt_pk_bf16(v0[0], v0[1]); b[1] = cvt_pk_bf16(v0[2], v0[3]); b[2] = cvt_pk_bf16(v1[0], v1[1]); b[3] = cvt_pk_bf16(v1[2], v1[3]);
                    *(u32x4*)(Cb + o) = b;
                    sq += v0[0] * v0[0] + v0[1] * v0[1] + v0[2] * v0[2] + v0[3] * v0[3] + v1[0] * v1[0] + v1[1] * v1[1] + v1[2] * v1[2] + v1[3] * v1[3];
                }
                sq += __shfl_xor(sq, 16); sq += __shfl_xor(sq, 32);
                if (fq == 0) atomicAdd(ss + row, sq);
            }
    }
};
struct EpiScaleB {
    static constexpr bool PERM = true, AFTER_DRAIN = false;
    bf16_t* O; int ldc; const float* ss;
    __device__ __forceinline__ void operator()(const f32x4 (&acc)[2][2][4][2], const Unit& u, int wr, int wc, int fr, int fq) const {
        const int row0 = u.pm * BM + wr * 64 + fr, col0 = u.pn * BM + wc * 32 + 8 * fq;
#pragma unroll
        for (int ai = 0; ai < 2; ++ai)
#pragma unroll
            for (int m = 0; m < 4; ++m) {
                const int row = row0 + ai * HALF + m * 16;
                const float rs = ss ? rs_of(ss[row], D_MODEL) : 1.f;
#pragma unroll
                for (int bj = 0; bj < 2; ++bj) {
                    const f32x4 v0 = acc[ai][bj][m][0] * rs, v1 = acc[ai][bj][m][1] * rs;
                    u32x4 b; b[0] = cvt_pk_bf16(v0[0], v0[1]); b[1] = cvt_pk_bf16(v0[2], v0[3]); b[2] = cvt_pk_bf16(v1[0], v1[1]); b[3] = cvt_pk_bf16(v1[2], v1[3]);
                    *(u32x4*)(O + (size_t)row * ldc + col0 + bj * HALF) = b;
                }
            }
    }
};
struct EpiCmp {
    static constexpr bool PERM = false, AFTER_DRAIN = false;
    float* CH; const float* bias; int c; int nrows;
    __device__ __forceinline__ void operator()(const f32x4 (&acc)[2][2][4][2], const Unit& u, int wr, int wc, int fr, int fq) const {
        const int row0 = u.pm * BM + wr * 64 + fr, col0 = wc * 32 + 4 * fq;
#pragma unroll
        for (int ai = 0; ai < 2; ++ai)
#pragma unroll
            for (int m = 0; m < 4; ++m) {
                const int row = row0 + ai * HALF + m * 16;
                if (row < nrows) {
#pragma unroll
                    for (int n = 0; n < 2; ++n) {
                        const f32x4 b = *(const f32x4*)(bias + c * 128 + col0 + n * 16);
                        const f32x4 x = (c == 0 ? acc[ai][0][m][n] : acc[ai][1][m][n]) + b;
                        f32x4 o; o[0] = geluf_(x[0]); o[1] = geluf_(x[1]); o[2] = geluf_(x[2]); o[3] = geluf_(x[3]);
                        *(f32x4*)(CH + ((size_t)row * 2 + c) * 128 + col0 + n * 16) = o;
                    }
                }
            }
    }
};
struct EpiIn {
    static constexpr bool PERM = true, AFTER_DRAIN = false;
    const float* RS1; const float* q_g; const float* ks_g; const float* kw_g; const float* gate_b; float* out; bf16_t* QNb; float* KC32;
    bf16_t *KSb, *VSb, *KWb, *VWb; float* GT; bf16_t* PRb;
    __device__ __forceinline__ void operator()(const f32x4 (&acc)[2][2][4][2], const Unit& u, int wr, int wc, int fr, int fq) const {
        const int G = 4 * u.pn + wc;
        const int row0 = u.pm * BM + wr * 64 + fr;
        const bool nrm = (G < 8) || G == 12 || G == 13 || G == 16 || G == 17;
        f32x4 gn[2][2];
        if (nrm) {
#pragma unroll
            for (int bj = 0; bj < 2; ++bj)
#pragma unroll
                for (int n = 0; n < 2; ++n) {
                    const int go = 32 * bj + 8 * fq + 4 * n;
                    if (G < 8) gn[bj][n] = *(const f32x4*)(q_g + go) * 0.125f; else if (G < 14) gn[bj][n] = *(const f32x4*)(ks_g + go); else gn[bj][n] = *(const f32x4*)(kw_g + go);
                }
        }
#pragma unroll
        for (int ai = 0; ai < 2; ++ai)
#pragma unroll
            for (int m = 0; m < 4; ++m) {
                const int row = row0 + ai * HALF + m * 16;
                const float rs = __builtin_amdgcn_rsqf(RS1[row] * (1.f / D_MODEL) + RMS_EPS);
                const int nb = row / SEQ, ti = row % SEQ;
                f32x4 v[2][2];
#pragma unroll
                for (int bj = 0; bj < 2; ++bj)
#pragma unroll
                    for (int n = 0; n < 2; ++n) v[bj][n] = acc[ai][bj][m][n] * rs;
                if (nrm) {
                    float sq = 0.f;
#pragma unroll
                    for (int bj = 0; bj < 2; ++bj)
#pragma unroll
                        for (int n = 0; n < 2; ++n) sq += v[bj][n][0] * v[bj][n][0] + v[bj][n][1] * v[bj][n][1] + v[bj][n][2] * v[bj][n][2] + v[bj][n][3] * v[bj][n][3];
                    sq += __shfl_xor(sq, 16); sq += __shfl_xor(sq, 32);
                    const float rr = __builtin_amdgcn_rsqf(sq * (1.f / 64.f) + RMS_EPS);
#pragma unroll
                    for (int bj = 0; bj < 2; ++bj)
#pragma unroll
                        for (int n = 0; n < 2; ++n) v[bj][n] = v[bj][n] * rr * gn[bj][n];
                }
#pragma unroll
                for (int bj = 0; bj < 2; ++bj) {
                    const int d = 32 * bj + 8 * fq;
                    const f32x4 x0 = v[bj][0], x1 = v[bj][1];
                    u32x4 b; b[0] = cvt_pk_bf16(x0[0], x0[1]); b[1] = cvt_pk_bf16(x0[2], x0[3]); b[2] = cvt_pk_bf16(x1[0], x1[1]); b[3] = cvt_pk_bf16(x1[2], x1[3]);
                    if (G < 8) {
                        *(u32x4*)(QNb + (size_t)row * 512 + 64 * G + d) = b;
                    } else if (G < 20) {
                        const int c6 = (G - 8) >> 1, g = G & 1, cc = c6 * 128 + g * 64 + d;
                        if (c6 < 2) { float* q = KC32 + (size_t)row * 256 + cc; *(f32x4*)q = x0; *(f32x4*)(q + 4) = x1; }
                        if (c6 < 4) { float* q = out + O_KV_P + (size_t)row * 512 + cc; *(f32x4*)q = x0; *(f32x4*)(q + 4) = x1; }
                        else if (ti >= SEQ - WP) { float* q = out + O_WIN_P + ((size_t)nb * WP + (ti - (SEQ - WP))) * 256 + cc - 512; *(f32x4*)q = x0; *(f32x4*)(q + 4) = x1; }
                        if (c6 >= 2) {
                            const size_t o = (((size_t)nb * 2 + g) * SEQ + ti) * 64 + d;
                            if (c6 == 2) *(u32x4*)(KSb + o) = b; else if (c6 == 3) *(u32x4*)(VSb + o) = b; else if (c6 == 4) *(u32x4*)(KWb + o) = b; else *(u32x4*)(VWb + o) = b;
                        }
                    } else {
                        const int c = 64 * G + d - NSA_COLS;
                        if (c < 0) {
                            const f32x4 g0 = *(const f32x4*)(gate_b + d), g1 = *(const f32x4*)(gate_b + d + 4);
                            f32x4 a0, a1;
#pragma unroll
                            for (int e = 0; e < 4; ++e) { a0[e] = fast_sigmoid(x0[e] + g0[e]); a1[e] = fast_sigmoid(x1[e] + g1[e]); }
                            *(f32x4*)(GT + (size_t)row * 24 + d) = a0; *(f32x4*)(GT + (size_t)row * 24 + d + 4) = a1;
                        } else {
                            *(u32x4*)(PRb + (size_t)row * RWKV_COLS + c) = b;
                            if (ti == SEQ - 1) { float* q = out + O_SH_P + (size_t)nb * RWKV_COLS + c; *(f32x4*)q = x0; *(f32x4*)(q + 4) = x1; }
                        }
                    }
                }
            }
    }
};
struct EpiScale {
    static constexpr bool PERM = false, AFTER_DRAIN = false;
    float* C; int ldc; const float* ss;
    __device__ __forceinline__ void operator()(const f32x4 (&acc)[2][2][4][2], const Unit& u, int wr, int wc, int fr, int fq) const {
        const int row0 = u.pm * BM + wr * 64 + fr, col0 = u.pn * BM + wc * 32 + 4 * fq;
#pragma unroll
        for (int ai = 0; ai < 2; ++ai)
#pragma unroll
            for (int m = 0; m < 4; ++m) {
                const int row = row0 + ai * HALF + m * 16;
                const float rs = ss ? rs_of(ss[row], D_MODEL) : 1.f;
                float* rowp = C + (size_t)row * ldc + col0;
#pragma unroll
                for (int bj = 0; bj < 2; ++bj)
#pragma unroll
                    for (int n = 0; n < 2; ++n) *(f32x4*)(rowp + bj * HALF + n * 16) = acc[ai][bj][m][n] * rs;
            }
    }
};

template <class Epi, class Sched>
__device__ __forceinline__ void gemm_phase(PG8_LAS unsigned char* lds, const Gemm g, const Sched& S, const Epi& E) {
    const int tid = opaque_tid(), wid = __builtin_amdgcn_readfirstlane(tid >> 6), lane = tid & 63, wr = wid >> 2, wc = wid & 3, fr = lane & 15, fq = lane >> 4;
    const int K = g.K, nt = K / BK;
    unsigned voffA[2], voffB[2];
#pragma unroll
    for (int i = 0; i < 2; ++i) { int R, C; stage_rc(tid * 16 + i * 8192, R, C); const int Rb = Epi::PERM ? ((R & ~31) + perm32(R & 31)) : R;
        voffA[i] = (unsigned)(R * K + C) * 2u; voffB[i] = (unsigned)(Rb * K + C) * 2u; }
    const size_t kstep = (size_t)(BK * 2);
    const size_t hstep = (size_t)HALF * K * 2;
    const size_t tstep = 2 * hstep;
    const unsigned ldsw = (unsigned)wid * 1024u;
    const int aoff = lds_byte(wr * 64 + fr, fq * 8), boff = lds_byte(wc * 32 + fr, fq * 8);
#define PG8_SA(b, h) (((b) * 2 + (h)) * HTB)
#define PG8_SB(b, h) ((4 + (b) * 2 + (h)) * HTB)
#define PG8_STAGE(bufoff, gbase, voff) do { _Pragma("unroll") for (int _i = 0; _i < 2; ++_i) \
        __builtin_amdgcn_global_load_lds((const unsigned*)((const char*)(gbase) + (voff)[_i]), (PG8_LAS unsigned*)(lds + (bufoff) + ldsw + _i * 8192), 16, 0, 0); } while (0)
#define PG8_LDA(dst, b, h) do { _Pragma("unroll") for (int m = 0; m < 4; ++m) _Pragma("unroll") for (int k = 0; k < 2; ++k) dst[m][k] = *(const PG8_LAS bf16x8*)(lds + PG8_SA(b, h) + aoff + m * 2048 + k * 1024); } while (0)
#define PG8_LDB(dst, b, h) do { _Pragma("unroll") for (int n = 0; n < 2; ++n) _Pragma("unroll") for (int k = 0; k < 2; ++k) dst[n][k] = *(const PG8_LAS bf16x8*)(lds + PG8_SB(b, h) + boff + n * 2048 + k * 1024); } while (0)
#define PG8_MMA(ai, bj, At, Bt) do { __builtin_amdgcn_s_setprio(1); _Pragma("unroll") for (int m = 0; m < 4; ++m) _Pragma("unroll") for (int n = 0; n < 2; ++n) _Pragma("unroll") for (int k = 0; k < 2; ++k) \
        acc[ai][bj][m][n] = __builtin_amdgcn_mfma_f32_16x16x32_bf16(Bt[n][k], At[m][k], acc[ai][bj][m][n], 0, 0, 0); __builtin_amdgcn_s_setprio(0); } while (0)
#define PG8_WAIT_V(n) asm volatile("s_waitcnt vmcnt(" #n ")" ::: "memory")
#define PG8_WAIT_L(n) asm volatile("s_waitcnt lgkmcnt(" #n ")" ::: "memory")
#define PG8_BAR __builtin_amdgcn_s_barrier()
#define PG8_SCHED __builtin_amdgcn_sched_barrier(0)
    Unit cur, nxt; int ui = 0;
    if (!S.next(0, cur)) return;
    f32x4 acc[2][2][4][2];
#pragma unroll
    for (int a = 0; a < 2; ++a)
#pragma unroll
        for (int b = 0; b < 2; ++b)
#pragma unroll
            for (int m = 0; m < 4; ++m)
#pragma unroll
                for (int n = 0; n < 2; ++n) acc[a][b][m][n] = (f32x4){0.f, 0.f, 0.f, 0.f};
    bf16x8 At[4][2], B0[2][2], B1[2][2];
    const char* cA = (const char*)g.A + (size_t)cur.pm * tstep; const char* cB = (const char*)g.Bt + (size_t)cur.pn * tstep;
    S.a_ready(cur);
    PG8_STAGE(PG8_SB(0, 0), cB, voffB); PG8_STAGE(PG8_SA(0, 0), cA, voffA); PG8_STAGE(PG8_SB(0, 1), cB + hstep, voffB); PG8_STAGE(PG8_SA(0, 1), cA + hstep, voffA);
    if (wr == 1) PG8_BAR;
    PG8_WAIT_V(4); PG8_BAR;
    PG8_STAGE(PG8_SB(1, 0), cB + kstep, voffB); PG8_STAGE(PG8_SA(1, 0), cA + kstep, voffA); PG8_STAGE(PG8_SB(1, 1), cB + hstep + kstep, voffB);
    PG8_WAIT_V(6); PG8_BAR;
    for (;;) {
        const bool has_next = S.next(ui + 1, nxt);
        const char* nA = has_next ? (const char*)g.A + (size_t)nxt.pm * tstep : cA; const char* nB = has_next ? (const char*)g.Bt + (size_t)nxt.pn * tstep : cB;
        for (int t = 0; t < nt; t += 2) {
            const bool last = (t == nt - 2);
            const char* a1 = cA + (size_t)(t + 1) * kstep;
            const char* a2 = last ? nA : cA + (size_t)(t + 2) * kstep; const char* b2 = last ? nB : cB + (size_t)(t + 2) * kstep;
            const char* a3 = a2 + kstep; const char* b3 = b2 + kstep;
            if (last && has_next) S.a_ready(nxt);
            PG8_LDB(B0, 0, 0); PG8_SCHED; PG8_LDA(At, 0, 0); PG8_STAGE(PG8_SA(1, 1), a1 + hstep, voffA);
            PG8_WAIT_L(8); PG8_BAR; PG8_WAIT_L(0); PG8_MMA(0, 0, At, B0); PG8_BAR; PG8_SCHED;
            PG8_LDB(B1, 0, 1); PG8_STAGE(PG8_SB(0, 0), b2, voffB);
            PG8_BAR; PG8_WAIT_L(0); PG8_MMA(0, 1, At, B1); PG8_BAR;
            PG8_LDA(At, 0, 1); PG8_STAGE(PG8_SA(0, 0), a2, voffA);
            PG8_BAR; PG8_WAIT_L(0); PG8_MMA(1, 0, At, B0); PG8_BAR; PG8_SCHED;
            PG8_STAGE(PG8_SB(0, 1), b2 + hstep, voffB);
            PG8_WAIT_V(6); PG8_BAR; PG8_MMA(1, 1, At, B1); PG8_BAR;
            PG8_LDB(B0, 1, 0); PG8_SCHED; PG8_LDA(At, 1, 0); PG8_STAGE(PG8_SA(0, 1), a2 + hstep, voffA);
            PG8_WAIT_L(8); PG8_BAR; PG8_WAIT_L(0); PG8_MMA(0, 0, At, B0); PG8_BAR; PG8_SCHED;
            PG8_LDB(B1, 1, 1); PG8_STAGE(PG8_SB(1, 0), b3, voffB);
            PG8_BAR; PG8_WAIT_L(0); PG8_MMA(0, 1, At, B1); PG8_BAR;
            PG8_LDA(At, 1, 1); PG8_STAGE(PG8_SA(1, 0), a3, voffA);
            PG8_BAR; PG8_WAIT_L(0); PG8_MMA(1, 0, At, B0); PG8_BAR; PG8_SCHED;
            PG8_STAGE(PG8_SB(1, 1), b3 + hstep, voffB);
            PG8_WAIT_V(6); PG8_BAR; PG8_MMA(1, 1, At, B1); PG8_BAR;
        }
        E(acc, cur, wr, wc, fr, fq); S.done(cur);
        if (!has_next) break;
#pragma unroll
        for (int a = 0; a < 2; ++a)
#pragma unroll
            for (int b = 0; b < 2; ++b)
#pragma unroll
                for (int m = 0; m < 4; ++m)
#pragma unroll
                    for (int n = 0; n < 2; ++n) acc[a][b][m][n] = (f32x4){0.f, 0.f, 0.f, 0.f};
        cur = nxt; cA = nA; cB = nB; ++ui;
    }
    PG8_WAIT_V(0);
    if (wr == 0) PG8_BAR;
    PG8_BAR;
#undef PG8_SA
#undef PG8_SB
#undef PG8_STAGE
#undef PG8_LDA
#undef PG8_LDB
#undef PG8_MMA
#undef PG8_WAIT_V
#undef PG8_WAIT_L
#undef PG8_BAR
#undef PG8_SCHED
}
}

namespace nsa {
typedef short bf16x8 __attribute__((ext_vector_type(8)));
typedef short s16x4 __attribute__((ext_vector_type(4)));
typedef float f32x16 __attribute__((ext_vector_type(16)));
typedef unsigned u32x4 __attribute__((ext_vector_type(4)));
typedef unsigned u32x2 __attribute__((ext_vector_type(2)));
#define NSA_MFMA(a, b, c) __builtin_amdgcn_mfma_f32_32x32x16_bf16((a), (b), (c), 0, 0, 0)
constexpr int KROW = 144, TILE_B = 64 * KROW;
constexpr int L_K = 0, L_V = 2 * TILE_B, L_IMP = 4 * TILE_B, L_UN = L_IMP + 8 * 2048, L_END = L_UN + 128;
constexpr float LOG2E = 1.4426950408889634f;
#define NSA_NEG (-__builtin_inff())
__device__ __forceinline__ bf16x8 pack8(const f32x16& x, int s) {
    u32x4 p;
    asm volatile("v_cvt_pk_bf16_f32 %0, %4, %5\n\tv_cvt_pk_bf16_f32 %1, %6, %7\n\tv_cvt_pk_bf16_f32 %2, %8, %9\n\tv_cvt_pk_bf16_f32 %3, %10, %11\n\ts_nop 1"
                 : "=&v"(p[0]), "=&v"(p[1]), "=&v"(p[2]), "=&v"(p[3])
                 : "v"(x[8 * s]), "v"(x[8 * s + 1]), "v"(x[8 * s + 2]), "v"(x[8 * s + 3]), "v"(x[8 * s + 4]), "v"(x[8 * s + 5]), "v"(x[8 * s + 6]), "v"(x[8 * s + 7]));
    return __builtin_bit_cast(bf16x8, p);
}
template <int DS, int NDB, int KSTR, int VSTR, bool HASB>
__device__ __forceinline__ void tile_step_g(const LAS unsigned char* Kb, const LAS unsigned char* Vb, const bf16x8 (&qf)[DS], f32x16 (&o)[NDB], f32x16 (&st)[2],
                                            float& m_run, float& l_run, float SC, const bf16x8 (&kext)[2], const bf16x8& qext, int lim_lo, int lim_hi, int ql, int h) {
#pragma unroll
    for (int sub = 0; sub < 2; ++sub) {
#pragma unroll
        for (int i = 0; i < 16; ++i) st[sub][i] = 0.f;
#pragma unroll
        for (int s = 0; s < DS; ++s) {
            const bf16x8 a = *(const LAS bf16x8*)(Kb + (32 * sub + ql) * KSTR + 32 * s + 16 * h);
            st[sub] = NSA_MFMA(a, qf[s], st[sub]);
        }
        if (HASB) st[sub] = NSA_MFMA(kext[sub], qext, st[sub]);
    }
    __builtin_amdgcn_sched_barrier(0);
    float mloc = NSA_NEG;
    const bool rowfull = (lim_lo <= 0 && lim_hi >= 59), rownone = (lim_hi < 0) || (lim_lo > 63);
    bool dead = false;
    if (__all(rowfull || rownone)) {
#pragma unroll
        for (int sub = 0; sub < 2; ++sub)
#pragma unroll
            for (int i = 0; i < 16; ++i) mloc = fmaxf(mloc, st[sub][i]);
        dead = rownone;
        if (dead) mloc = NSA_NEG;
    } else {
#pragma unroll
        for (int sub = 0; sub < 2; ++sub)
#pragma unroll
            for (int i = 0; i < 16; ++i) {
                const int c = 32 * sub + (i & 3) + 8 * (i >> 2);
                const float sv = ((c >= lim_lo) && (c <= lim_hi)) ? st[sub][i] : NSA_NEG;
                st[sub][i] = sv; mloc = fmaxf(mloc, sv);
            }
    }
    mloc = xhalf_max(mloc);
    const float mnew = fmaxf(m_run, mloc);
    const float msafe = (mnew == NSA_NEG) ? 0.f : mnew;
    const float alpha = __builtin_amdgcn_exp2f((m_run - msafe) * SC);
    const float nm = dead ? NSA_NEG : -msafe * SC;
    m_run = mnew;
    float ls = 0.f;
#pragma unroll
    for (int sub = 0; sub < 2; ++sub)
#pragma unroll
        for (int i = 0; i < 16; ++i) { const float pv = __builtin_amdgcn_exp2f(fmaf(st[sub][i], SC, nm)); st[sub][i] = pv; ls += pv; }
    l_run = l_run * alpha + ls;
    if (!__all(alpha == 1.f)) {
#pragma unroll
        for (int db = 0; db < NDB; ++db)
#pragma unroll
            for (int i = 0; i < 16; ++i) o[db][i] *= alpha;
    }
    __builtin_amdgcn_sched_barrier(0);
#pragma unroll
    for (int sub = 0; sub < 2; ++sub)
#pragma unroll
        for (int s2 = 0; s2 < 2; ++s2) {
            __builtin_amdgcn_sched_barrier(0);
            const bf16x8 pf = pack8(st[sub], s2);
#pragma unroll
            for (int db = 0; db < NDB; ++db) {
                const LAS unsigned char* vr = Vb + (32 * db + ql) * VSTR + (32 * sub + 16 * s2 + 4 * h) * 2;
                const s16x4 lo = *(const LAS s16x4*)(vr), hi = *(const LAS s16x4*)(vr + 16);
                const bf16x8 vf = __builtin_shufflevector(lo, hi, 0, 1, 2, 3, 4, 5, 6, 7);
                o[db] = NSA_MFMA(vf, pf, o[db]);
            }
        }
}
__device__ __forceinline__ bf16x8 bias_kext(int c64, int c65, int h) {
    bf16x8 v = {0, 0, 0, 0, 0, 0, 0, 0};
    if (h == 0) { v[0] = (short)f2bf((float)c64); v[1] = (short)f2bf((float)c65); }
    return v;
}
__device__ __forceinline__ bf16x8 bias_qext(float slope, int h) {
    bf16x8 v = {0, 0, 0, 0, 0, 0, 0, 0};
    if (h == 0) { v[0] = (short)f2bf(64.f * slope); v[1] = (short)f2bf(slope); }
    return v;
}
struct TileSrc { const unsigned short* k; const unsigned short* v; long vstride; };
__device__ __forceinline__ void tile_issue(const TileSrc& t, int tid, u32x4& kr, u32x4& vr) {
    const int row = tid >> 3, seg = tid & 7;
    kr = *(const u32x4*)(t.k + row * 64 + seg * 8);
    vr = *(const u32x4*)(t.v + (t.vstride > 0 ? (long)row * t.vstride : (long)row * 64) + seg * 8);
}
template <bool VT>
__device__ __forceinline__ void tile_commit(LAS unsigned char* lds, int buf, int tid, const u32x4& kr, const u32x4& vr) {
    const int row = tid >> 3, seg = tid & 7;
    *(LAS u32x4*)(lds + L_K + buf * TILE_B + row * KROW + seg * 16) = kr;
    if (VT) *(LAS u32x4*)(lds + L_V + buf * TILE_B + row * KROW + seg * 16) = vr;
    else {
        LAS unsigned char* vb = lds + L_V + buf * TILE_B + (seg * 8) * KROW + row * 2;
#pragma unroll
        for (int e = 0; e < 8; ++e) *(LAS unsigned short*)(vb + e * KROW) = (unsigned short)(vr[e >> 1] >> (16 * (e & 1)));
    }
}

__device__ __forceinline__ void prompt_unit(const Params& p, LAS unsigned char* lds, int n, int g, int qb) {
    const int tid = opaque_tid(), lane = tid & 63, w = __builtin_amdgcn_readfirstlane(tid >> 6), ql = lane & 31, h = lane >> 5;
    const int tloc = ql >> 2, r = ql & 3, tl = 8 * w + tloc, head = g * 4 + r;
    const int t0 = qb * 64, tq = t0 + tl;
    const long m = (long)n * SEQ + tq;
    const bf16x8 qext = bias_qext(exp2f(-(float)(head + 1)), h);
    bf16x8 qf[4];
#pragma unroll
    for (int s = 0; s < 4; ++s) qf[s] = *(const bf16x8*)(p.QNb + m * 512 + head * 64 + 16 * s + 8 * h);
    const float gc = p.GT[m * 24 + head * 3 + 0], gs = p.GT[m * 24 + head * 3 + 1], gw = p.GT[m * 24 + head * 3 + 2];
    f32x16 outacc[2], o[2], st[2];
#pragma unroll
    for (int db = 0; db < 2; ++db)
#pragma unroll
        for (int i = 0; i < 16; ++i) { outacc[db][i] = 0.f; o[db][i] = 0.f; }
    u32x4 kr, vr;
    const long ng = (long)n * 2 + g;
    {
        TileSrc ts{p.KCb + ng * NBP * 64, p.VCt + ng * 64 * NBP, NBP};
        tile_issue(ts, tid, kr, vr); tile_commit<true>(lds, 0, tid, kr, vr);
        __syncthreads();
        float m_run = NSA_NEG, l_run = 0.f;
        const bf16x8 kext[2] = {bias_kext(ql - qb, 63, h), bias_kext(32 + ql - qb, 63, h)};
        tile_step_g<4, 2, KROW, KROW, true>(lds + L_K, lds + L_V, qf, o, st, m_run, l_run, LOG2E, kext, qext, -1000, ((tq + 1) >> 6) - 1 - 4 * h, ql, h);
        const float ltot = xhalf_sum(l_run);
        const float inv = ltot > 0.f ? 1.f / ltot : 0.f;
#pragma unroll
        for (int db = 0; db < 2; ++db)
#pragma unroll
            for (int i = 0; i < 16; ++i) { outacc[db][i] += gc * inv * o[db][i]; o[db][i] = 0.f; }
        LAS float* impw = (LAS float*)(lds + L_IMP + w * 2048);
#pragma unroll
        for (int sub = 0; sub < 2; ++sub)
#pragma unroll
            for (int i = 0; i < 16; ++i) {
                float v = st[sub][i] * inv;
                v += __shfl_xor(v, 1); v += __shfl_xor(v, 2);
                const int kk = 32 * sub + (i & 3) + 8 * (i >> 2) + 4 * h;
                if (r == 0) impw[tloc * 64 + kk] = v;
            }
    }
    __syncthreads();
    unsigned long long mymask = 0ull, un = 0ull;
    {
        const LAS float* impw = (const LAS float*)(lds + L_IMP + w * 2048);
        for (int tt = 0; tt < 8; ++tt) {
            const int b = lane;
            const bool forced = (b == 0) || (b == qb) || (b == qb - 1);
            float sc = forced ? 1e9f : ((b <= qb) ? impw[tt * 64 + b] : -1e9f);
            const unsigned ub = __float_as_uint(sc), key = (ub & 0x80000000u) ? ~ub : (ub | 0x80000000u);
            unsigned T = 0u;
#pragma unroll
            for (int bit = 31; bit >= 0; --bit) {
                const unsigned cand = T | (1u << bit);
                if (__popcll(__ballot(key >= cand)) >= N_SEL) T = cand;
            }
            unsigned long long mk = __ballot(key > T), eqm = __ballot(key == T);
            int need = N_SEL - (int)__popcll(mk);
            while (need > 0 && eqm != 0ull) { const unsigned long long low = eqm & (0ull - eqm); mk |= low; eqm ^= low; --need; }
            if (tloc == tt) mymask = mk;
            un |= mk;
        }
        if (lane == 0) *(LAS unsigned long long*)(lds + L_UN + w * 8) = un;
    }
    __syncthreads();
    {
        unsigned long long u2 = 0ull;
#pragma unroll
        for (int k = 0; k < 8; ++k) u2 |= *(const LAS unsigned long long*)(lds + L_UN + k * 8);
        un = u2;
        const unsigned lo32 = __builtin_amdgcn_readfirstlane((unsigned)un), hi32 = __builtin_amdgcn_readfirstlane((unsigned)(un >> 32));
        un = ((unsigned long long)hi32 << 32) | lo32;
        if (qb < 63) un &= ((1ull << (qb + 1)) - 1ull);
    }
    {
        float m_run = NSA_NEG, l_run = 0.f;
        unsigned long long rem = un;
        auto nextb = [&]() { if (rem == 0ull) return -1; const int x = 63 - (int)__builtin_clzll(rem); rem &= ~(1ull << x); return x; };
        u32x4 kr2, vr2;
        int b = nextb(), b1 = nextb();
        { TileSrc ts{p.KSb + (ng * SEQ + (long)b * 64) * 64, p.VSb + (ng * SEQ + (long)b * 64) * 64, 0}; tile_issue(ts, tid, kr, vr); tile_commit<false>(lds, 0, tid, kr, vr); }
        if (b1 >= 0) { TileSrc ts{p.KSb + (ng * SEQ + (long)b1 * 64) * 64, p.VSb + (ng * SEQ + (long)b1 * 64) * 64, 0}; tile_issue(ts, tid, kr, vr); }
        __syncthreads();
        int buf = 0;
        for (;;) {
            const int b2 = (b1 >= 0) ? nextb() : -1;
            if (b2 >= 0) { TileSrc tn{p.KSb + (ng * SEQ + (long)b2 * 64) * 64, p.VSb + (ng * SEQ + (long)b2 * 64) * 64, 0}; tile_issue(tn, tid, kr2, vr2); }
            const int kb0 = b * 64;
            const bool selb = (mymask >> b) & 1ull;
            const bf16x8 kext[2] = {bias_kext(b - qb, ql, h), bias_kext(b - qb, 32 + ql, h)};
            tile_step_g<4, 2, KROW, KROW, true>(lds + L_K + buf * TILE_B, lds + L_V + buf * TILE_B, qf, o, st, m_run, l_run, LOG2E, kext, qext, -1000,
                                                selb ? (tq - kb0 - 4 * h) : -2000, ql, h);
            if (b1 >= 0) tile_commit<false>(lds, buf ^ 1, tid, kr, vr);
            __syncthreads();
            if (b1 < 0) break;
            b = b1; b1 = b2; kr = kr2; vr = vr2; buf ^= 1;
        }
        const float ltot = xhalf_sum(l_run);
        const float inv = ltot > 0.f ? 1.f / ltot : 0.f;
#pragma unroll
        for (int db = 0; db < 2; ++db)
#pragma unroll
            for (int i = 0; i < 16; ++i) { outacc[db][i] += gs * inv * o[db][i]; o[db][i] = 0.f; }
    }
    {
        float m_run = NSA_NEG, l_run = 0.f;
        int b = qb; const int blo = (qb - WINDOW / 64) < 0 ? 0 : (qb - WINDOW / 64);
        u32x4 kr2, vr2;
        { TileSrc ts{p.KWb + (ng * SEQ + (long)b * 64) * 64, p.VWb + (ng * SEQ + (long)b * 64) * 64, 0}; tile_issue(ts, tid, kr, vr); tile_commit<false>(lds, 0, tid, kr, vr); }
        if (b - 1 >= blo) { TileSrc ts{p.KWb + (ng * SEQ + (long)(b - 1) * 64) * 64, p.VWb + (ng * SEQ + (long)(b - 1) * 64) * 64, 0}; tile_issue(ts, tid, kr, vr); }
        __syncthreads();
        int buf = 0;
        for (;;) {
            const bool more = b - 1 >= blo;
            if (b - 2 >= blo) { TileSrc tn{p.KWb + (ng * SEQ + (long)(b - 2) * 64) * 64, p.VWb + (ng * SEQ + (long)(b - 2) * 64) * 64, 0}; tile_issue(tn, tid, kr2, vr2); }
            const int kb0 = b * 64;
            const bf16x8 kext[2] = {bias_kext(b - qb, ql, h), bias_kext(b - qb, 32 + ql, h)};
            tile_step_g<4, 2, KROW, KROW, true>(lds + L_K + buf * TILE_B, lds + L_V + buf * TILE_B, qf, o, st, m_run, l_run, LOG2E, kext, qext,
                                                tq - (WINDOW - 1) - kb0 - 4 * h, tq - kb0 - 4 * h, ql, h);
            if (more) tile_commit<false>(lds, buf ^ 1, tid, kr, vr);
            __syncthreads();
            if (!more) break;
            --b; kr = kr2; vr = vr2; buf ^= 1;
        }
        const float ltot = xhalf_sum(l_run);
        const float inv = ltot > 0.f ? 1.f / ltot : 0.f;
#pragma unroll
        for (int db = 0; db < 2; ++db)
#pragma unroll
            for (int i = 0; i < 16; ++i) outacc[db][i] += gw * inv * o[db][i];
    }
#pragma unroll
    for (int db = 0; db < 2; ++db)
#pragma unroll
        for (int g4 = 0; g4 < 4; ++g4) {
            u32x2 v; v[0] = pg8::cvt_pk_bf16(outacc[db][4 * g4 + 0], outacc[db][4 * g4 + 1]); v[1] = pg8::cvt_pk_bf16(outacc[db][4 * g4 + 2], outacc[db][4 * g4 + 3]);
            *(u32x2*)(p.MIXb + m * MIX_W + head * 64 + 32 * db + 8 * g4 + 4 * h) = v;
        }
}
__device__ __forceinline__ void prompt_phase(const Params& p, LAS unsigned char* lds) {
    const int nu = BATCH * 2 * NBP;
    for (int u = blockIdx.x; u < nu; u += gridDim.x) {
        const int per = BATCH * 2;
        const int rnd = u / 256, idx = u % 256;
        int qb, ngi;
        if (NBP == 64 && per == 16) {
            const int a = idx / 16; ngi = idx % 16;
            qb = rnd == 0 ? 63 - a : rnd == 1 ? 32 + a : rnd == 2 ? 31 - a : a;
        } else { qb = NBP - 1 - u / per; ngi = u % per; }
        prompt_unit(p, lds, ngi >> 1, (ngi & 1) ^ (rnd & 1), qb);
    }
}

__device__ __forceinline__ void prompt_phase_q(const Params& p, LAS unsigned char* lds, unsigned* ctr) {
    const int nu = BATCH * 2 * NBP, per = BATCH * 2;
    volatile LAS int* slot = (volatile LAS int*)(lds + (159744 - 256 + 64));
    for (;;) {
        if (threadIdx.x == 0) *slot = (int)__hip_atomic_fetch_add(ctr, 1u, __ATOMIC_RELAXED, __HIP_MEMORY_SCOPE_AGENT);
        __syncthreads();
        const int u = __builtin_amdgcn_readfirstlane(*slot);
        __syncthreads();
        if (u >= nu) break;
        const int qb = NBP - 1 - u / per, ngi = u % per;
        prompt_unit(p, lds, ngi >> 1, ngi & 1, qb);
    }
}

constexpr int XK_ROW = 272, XK_TILE = 64 * XK_ROW, XV_TILE = 128 * KROW, XL_K = 0, XL_V = 2 * XK_TILE;
__device__ __forceinline__ void x_issue(const unsigned short* kb, const unsigned short* vb, int tid, u32x4 (&kr)[2], u32x4 (&vr)[2]) {
#pragma unroll
    for (int q = 0; q < 2; ++q) { const int idx = tid + 512 * q; kr[q] = *(const u32x4*)(kb + idx * 8); vr[q] = *(const u32x4*)(vb + idx * 8); }
}
__device__ __forceinline__ void x_commit(LAS unsigned char* lds, int buf, int tid, const u32x4 (&kr)[2], const u32x4 (&vr)[2]) {
#pragma unroll
    for (int q = 0; q < 2; ++q) {
        const int idx = tid + 512 * q, row = idx >> 4, seg = idx & 15;
        *(LAS u32x4*)(lds + XL_K + buf * XK_TILE + row * XK_ROW + seg * 16) = kr[q];
        LAS unsigned char* vt = lds + XL_V + buf * XV_TILE + (seg * 8) * KROW + row * 2;
#pragma unroll
        for (int e = 0; e < 8; ++e) *(LAS unsigned short*)(vt + e * KROW) = (unsigned short)(vr[q][e >> 1] >> (16 * (e & 1)));
    }
}
__device__ __forceinline__ void xattn_unit(const Params& p, LAS unsigned char* lds, const unsigned short* kb, const unsigned short* vb, long m0, int nv, int head) {
    const int tid = opaque_tid(), lane = tid & 63, w = __builtin_amdgcn_readfirstlane(tid >> 6), ql = lane & 31, h = lane >> 5;
    const int rowi = 32 * w + ql; const bool valid = rowi < nv;
    const long m = m0 + (valid ? rowi : 0);
    bf16x8 qf[8];
    {
        const unsigned short* qrow = p.XQb + m * XW + head * 128 + 8 * h;
        const float* gq = p.in[I_XQ_G] + 8 * h;
        float ss = 0.f;
#pragma unroll
        for (int s = 0; s < 8; ++s)
#pragma unroll
            for (int j = 0; j < 8; ++j) { const float v = bf2f(qrow[16 * s + j]); ss += v * v; }
        ss += __shfl_xor(ss, 32);
        const float r = valid ? (1.f / sqrtf(ss * (1.f / 128.f) + RMS_EPS)) * (LOG2E * 0.08838834764831845f) : 0.f;
#pragma unroll
        for (int s = 0; s < 8; ++s)
#pragma unroll
            for (int j = 0; j < 8; ++j) qf[s][j] = (short)f2bf(bf2f(qrow[16 * s + j]) * r * gq[16 * s + j]);
    }
    f32x16 o[4], st[2];
#pragma unroll
    for (int db = 0; db < 4; ++db)
#pragma unroll
        for (int i = 0; i < 16; ++i) o[db][i] = 0.f;
    u32x4 kr[2], vr[2];
    x_issue(kb, vb, tid, kr, vr); x_commit(lds, 0, tid, kr, vr);
    __syncthreads();
    float m_run = NSA_NEG, l_run = 0.f;
    const bf16x8 kext0[2] = {{0, 0, 0, 0, 0, 0, 0, 0}, {0, 0, 0, 0, 0, 0, 0, 0}};
    constexpr int NT = N_MEM / 64;
    for (int t = 0; t < NT; ++t) {
        const bool more = t + 1 < NT;
        if (more) x_issue(kb + (long)(t + 1) * 64 * 128, vb + (long)(t + 1) * 64 * 128, tid, kr, vr);
        tile_step_g<8, 4, XK_ROW, KROW, false>(lds + XL_K + (t & 1) * XK_TILE, lds + XL_V + (t & 1) * XV_TILE, qf, o, st, m_run, l_run, 1.f, kext0, kext0[0], -1000, 1000, ql, h);
        if (more) x_commit(lds, (t + 1) & 1, tid, kr, vr);
        __syncthreads();
    }
    const float ltot = xhalf_sum(l_run);
    const float inv = 1.f / ltot;
    if (valid) {
#pragma unroll
        for (int db = 0; db < 4; ++db)
#pragma unroll
            for (int g4 = 0; g4 < 4; ++g4) {
                u32x2 v; v[0] = pg8::cvt_pk_bf16(o[db][4 * g4 + 0] * inv, o[db][4 * g4 + 1] * inv); v[1] = pg8::cvt_pk_bf16(o[db][4 * g4 + 2] * inv, o[db][4 * g4 + 3] * inv);
                *(u32x2*)(p.OXb + m * XW + head * 128 + 32 * db + 8 * g4 + 4 * h) = v;
            }
    }
}
__device__ __forceinline__ void xattn_phase(const Params& p, LAS unsigned char* lds) {
    constexpr int QT = SEQ / 256, NPU = BATCH * 4 * QT, NSU = DEC_BATCH * 4;
    for (int u = blockIdx.x; u < NPU + NSU; u += gridDim.x) {
        if (u < NPU) {
            const int qt = u % QT, nh = u / QT, hd = nh % 4, n = nh / 4;
            xattn_unit(p, lds, p.XKb + (long)nh * N_MEM * 128, p.XVb + (long)nh * N_MEM * 128, (long)n * SEQ + qt * 256, 256, hd);
        } else {
            const int nh = u - NPU, hd = nh % 4, n = nh / 4;
            xattn_unit(p, lds, p.XKSb + (long)nh * N_MEM * 128, p.XVSb + (long)nh * N_MEM * 128, (long)MP + (long)n * DEC_SEQ, DEC_SEQ, hd);
        }
    }
}

constexpr int SW_BYTES = 16384, S_SH = 8 * SW_BYTES, S_ML = S_SH, S_OACC = S_ML + 3 * 2048, S_IMP = S_OACC + 8192, S_MASK = S_IMP + 8 * 320 * 4, S_END = S_MASK + 8 * 8 * 8;
__device__ __forceinline__ void stage_f32(LAS unsigned char* wk, LAS unsigned char* wv, const float* kp, const float* vp, long stride, int nvalid, int lane) {
    const int q = lane & 15, r0 = lane >> 4;
    const float* kb = kp + q * 4; const float* vb = vp + q * 4;
#pragma unroll 1
    for (int half = 0; half < 2; ++half) {
        pg8::f32x4 kv[8], vv[8];
#pragma unroll
        for (int it = 0; it < 8; ++it) {
            const int row = (half * 8 + it) * 4 + r0;
            kv[it] = (pg8::f32x4){0.f, 0.f, 0.f, 0.f}; vv[it] = (pg8::f32x4){0.f, 0.f, 0.f, 0.f};
            if (row < nvalid) { kv[it] = *(const pg8::f32x4*)(kb + (long)row * stride); vv[it] = *(const pg8::f32x4*)(vb + (long)row * stride); }
        }
#pragma unroll
        for (int it = 0; it < 8; ++it) {
            const int row = (half * 8 + it) * 4 + r0;
            u32x2 pk; pk[0] = pg8::cvt_pk_bf16(kv[it][0], kv[it][1]); pk[1] = pg8::cvt_pk_bf16(kv[it][2], kv[it][3]);
            *(LAS u32x2*)(wk + row * 128 + q * 8) = pk;
#pragma unroll
            for (int e = 0; e < 4; ++e) *(LAS unsigned short*)(wv + (q * 4 + e) * 128 + row * 2) = f2bf(vv[it][e]);
        }
    }
    asm volatile("s_waitcnt vmcnt(0) lgkmcnt(0)" ::: "memory");
}
__device__ __forceinline__ float combine_branch(LAS unsigned char* lds, int slot, int w, int ql, int h, float m_run, float l_run, const f32x16 (&o)[2], float gate) {
    LAS float* ml = (LAS float*)(lds + S_ML + slot * 2048);
    const float ltot = xhalf_sum(l_run);
    if (h == 0) { ml[(w * 32 + ql) * 2] = m_run; ml[(w * 32 + ql) * 2 + 1] = ltot; }
    __syncthreads();
    float M = NSA_NEG;
#pragma unroll
    for (int k = 0; k < 8; ++k) M = fmaxf(M, ml[(k * 32 + ql) * 2]);
    const float Ms = (M == NSA_NEG) ? 0.f : M;
    float L = 0.f;
#pragma unroll
    for (int k = 0; k < 8; ++k) L += ml[(k * 32 + ql) * 2 + 1] * __builtin_amdgcn_exp2f((ml[(k * 32 + ql) * 2] - Ms) * LOG2E);
    const float f = (L > 0.f) ? __builtin_amdgcn_exp2f((m_run - Ms) * LOG2E) / L : 0.f;
    const float gf = gate * f;
    if (gf != 0.f) {
        LAS float* oa = (LAS float*)(lds + S_OACC) + ql * 64;
#pragma unroll
        for (int db = 0; db < 2; ++db)
#pragma unroll
            for (int i = 0; i < 16; ++i)
                (void)__hip_atomic_fetch_add(oa + 32 * db + (i & 3) + 8 * (i >> 2) + 4 * h, gf * o[db][i], __ATOMIC_RELAXED, __HIP_MEMORY_SCOPE_WORKGROUP);
    }
    return f;
}
__device__ __forceinline__ void sample_unit(const Params& p, LAS unsigned char* lds, int n, int g) {
    static_assert(NBS % 64 == 0 && NBS / 64 <= 8 && WBUF == 512 && DEC_SEQ == 8 && NBS + 1 <= 320, "sample NSA unit geometry");
    const int tid = opaque_tid(), lane = tid & 63, w = __builtin_amdgcn_readfirstlane(tid >> 6), ql = lane & 31, h = lane >> 5;
    const int tloc = ql >> 2, r = ql & 3, head = g * 4 + r;
    const int tq = PAST_LEN + tloc, t0 = PAST_LEN;
    const long m = (long)MP + (long)n * DEC_SEQ + tloc;
    const bf16x8 qext = bias_qext(exp2f(-(float)(head + 1)), h);
    LAS unsigned char* wk = lds + w * SW_BYTES; LAS unsigned char* wv = wk + 8192;
    bf16x8 qf[4];
#pragma unroll
    for (int s = 0; s < 4; ++s) qf[s] = *(const bf16x8*)(p.QNb + m * 512 + head * 64 + 16 * s + 8 * h);
    const float gc = p.GT[m * 24 + head * 3 + 0], gs = p.GT[m * 24 + head * 3 + 1], gw = p.GT[m * 24 + head * 3 + 2];
    for (int i = tid; i < 2048; i += 512) ((LAS float*)(lds + S_OACC))[i] = 0.f;
    f32x16 o[2], st[2];
    const int* pt = (const int*)p.in[I_PAGE_TABLE] + n * NPAGES;
    const float* newrow = p.KVW + ((long)MP + (long)n * DEC_SEQ) * 768;
    {
#pragma unroll
        for (int db = 0; db < 2; ++db)
#pragma unroll
            for (int i = 0; i < 16; ++i) o[db][i] = 0.f;
        float m_run = NSA_NEG, l_run = 0.f;
        const bool mine = w < NBS / 64;
        if (mine) {
            const float* kp = p.KCS + (((long)n * NBS + w * 64) * 2 + g) * 64; const float* vp = p.VCS + (((long)n * NBS + w * 64) * 2 + g) * 64;
            stage_f32(wk, wv, kp, vp, 128, 64, lane);
            const bf16x8 kext[2] = {bias_kext(w * 64 + ql - NBS, 63, h), bias_kext(w * 64 + 32 + ql - NBS, 63, h)};
            tile_step_g<4, 2, 128, 128, true>(wk, wv, qf, o, st, m_run, l_run, LOG2E, kext, qext, -1000, 1000, ql, h);
        }
        const float f = combine_branch(lds, 0, w, ql, h, m_run, l_run, o, gc);
        if (mine) {
            LAS float* imp = (LAS float*)(lds + S_IMP) + tloc * 320;
#pragma unroll
            for (int sub = 0; sub < 2; ++sub)
#pragma unroll
                for (int i = 0; i < 16; ++i) {
                    float v = st[sub][i] * f;
                    v += __shfl_xor(v, 1); v += __shfl_xor(v, 2);
                    if (r == 0) imp[w * 64 + 32 * sub + (i & 3) + 8 * (i >> 2) + 4 * h] = v;
                }
        }
    }
    __syncthreads();
    {
        LAS float* sc = (LAS float*)(lds + S_IMP) + w * 320;
        float scq[5]; int rk[5];
#pragma unroll
        for (int q = 0; q < 5; ++q) {
            const int b = lane + 64 * q;
            const bool forced = (b == 0) || (b == NBS) || (b == NBS - 1);
            float v = -3e38f;
            if (b <= NBS) v = forced ? 1e9f : sc[b];
            scq[q] = v; rk[q] = 0;
        }
        asm volatile("s_waitcnt lgkmcnt(0)" ::: "memory");
#pragma unroll
        for (int q = 0; q < 5; ++q) sc[lane + 64 * q] = scq[q];
        asm volatile("s_waitcnt lgkmcnt(0)" ::: "memory");
        for (int j = 0; j <= NBS; ++j) {
            const float sj = sc[j];
#pragma unroll
            for (int q = 0; q < 5; ++q) rk[q] += (sj > scq[q] || (sj == scq[q] && j < lane + 64 * q)) ? 1 : 0;
        }
#pragma unroll
        for (int q = 0; q < 5; ++q) {
            const unsigned long long mk = __ballot(rk[q] < N_SEL && (lane + 64 * q) <= NBS);
            if (lane == 0) *(LAS unsigned long long*)(lds + S_MASK + (w * 8 + q) * 8) = mk;
        }
    }
    __syncthreads();
    {
#pragma unroll
        for (int db = 0; db < 2; ++db)
#pragma unroll
            for (int i = 0; i < 16; ++i) o[db][i] = 0.f;
        float m_run = NSA_NEG, l_run = 0.f;
        int k = 0;
        for (int q = 0; q < 5; ++q) {
            unsigned long long un = 0ull;
#pragma unroll
            for (int t = 0; t < 8; ++t) un |= *(const LAS unsigned long long*)(lds + S_MASK + (t * 8 + q) * 8);
            const unsigned lo32 = __builtin_amdgcn_readfirstlane((unsigned)un), hi32 = __builtin_amdgcn_readfirstlane((unsigned)(un >> 32));
            un = ((unsigned long long)hi32 << 32) | lo32;
            const unsigned long long mine_mask = *(const LAS unsigned long long*)(lds + S_MASK + (tloc * 8 + q) * 8);
            while (un) {
                const int bit = (int)__builtin_ctzll(un); un &= un - 1ull;
                const int b = 64 * q + bit;
                if ((k++ & 7) != w) continue;
                const float *kp, *vp; long stride; int nvalid;
                if (b < NBS) {
                    const long phys = pt[b / BPP];
                    kp = p.in[I_CACHE_KV] + (((phys * PAGE_SIZE + (long)(b % BPP) * 64) * 4 + 2) * 2 + g) * 64; vp = kp + 128; stride = 512; nvalid = 64;
                } else { kp = newrow + 256 + g * 64; vp = newrow + 384 + g * 64; stride = 768; nvalid = DEC_SEQ; }
                stage_f32(wk, wv, kp, vp, stride, nvalid, lane);
                const int kb0 = b * 64;
                const bool selb = (mine_mask >> bit) & 1ull;
                const bf16x8 kext[2] = {bias_kext(b - NBS, ql, h), bias_kext(b - NBS, 32 + ql, h)};
                tile_step_g<4, 2, 128, 128, true>(wk, wv, qf, o, st, m_run, l_run, LOG2E, kext, qext, -1000, selb ? (tq - kb0 - 4 * h) : -2000, ql, h);
            }
        }
        (void)combine_branch(lds, 1, w, ql, h, m_run, l_run, o, gs);
    }
    {
#pragma unroll
        for (int db = 0; db < 2; ++db)
#pragma unroll
            for (int i = 0; i < 16; ++i) o[db][i] = 0.f;
        float m_run = NSA_NEG, l_run = 0.f;
        for (int t = w; t < 9; t += 8) {
            const float *kp, *vp; long stride; int nvalid, kb0;
            if (t < 8) { kp = p.in[I_CACHE_WIN] + ((long)n * WBUF + 64 * t) * 256 + g * 64; vp = kp + 128; stride = 256; nvalid = 64; kb0 = PAST_LEN - WBUF + 64 * t; }
            else { kp = newrow + 512 + g * 64; vp = newrow + 640 + g * 64; stride = 768; nvalid = DEC_SEQ; kb0 = PAST_LEN; }
            stage_f32(wk, wv, kp, vp, stride, nvalid, lane);
            const bf16x8 kext[2] = {bias_kext((kb0 - t0) / 64, ql, h), bias_kext((kb0 - t0) / 64, 32 + ql, h)};
            tile_step_g<4, 2, 128, 128, true>(wk, wv, qf, o, st, m_run, l_run, LOG2E, kext, qext, tq - (WINDOW - 1) - kb0 - 4 * h, tq - kb0 - 4 * h, ql, h);
        }
        (void)combine_branch(lds, 2, w, ql, h, m_run, l_run, o, gw);
    }
    __syncthreads();
    for (int i = tid; i < 2048; i += 512) {
        const int row = i >> 6, d = i & 63, tl = row >> 2, rr = row & 3;
        const float v = ((const LAS float*)(lds + S_OACC))[i];
        const long mm = (long)MP + (long)n * DEC_SEQ + tl;
        p.MIXb[mm * MIX_W + (g * 4 + rr) * 64 + d] = f2bf(v);
    }
    __syncthreads();
}
static_assert(S_END <= 159744 - 256, "sample NSA LDS map");
__device__ __forceinline__ void sample_phase(const Params& p, LAS unsigned char* lds) {
    for (int u = blockIdx.x; u < DEC_BATCH * 2; u += gridDim.x) sample_unit(p, lds, u >> 1, u & 1);
}
}

namespace ew { __device__ __forceinline__ float wsum(float v); }
namespace rw {
typedef float f32x2 __attribute__((ext_vector_type(2)));
typedef float f32x4 __attribute__((ext_vector_type(4)));
constexpr int SB = 4, STEP_B = 6 * 64 * 4, SUB_B = SB * STEP_B, WAVE_B = 2 * SUB_B;
__device__ __forceinline__ void wave_sync() { asm volatile("s_waitcnt vmcnt(0) lgkmcnt(0)" ::: "memory"); }
__device__ __forceinline__ void lds_sync() { asm volatile("s_waitcnt lgkmcnt(0)" ::: "memory"); }
typedef unsigned u32x4_ __attribute__((ext_vector_type(4)));
struct StageRegs { f32x4 fr[3]; u32x4_ hr[2]; };
__device__ __forceinline__ void stage_issue(const Params& p, long m, int h, int lane, StageRegs& rg, bool skip_v = false) {
    const float* fb = p.RWB + m * 1536 + h * 64;
    const unsigned short* hb_ = p.RWH + m * 1536 + h * 64;
#pragma unroll
    for (int q = 0; q < 3; ++q) {
        const int idx = q * 64 + lane, seg = idx >> 4, f = idx & 15, st = seg / 3, vv = seg % 3;
        const int off = st * 1536 + vv * 512 + f * 4;
        rg.fr[q] = *(const f32x4*)(fb + off);
    }
#pragma unroll
    for (int q = 0; q < 2; ++q) {
        const int idx = q * 64 + lane, seg = idx >> 3, f8 = idx & 7, st = seg / 3, vv = seg % 3;
        const int off = st * 1536 + vv * 512 + f8 * 8;
        if (idx < 96) { if (skip_v && vv != 0) rg.hr[q] = (u32x4_){0u, 0u, 0u, 0u}; else rg.hr[q] = *(const u32x4_*)(hb_ + off); }
    }
}
__device__ __forceinline__ void stage_commit(LAS unsigned char* buf, int lane, const StageRegs& rg) {
#pragma unroll
    for (int q = 0; q < 3; ++q) {
        const int idx = q * 64 + lane, seg = idx >> 4, f = idx & 15, st = seg / 3, vv = seg % 3;
        *(LAS f32x4*)(buf + (st * 6 + 3 + vv) * 256 + f * 16) = rg.fr[q];
    }
#pragma unroll
    for (int q = 0; q < 2; ++q) {
        const int idx = q * 64 + lane, seg = idx >> 3, f8 = idx & 7, st = seg / 3, vv = seg % 3;
        if (idx < 96) {
            const u32x4_ r = rg.hr[q];
            LAS unsigned char* d = buf + (st * 6 + vv) * 256 + f8 * 32;
            *(LAS f32x4*)(d) = (f32x4){__uint_as_float(r[0] << 16), __uint_as_float(r[0] & 0xffff0000u), __uint_as_float(r[1] << 16), __uint_as_float(r[1] & 0xffff0000u)};
            *(LAS f32x4*)(d + 16) = (f32x4){__uint_as_float(r[2] << 16), __uint_as_float(r[2] & 0xffff0000u), __uint_as_float(r[3] << 16), __uint_as_float(r[3] & 0xffff0000u)};
        }
    }
}
struct PrepConst { float mu_r, mu_k, mu_v, w0, a0, k_k, k_a, r_k; };
template <int ST0, int ST1>
__device__ __forceinline__ void stage_compute(const Params& p, LAS unsigned char* buf, long m, int i0, int hd, int lane, const PrepConst& pc, bool isL) {
    static_assert(ST1 - ST0 == 2 && (ST0 & 1) == 0, "decay pairs");
    const int c = hd * 64 + lane;
    float dprev = 1.f;
#pragma unroll
    for (int st = ST0; st < ST1; ++st) {
        const long mm = m + st;
        const unsigned short* row = p.PRb + mm * RWKV_COLS + c;
        const float rc = bf2f(row[0]), kc = bf2f(row[512]), vc = bf2f(row[1024]);
        float rp = 0.f, kp = 0.f, vp = 0.f;
        if (i0 + st > 0) { rp = bf2f(row[-RWKV_COLS]); kp = bf2f(row[512 - RWKV_COLS]); vp = bf2f(row[1024 - RWKV_COLS]); }
        const unsigned short* dq = p.DWb + mm * 1536 + c;
        const float dw = pc.w0 + bf2f(dq[0]), da = pc.a0 + bf2f(dq[512]);
        const float xr = rc + (rp - rc) * pc.mu_r, xk = kc + (kp - kc) * pc.mu_k, xv = vc + (vp - vc) * pc.mu_v;
        const float decay = __expf(-0.6065306597126334f * fast_sigmoid(dw));
        const float a = fast_sigmoid(da);
        const float kkr = xk * pc.k_k, kh = xk * (1.f + (a - 1.f) * pc.k_a);
        const float kk = kkr * __builtin_amdgcn_rsqf(fmaxf(dpp_wsum(kkr * kkr), 1e-24f));
        LAS float* d = (LAS float*)(buf + st * STEP_B) + lane;
        if ((st & 1) == 0) { const float rd = __builtin_amdgcn_rcpf(decay); d[0] = xr * decay; d[64] = kh * rd; d[128] = xv; d[192] = kk; d[256] = kk * a * rd; d[320] = 1.f; dprev = decay; }
        else { d[0] = xr; d[64] = kh; d[128] = xv; d[192] = kk * dprev; d[256] = kk * a; d[320] = decay * dprev; }
        if (isL) {
            p.RWH[mm * 1536 + 1024 + c] = f2bf(xv);
            const float bon = dpp_wsum(xr * kh * pc.r_k);
            if (lane == 0) p.BON[mm * 8 + hd] = bon;
        }
    }
}
struct StageIn { unsigned r[2], k[2], v[2], dw[2], da[2], rp, kp, vp; };
template <int ST0>
__device__ __forceinline__ void stage_load(const Params& p, long m, int i0, int hd, int lane, StageIn& in) {
    const int c = hd * 64 + lane;
    const unsigned short* row = p.PRb + (m + ST0) * RWKV_COLS + c;
    const unsigned short* dq = p.DWb + (m + ST0) * 1536 + c;
#pragma unroll
    for (int j = 0; j < 2; ++j) { in.r[j] = row[j * RWKV_COLS]; in.k[j] = row[j * RWKV_COLS + 512]; in.v[j] = row[j * RWKV_COLS + 1024]; in.dw[j] = dq[j * 1536]; in.da[j] = dq[j * 1536 + 512]; }
    in.rp = 0u; in.kp = 0u; in.vp = 0u;
    if (i0 + ST0 > 0) { in.rp = row[-RWKV_COLS]; in.kp = row[512 - RWKV_COLS]; in.vp = row[1024 - RWKV_COLS]; }
}
template <int ST0>
__device__ __forceinline__ void stage_finish(const Params& p, LAS unsigned char* buf, long m, int hd, int lane, const PrepConst& pc, const StageIn& in) {
    static_assert((ST0 & 1) == 0, "decay pairs");
    const int c = hd * 64 + lane;
    float dprev = 1.f;
#pragma unroll
    for (int j = 0; j < 2; ++j) {
        const int st = ST0 + j;
        const long mm = m + st;
        const float rc = __uint_as_float(in.r[j] << 16), kc = __uint_as_float(in.k[j] << 16), vc = __uint_as_float(in.v[j] << 16);
        const float rp = __uint_as_float((j ? in.r[0] : in.rp) << 16), kp = __uint_as_float((j ? in.k[0] : in.kp) << 16), vp = __uint_as_float((j ? in.v[0] : in.vp) << 16);
        const float dw = pc.w0 + __uint_as_float(in.dw[j] << 16), da = pc.a0 + __uint_as_float(in.da[j] << 16);
        const float xr = rc + (rp - rc) * pc.mu_r, xk = kc + (kp - kc) * pc.mu_k, xv = vc + (vp - vc) * pc.mu_v;
        const float decay = __expf(-0.6065306597126334f * fast_sigmoid(dw));
        const float a = fast_sigmoid(da);
        const float kkr = xk * pc.k_k, kh = xk * (1.f + (a - 1.f) * pc.k_a);
        const float kk = kkr * __builtin_amdgcn_rsqf(fmaxf(dpp_wsum(kkr * kkr), 1e-24f));
        LAS float* d = (LAS float*)(buf + st * STEP_B) + lane;
        if (j == 0) { const float rd = __builtin_amdgcn_rcpf(decay); d[0] = xr * decay; d[64] = kh * rd; d[128] = xv; d[192] = kk; d[256] = kk * a * rd; d[320] = 1.f; dprev = decay; }
        else { d[0] = xr; d[64] = kh; d[128] = xv; d[192] = kk * dprev; d[256] = kk * a; d[320] = decay * dprev; }
        p.RWH[mm * 1536 + 1024 + c] = f2bf(xv);
        const float bon = dpp_wsum(xr * kh * pc.r_k);
        if (lane == 0) p.BON[mm * 8 + hd] = bon;
    }
}
template <int MODE>
__device__ __forceinline__ float step(const LAS unsigned char* sb, f32x2 (&S)[32], int lane, float vmul) {
    f32x2 a0 = {0.f, 0.f}, a1 = {0.f, 0.f};
#pragma unroll
    for (int jj = 0; jj < 16; ++jj) {
        const f32x4 k4 = *(const LAS f32x4*)(sb + 3 * 256 + jj * 16);
        a0 += S[2 * jj] * (f32x2){k4[0], k4[1]}; a1 += S[2 * jj + 1] * (f32x2){k4[2], k4[3]};
    }
    const float sa = -((a0[0] + a0[1]) + (a1[0] + a1[1]));
    const f32x2 sa2 = {sa, sa};
    float v = 0.f;
    if (MODE != 1) v = *(const LAS float*)(sb + 2 * 256 + lane * 4) * vmul;
    const f32x2 v2 = {v, v};
    f32x2 o0 = {0.f, 0.f}, o1 = {0.f, 0.f};
#pragma unroll
    for (int jj = 0; jj < 16; ++jj) {
        const f32x4 d4 = *(const LAS f32x4*)(sb + 5 * 256 + jj * 16), b4 = *(const LAS f32x4*)(sb + 4 * 256 + jj * 16);
        f32x2 t0 = sa2 * (f32x2){b4[0], b4[1]}, t1 = sa2 * (f32x2){b4[2], b4[3]};
        if (MODE != 1) {
            const f32x4 k4 = *(const LAS f32x4*)(sb + 1 * 256 + jj * 16);
            t0 += v2 * (f32x2){k4[0], k4[1]}; t1 += v2 * (f32x2){k4[2], k4[3]};
        }
        S[2 * jj] = S[2 * jj] * (f32x2){d4[0], d4[1]} + t0; S[2 * jj + 1] = S[2 * jj + 1] * (f32x2){d4[2], d4[3]} + t1;
        if (MODE == 2) {
            const f32x4 r4 = *(const LAS f32x4*)(sb + 0 * 256 + jj * 16);
            o0 += S[2 * jj] * (f32x2){r4[0], r4[1]}; o1 += S[2 * jj + 1] * (f32x2){r4[2], r4[3]};
        }
    }
    return (o0[0] + o0[1]) + (o1[0] + o1[1]);
}
template <int MODE>
__device__ __forceinline__ void run(const Params& p, LAS unsigned char* wl, long m0, int h, int T, f32x2 (&S)[32], int lane, float vmul, float* odst) {
    StageRegs rg;
    stage_issue(p, m0, h, lane, rg); stage_commit(wl, lane, rg); wave_sync();
    const int nsb = T / SB;
    for (int sbi = 0; sbi < nsb; ++sbi) {
        const bool more = sbi + 1 < nsb;
        if (more) stage_issue(p, m0 + (long)(sbi + 1) * SB, h, lane, rg);
        const LAS unsigned char* cur = wl + (sbi & 1) * SUB_B;
#pragma unroll 1
        for (int st = 0; st < SB; ++st) {
            __builtin_amdgcn_sched_barrier(0);
            const float o = step<MODE>(cur + st * STEP_B, S, lane, vmul);
            if (MODE == 2) odst[(m0 + (long)sbi * SB + st) * 512 + h * 64 + lane] = o;
        }
        if (more) stage_commit(wl + ((sbi + 1) & 1) * SUB_B, lane, rg);
        wave_sync();
    }
}
__device__ __forceinline__ void load_rows(const float* src, f32x2 (&S)[32]) {
#pragma unroll
    for (int q = 0; q < 16; ++q) { const f32x4 v = *(const f32x4*)(src + q * 4); S[2 * q] = (f32x2){v[0], v[1]}; S[2 * q + 1] = (f32x2){v[2], v[3]}; }
}
__device__ __forceinline__ void store_rows(float* dst, const f32x2 (&S)[32]) {
#pragma unroll
    for (int q = 0; q < 16; ++q) *(f32x4*)(dst + q * 4) = (f32x4){S[2 * q][0], S[2 * q][1], S[2 * q + 1][0], S[2 * q + 1][1]};
}
typedef float f32x16 __attribute__((ext_vector_type(16)));
#define RW_MFMA(a, b, c) __builtin_amdgcn_mfma_f32_32x32x2f32((a), (b), (c), 0, 0, 0)
#define RW_PAIR(v, q) ((f32x2){(v)[2 * (q)], (v)[2 * (q) + 1]})
template <int NCT>
__device__ __forceinline__ void step_t(const LAS unsigned char* sb, f32x16 (&T)[2][NCT], int lane, float (&outv)[NCT], float vmul, bool dec) {
    const int h = lane >> 5, l31 = lane & 31;
    const LAS unsigned char* hb = sb + 16 * h;
    f32x4 kv[2][4], dv[2][4], rv[2][4]; float aop[2], vv[NCT];
#pragma unroll
    for (int rt = 0; rt < 2; ++rt)
#pragma unroll
        for (int gq = 0; gq < 4; ++gq) kv[rt][gq] = *(const LAS f32x4*)(hb + 3 * 256 + (32 * rt + 8 * gq) * 4);
#pragma unroll
    for (int ct = 0; ct < NCT; ++ct) vv[ct] = *(const LAS float*)(sb + 2 * 256 + (32 * (ct & 1) + l31) * 4);
#pragma unroll
    for (int rt = 0; rt < 2; ++rt) aop[rt] = *(const LAS float*)(sb + (h ? 1 * 256 : 4 * 256) + (32 * rt + l31) * 4);
    if (NCT <= 2) {
#pragma unroll
        for (int rt = 0; rt < 2; ++rt)
#pragma unroll
            for (int gq = 0; gq < 4; ++gq) rv[rt][gq] = *(const LAS f32x4*)(hb + 0 * 256 + (32 * rt + 8 * gq) * 4);
        if (dec) {
#pragma unroll
            for (int rt = 0; rt < 2; ++rt)
#pragma unroll
                for (int gq = 0; gq < 4; ++gq) dv[rt][gq] = *(const LAS f32x4*)(hb + 5 * 256 + (32 * rt + 8 * gq) * 4);
        }
    }
    __builtin_amdgcn_sched_barrier(0);
    f32x2 pa[NCT], pb_[NCT];
#pragma unroll
    for (int ct = 0; ct < NCT; ++ct) { pa[ct] = (f32x2){0.f, 0.f}; pb_[ct] = (f32x2){0.f, 0.f}; }
#pragma unroll
    for (int rt = 0; rt < 2; ++rt)
#pragma unroll
        for (int gq = 0; gq < 4; ++gq) {
            const f32x2 klo = {kv[rt][gq][0], kv[rt][gq][1]}, khi = {kv[rt][gq][2], kv[rt][gq][3]};
#pragma unroll
            for (int ct = 0; ct < NCT; ++ct) { pa[ct] += RW_PAIR(T[rt][ct], 2 * gq) * klo; pb_[ct] += RW_PAIR(T[rt][ct], 2 * gq + 1) * khi; }
        }
    float bop[NCT];
#pragma unroll
    for (int ct = 0; ct < NCT; ++ct) {
        const float sa = -xhalf_sum((pa[ct][0] + pa[ct][1]) + (pb_[ct][0] + pb_[ct][1]));
        bop[ct] = h ? (ct < 2 ? vv[ct] * vmul : 0.f) : sa;
    }
    if (NCT > 2) {
#pragma unroll
        for (int rt = 0; rt < 2; ++rt)
#pragma unroll
            for (int gq = 0; gq < 4; ++gq) dv[rt][gq] = *(const LAS f32x4*)(hb + 5 * 256 + (32 * rt + 8 * gq) * 4);
        __builtin_amdgcn_sched_barrier(0);
    }
    if (dec)
#pragma unroll
    for (int rt = 0; rt < 2; ++rt)
#pragma unroll
        for (int gq = 0; gq < 4; ++gq) {
            const f32x2 dlo = {dv[rt][gq][0], dv[rt][gq][1]}, dhi = {dv[rt][gq][2], dv[rt][gq][3]};
#pragma unroll
            for (int ct = 0; ct < NCT; ++ct) {
                const f32x2 x = RW_PAIR(T[rt][ct], 2 * gq) * dlo, y = RW_PAIR(T[rt][ct], 2 * gq + 1) * dhi;
                T[rt][ct][4 * gq] = x[0]; T[rt][ct][4 * gq + 1] = x[1]; T[rt][ct][4 * gq + 2] = y[0]; T[rt][ct][4 * gq + 3] = y[1];
            }
        }
    if (NCT > 2) {
#pragma unroll
        for (int rt = 0; rt < 2; ++rt)
#pragma unroll
            for (int gq = 0; gq < 4; ++gq) rv[rt][gq] = *(const LAS f32x4*)(hb + 0 * 256 + (32 * rt + 8 * gq) * 4);
    }
#pragma unroll
    for (int rt = 0; rt < 2; ++rt)
#pragma unroll
        for (int ct = 0; ct < NCT; ++ct) T[rt][ct] = RW_MFMA(aop[rt], bop[ct], T[rt][ct]);
#pragma unroll
    for (int ct = 0; ct < NCT; ++ct) { pa[ct] = (f32x2){0.f, 0.f}; pb_[ct] = (f32x2){0.f, 0.f}; }
#pragma unroll
    for (int rt = 0; rt < 2; ++rt)
#pragma unroll
        for (int gq = 0; gq < 4; ++gq) {
            const f32x2 rlo = {rv[rt][gq][0], rv[rt][gq][1]}, rhi = {rv[rt][gq][2], rv[rt][gq][3]};
#pragma unroll
            for (int ct = 0; ct < NCT; ++ct) { pa[ct] += RW_PAIR(T[rt][ct], 2 * gq) * rlo; pb_[ct] += RW_PAIR(T[rt][ct], 2 * gq + 1) * rhi; }
        }
#pragma unroll
    for (int ct = 0; ct < NCT; ++ct) outv[ct] = xhalf_sum((pa[ct][0] + pa[ct][1]) + (pb_[ct][0] + pb_[ct][1]));
}
__device__ __forceinline__ void sa_first(const LAS unsigned char* sb, const f32x16 (&T)[2][2], int lane, float (&sa)[2]) {
    const int h = lane >> 5;
    const LAS unsigned char* hb = sb + 16 * h;
    f32x2 pa[2], pb_[2];
#pragma unroll
    for (int ct = 0; ct < 2; ++ct) { pa[ct] = (f32x2){0.f, 0.f}; pb_[ct] = (f32x2){0.f, 0.f}; }
#pragma unroll
    for (int rt = 0; rt < 2; ++rt)
#pragma unroll
        for (int gq = 0; gq < 4; ++gq) {
            const f32x4 k4 = *(const LAS f32x4*)(hb + 3 * 256 + (32 * rt + 8 * gq) * 4);
            const f32x2 klo = {k4[0], k4[1]}, khi = {k4[2], k4[3]};
#pragma unroll
            for (int ct = 0; ct < 2; ++ct) { pa[ct] += RW_PAIR(T[rt][ct], 2 * gq) * klo; pb_[ct] += RW_PAIR(T[rt][ct], 2 * gq + 1) * khi; }
        }
#pragma unroll
    for (int ct = 0; ct < 2; ++ct) sa[ct] = -xhalf_sum((pa[ct][0] + pa[ct][1]) + (pb_[ct][0] + pb_[ct][1]));
}
struct StepPre { f32x4 dv[2][4]; float aop[2], vv[2]; };
__device__ __forceinline__ void pre_load(const LAS unsigned char* sb, int lane, StepPre& q, bool dec) {
    const int h = lane >> 5, l31 = lane & 31;
    const LAS unsigned char* hb = sb + 16 * h;
#pragma unroll
    for (int ct = 0; ct < 2; ++ct) q.vv[ct] = *(const LAS float*)(sb + 2 * 256 + (32 * ct + l31) * 4);
#pragma unroll
    for (int rt = 0; rt < 2; ++rt) q.aop[rt] = *(const LAS float*)(sb + (h ? 1 * 256 : 4 * 256) + (32 * rt + l31) * 4);
    if (dec) {
#pragma unroll
        for (int rt = 0; rt < 2; ++rt)
#pragma unroll
            for (int gq = 0; gq < 4; ++gq) q.dv[rt][gq] = *(const LAS f32x4*)(hb + 5 * 256 + (32 * rt + 8 * gq) * 4);
    }
}
__device__ __forceinline__ void step_tf(const LAS unsigned char* sb, f32x16 (&T)[2][2], int lane, float (&outv)[2], float (&sa)[2], StepPre& pre, float vmul, bool dec, bool nxt) {
    const int h = lane >> 5, l31 = lane & 31;
    const LAS unsigned char* hb = sb + 16 * h;
    f32x4 dv[2][4], rv[2][4], kn[2][4]; float aop[2], vv[2];
#pragma unroll
    for (int ct = 0; ct < 2; ++ct) vv[ct] = pre.vv[ct];
#pragma unroll
    for (int rt = 0; rt < 2; ++rt) aop[rt] = pre.aop[rt];
    if (dec) {
#pragma unroll
        for (int rt = 0; rt < 2; ++rt)
#pragma unroll
            for (int gq = 0; gq < 4; ++gq) dv[rt][gq] = pre.dv[rt][gq];
    }
#pragma unroll
    for (int rt = 0; rt < 2; ++rt)
#pragma unroll
        for (int gq = 0; gq < 4; ++gq) rv[rt][gq] = *(const LAS f32x4*)(hb + 0 * 256 + (32 * rt + 8 * gq) * 4);
    if (nxt) {
#pragma unroll
        for (int rt = 0; rt < 2; ++rt)
#pragma unroll
            for (int gq = 0; gq < 4; ++gq) kn[rt][gq] = *(const LAS f32x4*)(hb + STEP_B + 3 * 256 + (32 * rt + 8 * gq) * 4);
    }
    float bop[2];
#pragma unroll
    for (int ct = 0; ct < 2; ++ct) bop[ct] = h ? vv[ct] * vmul : sa[ct];
    if (dec) {
#pragma unroll
        for (int rt = 0; rt < 2; ++rt)
#pragma unroll
            for (int gq = 0; gq < 4; ++gq) {
                const f32x2 dlo = {dv[rt][gq][0], dv[rt][gq][1]}, dhi = {dv[rt][gq][2], dv[rt][gq][3]};
#pragma unroll
                for (int ct = 0; ct < 2; ++ct) {
                    const f32x2 x = RW_PAIR(T[rt][ct], 2 * gq) * dlo, y = RW_PAIR(T[rt][ct], 2 * gq + 1) * dhi;
                    T[rt][ct][4 * gq] = x[0]; T[rt][ct][4 * gq + 1] = x[1]; T[rt][ct][4 * gq + 2] = y[0]; T[rt][ct][4 * gq + 3] = y[1];
                }
            }
    }
    __builtin_amdgcn_s_setprio(1);
#pragma unroll
    for (int rt = 0; rt < 2; ++rt)
#pragma unroll
        for (int ct = 0; ct < 2; ++ct) T[rt][ct] = RW_MFMA(aop[rt], bop[ct], T[rt][ct]);
    __builtin_amdgcn_s_setprio(0);
    if (nxt) pre_load(sb + STEP_B, lane, pre, !dec);
    f32x2 pa[2], pb_[2];
#pragma unroll
    for (int ct = 0; ct < 2; ++ct) { pa[ct] = (f32x2){0.f, 0.f}; pb_[ct] = (f32x2){0.f, 0.f}; }
    if (nxt) {
        f32x2 qa[2], qb_[2];
#pragma unroll
        for (int ct = 0; ct < 2; ++ct) { qa[ct] = (f32x2){0.f, 0.f}; qb_[ct] = (f32x2){0.f, 0.f}; }
#pragma unroll
        for (int rt = 0; rt < 2; ++rt)
#pragma unroll
            for (int gq = 0; gq < 4; ++gq) {
                const f32x2 rlo = {rv[rt][gq][0], rv[rt][gq][1]}, rhi = {rv[rt][gq][2], rv[rt][gq][3]};
                const f32x2 klo = {kn[rt][gq][0], kn[rt][gq][1]}, khi = {kn[rt][gq][2], kn[rt][gq][3]};
#pragma unroll
                for (int ct = 0; ct < 2; ++ct) {
                    const f32x2 t0 = RW_PAIR(T[rt][ct], 2 * gq), t1 = RW_PAIR(T[rt][ct], 2 * gq + 1);
                    pa[ct] += t0 * rlo; pb_[ct] += t1 * rhi; qa[ct] += t0 * klo; qb_[ct] += t1 * khi;
                }
            }
#pragma unroll
        for (int ct = 0; ct < 2; ++ct) sa[ct] = -xhalf_sum((qa[ct][0] + qa[ct][1]) + (qb_[ct][0] + qb_[ct][1]));
    } else {
#pragma unroll
        for (int rt = 0; rt < 2; ++rt)
#pragma unroll
            for (int gq = 0; gq < 4; ++gq) {
                const f32x2 rlo = {rv[rt][gq][0], rv[rt][gq][1]}, rhi = {rv[rt][gq][2], rv[rt][gq][3]};
#pragma unroll
                for (int ct = 0; ct < 2; ++ct) { pa[ct] += RW_PAIR(T[rt][ct], 2 * gq) * rlo; pb_[ct] += RW_PAIR(T[rt][ct], 2 * gq + 1) * rhi; }
            }
    }
#pragma unroll
    for (int ct = 0; ct < 2; ++ct) outv[ct] = xhalf_sum((pa[ct][0] + pa[ct][1]) + (pb_[ct][0] + pb_[ct][1]));
}
__device__ __forceinline__ void pass1(const Params& p, LAS unsigned char* lds) {
    const int tid = opaque_tid(), lane = tid & 63, w = __builtin_amdgcn_readfirstlane(tid >> 6);
    LAS unsigned char* wl = lds + w * WAVE_B;
    const int nchunk = BATCH * 8 * NCH;
    for (int cb = (int)blockIdx.x * 4; cb < nchunk; cb += (int)gridDim.x * 4) {
        int lq = lane; asm volatile("" : "+v"(lq));
        const int h = lq >> 5, l31 = lq & 31;
        const int kind = w & 1, ct_ = cb + (w >> 1); const bool act = ct_ < nchunk;
        const int cta = act ? ct_ : 0, c = cta % NCH, sh = cta / NCH, hd = sh % 8, sq = sh / 8;
        const long m0 = (long)sq * SEQ + (long)c * RC;
        LAS unsigned char* pl = lds + (w >> 1) * (2 * 8 * STEP_B);
        f32x16 T[2][2];
#pragma unroll
        for (int rt = 0; rt < 2; ++rt)
#pragma unroll
            for (int ct = 0; ct < 2; ++ct)
#pragma unroll
                for (int rg_ = 0; rg_ < 16; ++rg_)
                    T[rt][ct][rg_] = (kind == 1 && (32 * rt + (rg_ & 3) + 8 * (rg_ >> 2) + 4 * h) == (32 * ct + l31)) ? 1.f : 0.f;
        const float vmul = kind == 0 ? 1.f : 0.f;
        float* odst = kind == 0 ? p.RO : p.RHO;
        PrepConst pc;
        { const int cch = hd * 64 + lane; pc.mu_r = p.in[I_MU][cch]; pc.mu_k = p.in[I_MU][512 + cch]; pc.mu_v = p.in[I_MU][1024 + cch]; pc.w0 = p.in[I_W0][cch]; pc.a0 = p.in[I_A0][cch];
          pc.k_k = p.in[I_K_K][cch]; pc.k_a = p.in[I_K_A][cch]; pc.r_k = p.in[I_R_K][cch]; }
        const int i0 = c * RC;
        __syncthreads();
        constexpr int SBP = 8, PSUB = SBP * STEP_B, nsb = RC / SBP;
        StageIn sA, sB;
        if (kind == 0) { stage_load<0>(p, m0, i0, hd, lane, sA); stage_load<2>(p, m0, i0, hd, lane, sB); stage_finish<0>(p, pl, m0, hd, lane, pc, sA); stage_finish<2>(p, pl, m0, hd, lane, pc, sB);
                         stage_load<0>(p, m0 + SBP, i0 + SBP, hd, lane, sA); stage_load<2>(p, m0 + SBP, i0 + SBP, hd, lane, sB); }
        else { stage_load<4>(p, m0, i0, hd, lane, sA); stage_load<6>(p, m0, i0, hd, lane, sB); stage_finish<4>(p, pl, m0, hd, lane, pc, sA); stage_finish<6>(p, pl, m0, hd, lane, pc, sB);
               stage_load<4>(p, m0 + SBP, i0 + SBP, hd, lane, sA); stage_load<6>(p, m0 + SBP, i0 + SBP, hd, lane, sB); }
        __syncthreads();
        for (int sbi = 0; sbi < nsb; ++sbi) {
            const bool more = sbi + 1 < nsb;
            if (more) {
                LAS unsigned char* nb = pl + ((sbi + 1) & 1) * PSUB; const long mn = m0 + (long)(sbi + 1) * SBP;
                const bool more2 = sbi + 2 < nsb; const long m2 = more2 ? mn + SBP : mn; const int i2 = i0 + (sbi + (more2 ? 2 : 1)) * SBP;
                if (kind == 0) { stage_finish<0>(p, nb, mn, hd, lane, pc, sA); stage_finish<2>(p, nb, mn, hd, lane, pc, sB); stage_load<0>(p, m2, i2, hd, lane, sA); stage_load<2>(p, m2, i2, hd, lane, sB); }
                else { stage_finish<4>(p, nb, mn, hd, lane, pc, sA); stage_finish<6>(p, nb, mn, hd, lane, pc, sB); stage_load<4>(p, m2, i2, hd, lane, sA); stage_load<6>(p, m2, i2, hd, lane, sB); }
            }
            const LAS unsigned char* cur = pl + (sbi & 1) * PSUB;
            float sa[2]; StepPre pre;
            pre_load(cur, lane, pre, false);
            sa_first(cur, T, lane, sa);
#pragma unroll 2
            for (int st = 0; st < SBP; ++st) {
                float ov[2];
                step_tf(cur + st * STEP_B, T, lane, ov, sa, pre, vmul, (st & 1) != 0, st + 1 < SBP);
                if (act) odst[(m0 + (long)sbi * SBP + st) * 512 + hd * 64 + lane] = h ? ov[1] : ov[0];
            }
            __syncthreads();
        }
        if (act) {
            float* lt = (kind == 0 ? p.RLC : p.RPC) + (long)ct_ * 4096 + (4 * h) * 64 + l31;
#pragma unroll
            for (int rt = 0; rt < 2; ++rt)
#pragma unroll
                for (int cc = 0; cc < 2; ++cc)
#pragma unroll
                    for (int rg_ = 0; rg_ < 16; ++rg_) lt[(32 * rt + (rg_ & 3) + 8 * (rg_ >> 2)) * 64 + 32 * cc] = T[rt][cc][rg_];
        }
    }
}
__device__ __forceinline__ void pass1_sample(const Params& p, LAS unsigned char* lds, int wg0) {
    const int tid = opaque_tid(), lane = tid & 63, w = __builtin_amdgcn_readfirstlane(tid >> 6);
    LAS unsigned char* wl = lds + w * WAVE_B;
    const int npr = 0, ntask = DEC_BATCH * 8, G_ = (int)gridDim.x;
    for (int task = (((int)blockIdx.x - wg0 + G_) % G_) * 8 + w; task < ntask; task += G_ * 8) {
        StageRegs rg;
        int lq = lane; asm volatile("" : "+v"(lq));
        const int h = lq >> 5, l31 = lq & 31;
        {
            const int sh = task - npr, hd = sh % 8, n = sh / 8;
            const long m0 = (long)MP + (long)n * DEC_SEQ;
            const float* s0 = p.in[I_STATE_S] + (long)sh * 4096;
            f32x16 T[2][2];
#pragma unroll
            for (int rt = 0; rt < 2; ++rt)
#pragma unroll
                for (int ct = 0; ct < 2; ++ct)
#pragma unroll
                    for (int gq = 0; gq < 4; ++gq) {
                        const f32x4 v = *(const f32x4*)(s0 + l31 * 64 + 4 * h + ((32 * ct) * 64 + 32 * rt + 8 * gq));
#pragma unroll
                        for (int e = 0; e < 4; ++e) T[rt][ct][4 * gq + e] = v[e];
                    }
            constexpr int nsb = DEC_SEQ / SB;
            for (int sbi = 0; sbi < nsb; ++sbi) {
                stage_issue(p, m0 + (long)sbi * SB, hd, lane, rg); stage_commit(wl, lane, rg); lds_sync();
#pragma unroll 1
                for (int st = 0; st < SB; ++st) {
                    float ov[2];
                    step_t<2>(wl + st * STEP_B, T, lane, ov, 1.f, true);
                    p.RO[(m0 + (long)sbi * SB + st) * 512 + hd * 64 + lane] = h ? ov[1] : ov[0];
                }
                lds_sync();
            }
            float* so = p.out + O_RS_S + (long)sh * 4096;
#pragma unroll
            for (int rt = 0; rt < 2; ++rt)
#pragma unroll
                for (int ct = 0; ct < 2; ++ct)
#pragma unroll
                    for (int gq = 0; gq < 4; ++gq)
                        *(f32x4*)(so + l31 * 64 + 4 * h + ((32 * ct) * 64 + 32 * rt + 8 * gq)) = (f32x4){T[rt][ct][4 * gq], T[rt][ct][4 * gq + 1], T[rt][ct][4 * gq + 2], T[rt][ct][4 * gq + 3]};
        }
    }
}
constexpr int PT_ROW = 65 * 4, PT_B = 64 * PT_ROW;
__device__ __forceinline__ void pass2(const Params& p, LAS unsigned char* lds, unsigned* flags = (unsigned*)0) {
    const int tid = opaque_tid(), lane = tid & 63, w = __builtin_amdgcn_readfirstlane(tid >> 6), h = lane >> 5, l31 = lane & 31;
    const int pr = w >> 1, ct = w & 1;
    for (int sh0 = ((int)gridDim.x - 1 - (int)blockIdx.x) * 4; sh0 < BATCH * 8; sh0 += gridDim.x * 4) {
        const int sh = sh0 + pr; const bool act = sh < BATCH * 8;
        LAS unsigned char* pb = lds + pr * PT_B;
        f32x16 S[2];
#pragma unroll
        for (int kt = 0; kt < 2; ++kt)
#pragma unroll
            for (int t = 0; t < 16; ++t) S[kt][t] = 0.f;
        f32x4 pg[8];
        const long cbase = (long)(act ? sh : 0) * NCH;
        auto issue = [&](long ctk) {
#pragma unroll
            for (int q = 0; q < 8; ++q) { const int idx = q * 64 + lane; pg[q] = *(const f32x4*)(p.RPC + ctk * 4096 + (32 * ct + (idx >> 4)) * 64 + (idx & 15) * 4); }
        };
        auto commit = [&]() {
#pragma unroll
            for (int q = 0; q < 8; ++q) {
                const int idx = q * 64 + lane; LAS float* d = (LAS float*)(pb + (32 * ct + (idx >> 4)) * PT_ROW) + (idx & 15) * 4;
                d[0] = pg[q][0]; d[1] = pg[q][1]; d[2] = pg[q][2]; d[3] = pg[q][3];
            }
        };
        issue(cbase);
        f32x16 Ln[2];
        {
            const float* lt0 = p.RLC + cbase * 4096 + (4 * h) * 64 + 32 * ct + l31;
#pragma unroll
            for (int rt = 0; rt < 2; ++rt)
#pragma unroll
                for (int t = 0; t < 16; ++t) Ln[rt][t] = lt0[(32 * rt + (t & 3) + 8 * (t >> 2)) * 64];
        }
        for (int c = 0; c < NCH; ++c) {
            const long ctk = cbase + c;
            __syncthreads();
            commit();
            if (act) {
                float* ss = p.RSS + ctk * 4096 + (4 * h) * 64 + 32 * ct + l31;
#pragma unroll
                for (int kt = 0; kt < 2; ++kt)
#pragma unroll
                    for (int t = 0; t < 16; ++t) ss[(32 * kt + (t & 3) + 8 * (t >> 2)) * 64] = S[kt][t];
            }
            __syncthreads();
            if (c + 1 < NCH) issue(ctk + 1);
            f32x16 N[2];
#pragma unroll
            for (int rt = 0; rt < 2; ++rt) N[rt] = Ln[rt];
            if (c + 1 < NCH) {
                const float* lt = p.RLC + (ctk + 1) * 4096 + (4 * h) * 64 + 32 * ct + l31;
#pragma unroll
                for (int rt = 0; rt < 2; ++rt)
#pragma unroll
                    for (int t = 0; t < 16; ++t) Ln[rt][t] = lt[(32 * rt + (t & 3) + 8 * (t >> 2)) * 64];
            }
#pragma unroll
            for (int rt = 0; rt < 2; ++rt)
#pragma unroll
                for (int kt = 0; kt < 2; ++kt) {
                    __builtin_amdgcn_sched_barrier(0);
#pragma unroll
                    for (int t = 0; t < 16; ++t) {
                        const float a = *(const LAS float*)(pb + l31 * PT_ROW + 16 * h + ((32 * rt) * PT_ROW + (32 * kt + (t & 3) + 8 * (t >> 2)) * 4));
                        N[rt] = RW_MFMA(a, S[kt][t], N[rt]);
                    }
                }
#pragma unroll
            for (int rt = 0; rt < 2; ++rt) S[rt] = N[rt];
        }
        if (act) {
            float* so = p.out + O_RS_P + (long)sh * 4096;
#pragma unroll
            for (int kt = 0; kt < 2; ++kt)
#pragma unroll
                for (int gq = 0; gq < 4; ++gq)
                    *(f32x4*)(so + (32 * ct + l31) * 64 + 4 * h + (32 * kt + 8 * gq)) = (f32x4){S[kt][4 * gq], S[kt][4 * gq + 1], S[kt][4 * gq + 2], S[kt][4 * gq + 3]};
        }
        if (flags) {
            asm volatile("s_waitcnt vmcnt(0)" ::: "memory");
            __syncthreads();
            if (threadIdx.x == 0) {
                __builtin_amdgcn_fence(__ATOMIC_RELEASE, "agent");
                asm volatile("s_waitcnt vmcnt(0)" ::: "memory");
                for (int q = 0; q < 4; ++q) if (sh0 + q < BATCH * 8) __hip_atomic_store(flags + sh0 + q, 1u, __ATOMIC_RELAXED, __HIP_MEMORY_SCOPE_AGENT);
            }
        }
        __syncthreads();
    }
}
__device__ __forceinline__ void pass3_task(const Params& p, LAS unsigned char* wl, int lane, int ct);
__device__ __forceinline__ void pass3(const Params& p, LAS unsigned char* lds, bool share = true) {
    const int tid = opaque_tid(), lane = tid & 63, w = __builtin_amdgcn_readfirstlane(tid >> 6);
    LAS unsigned char* wl = lds + w * WAVE_B;
    const int npr = BATCH * 8 * NCH;
    const int skip = (share && (int)gridDim.x > 2 * DEC_BATCH * 2) ? DEC_BATCH * 2 : 0, gw = (int)gridDim.x - skip;
    if ((int)blockIdx.x < skip) return;
    for (int task = w * gw + ((int)blockIdx.x - skip); task < npr; task += gw * 8) pass3_task(p, wl, lane, task);
}
__device__ __forceinline__ void pass3_task(const Params& p, LAS unsigned char* wl, int lane, int ct) {
    const int c = ct % NCH, sh = ct / NCH, hd = sh % 8, sq = sh / 8;
    const long m0 = (long)sq * SEQ + (long)c * RC;
    const int l31 = lane & 31, h = lane >> 5;
    float B[2][32];
    {
        const float* sb = p.RSS + (long)ct * 4096 + (32 * h) * 64 + l31;
#pragma unroll
        for (int it = 0; it < 2; ++it)
#pragma unroll
            for (int kk = 0; kk < 32; ++kk) B[it][kk] = sb[kk * 64 + 32 * it];
    }
    const float* rb = p.RHO + (m0 + l31) * 512 + hd * 64 + 32 * h;
    float* ob = p.RO + (m0 + 4 * h) * 512 + hd * 64 + l31;
    f32x4 An[8]; f32x16 Cn[2];
#pragma unroll
    for (int q = 0; q < 8; ++q) An[q] = *(const f32x4*)(rb + 4 * q);
#pragma unroll
    for (int it = 0; it < 2; ++it)
#pragma unroll
        for (int r = 0; r < 16; ++r) Cn[it][r] = ob[(8 * (r >> 2) + (r & 3)) * 512 + 32 * it];
#pragma unroll 1
    for (int tt = 0; tt < RC / 32; ++tt) {
        f32x4 A[8]; f32x16 C[2];
#pragma unroll
        for (int q = 0; q < 8; ++q) A[q] = An[q];
        C[0] = Cn[0]; C[1] = Cn[1];
        if (tt + 1 < RC / 32) {
            const float* rn = rb + (long)(tt + 1) * 32 * 512; const float* on = ob + (long)(tt + 1) * 32 * 512;
#pragma unroll
            for (int q = 0; q < 8; ++q) An[q] = *(const f32x4*)(rn + 4 * q);
#pragma unroll
            for (int it = 0; it < 2; ++it)
#pragma unroll
                for (int r = 0; r < 16; ++r) Cn[it][r] = on[(8 * (r >> 2) + (r & 3)) * 512 + 32 * it];
        }
#pragma unroll
        for (int kk = 0; kk < 32; ++kk) {
            C[0] = RW_MFMA(A[kk >> 2][kk & 3], B[0][kk], C[0]);
            C[1] = RW_MFMA(A[kk >> 2][kk & 3], B[1][kk], C[1]);
        }
        float* oc = ob + (long)tt * 32 * 512;
#pragma unroll
        for (int it = 0; it < 2; ++it)
#pragma unroll
            for (int r = 0; r < 16; ++r) oc[(8 * (r >> 2) + (r & 3)) * 512 + 32 * it] = C[it][r];
    }
}
}

namespace mq {
constexpr int NU = BATCH * 2 * NBP, PER = BATCH * 2, N3 = BATCH * 8 * NCH / 8, Q0 = (NU * 3) / 8, QT = NU + N3;
static_assert(NCH % 8 == 0 && Q0 + 3 * N3 <= NU, "queue layout");
__device__ __forceinline__ void phase(const Params& p, LAS unsigned char* lds, unsigned* bar) {
    unsigned* ctr = bar + 3600; unsigned* flags = bar + 3616;
    volatile LAS int* slot = (volatile LAS int*)(lds + (159744 - 256 + 64));
    const int tid = opaque_tid(), lane = tid & 63, w = __builtin_amdgcn_readfirstlane(tid >> 6);
    for (;;) {
        if (threadIdx.x == 0) *slot = (int)__hip_atomic_fetch_add(ctr, 1u, __ATOMIC_RELAXED, __HIP_MEMORY_SCOPE_AGENT);
        __syncthreads();
        const int i = __builtin_amdgcn_readfirstlane(*slot);
        __syncthreads();
        if (i >= QT) break;
        int u = -1, it = -1;
        if (i < Q0) u = i;
        else if (i < Q0 + 4 * N3) { const int k = i - Q0; if ((k & 3) == 3) it = k >> 2; else u = Q0 + k - (k >> 2); }
        else u = i - N3;
        if (it >= 0) {
            const int sh = (it * 8) / NCH;
            if (threadIdx.x == 0) {
                XB_SPIN(xb_ld(flags + sh) == 0u, bar);
                __builtin_amdgcn_fence(__ATOMIC_ACQUIRE, "agent");
                asm volatile("s_waitcnt vmcnt(0)" ::: "memory");
            }
            __syncthreads();
            rw::pass3_task(p, lds + w * rw::WAVE_B, lane, it * 8 + w);
        } else {
            const int qb = NBP - 1 - u / PER, ngi = u % PER;
            nsa::prompt_unit(p, lds, ngi >> 1, ngi & 1, qb);
        }
    }
}
}

namespace ew {
__device__ __forceinline__ float wsum(float v) {
    v += __shfl_xor(v, 1); v += __shfl_xor(v, 2); v += __shfl_xor(v, 4); v += __shfl_xor(v, 8); v += __shfl_xor(v, 16); v += __shfl_xor(v, 32);
    return v;
}
#define EW_WAVES(ntask) for (long task = (long)blockIdx.x * 8 + w; task < (ntask); task += (long)gridDim.x * 8)
__device__ __forceinline__ float gsum16(float v) { v += __shfl_xor(v, 1); v += __shfl_xor(v, 2); v += __shfl_xor(v, 4); v += __shfl_xor(v, 8); return v; }
typedef float f32x4 __attribute__((ext_vector_type(4)));
typedef unsigned u32x2 __attribute__((ext_vector_type(2)));
__device__ __forceinline__ u32x2 pk4(f32x4 v) { u32x2 r; r[0] = pg8::cvt_pk_bf16(v[0], v[1]); r[1] = pg8::cvt_pk_bf16(v[2], v[3]); return r; }
__device__ __forceinline__ void p_post(const Params& p, long mbase, long ntok) {
    const int tid = opaque_tid(), lane = tid & 63, w = __builtin_amdgcn_readfirstlane(tid >> 6);
    const int d4 = (lane & 15) * 4;
    EW_WAVES(ntok) {
        const long m = mbase + task; const bool smp = m >= MP;
        const int n = tok_seq(m), i = tok_i(m);
        const float* row = p.P + m * IN_COLS;
        f32x4 x[13];
#pragma unroll
        for (int k = 0; k < 13; ++k) { const int f = lane + 64 * k; x[k] = (f < IN_COLS / 4) ? *(const f32x4*)(row + 4 * f) : (f32x4){0.f, 0.f, 0.f, 0.f}; }
        const int fl = 710 + lane;
        f32x4 prev = {0.f, 0.f, 0.f, 0.f};
        if (i > 0) prev = *(const f32x4*)(row - IN_COLS + 4 * fl);
        else if (smp) prev = *(const f32x4*)(p.in[I_STATE_SHIFT] + (long)n * RWKV_COLS + 1536 + 4 * lane);
        const f32x4 cur = *(const f32x4*)(row + 4 * fl);
        const f32x4 mu = *(const f32x4*)(p.in[I_MU] + 1536 + 4 * lane);
        const f32x4 qg = *(const f32x4*)(p.in[I_Q_G] + d4);
#pragma unroll
        for (int k = 0; k < 2; ++k) {
            const f32x4 v = x[k];
            const float r = 1.f / sqrtf(gsum16(v[0] * v[0] + v[1] * v[1] + v[2] * v[2] + v[3] * v[3]) * (1.f / 64.f) + RMS_EPS);
            const f32x4 qn = v * r * qg;
            const long o = m * 512 + 256 * k + 4 * lane;
            *(f32x4*)(p.QN + o) = qn;
            *(u32x2*)(p.QNb + o) = pk4(qn * 0.125f);
        }
        const int hv = lane >> 5, g = (lane >> 4) & 1;
#pragma unroll
        for (int k = 2; k < 5; ++k) {
            f32x4 v = x[k];
            const float ssq = gsum16(v[0] * v[0] + v[1] * v[1] + v[2] * v[2] + v[3] * v[3]);
            if (k >= 3 && hv == 0) {
                const f32x4 gn = *(const f32x4*)((k == 3 ? p.in[I_KS_G] : p.in[I_KW_G]) + d4);
                v = v * (1.f / sqrtf(ssq * (1.f / 64.f) + RMS_EPS)) * gn;
            }
            const int cc = (k - 2) * 256 + 4 * lane;
            *(f32x4*)(p.KVW + m * 768 + cc) = v;
            if (k < 4) *(f32x4*)(p.out + (smp ? O_KV_S + (m - MP) * 512 : O_KV_P + m * 512) + cc) = v;
            else if (smp) *(f32x4*)(p.out + O_WIN_S + ((long)n * WBUF + (WBUF - DEC_SEQ + i)) * 256 + cc - 512) = v;
            else if (i >= SEQ - WP) *(f32x4*)(p.out + O_WIN_P + ((long)n * WP + (i - (SEQ - WP))) * 256 + cc - 512) = v;
            if (!smp && k >= 3) {
                unsigned short* dst = k == 3 ? (hv == 0 ? p.KSb : p.VSb) : (hv == 0 ? p.KWb : p.VWb);
                *(u32x2*)(dst + (((long)n * 2 + g) * SEQ + i) * 64 + d4) = pk4(v);
            }
        }
        if (lane < 6) {
            const f32x4 gb = *(const f32x4*)(p.in[I_GATE_B] + 4 * lane);
            f32x4 gv; gv[0] = sigmoidf_(x[5][0] + gb[0]); gv[1] = sigmoidf_(x[5][1] + gb[1]); gv[2] = sigmoidf_(x[5][2] + gb[2]); gv[3] = sigmoidf_(x[5][3] + gb[3]);
            *(f32x4*)(p.GT + m * 24 + 4 * lane) = gv;
        }
#pragma unroll
        for (int k = 5; k < 13; ++k) { const int f = lane + 64 * k; if (f >= 326 && f < IN_COLS / 4) *(u32x2*)(p.PRb + m * RWKV_COLS + 4 * (f - 326)) = pk4(x[k]); }
        if (i == (smp ? DEC_SEQ : SEQ) - 1) {
            float* so = p.out + (smp ? O_SH_S : O_SH_P) + (long)n * RWKV_COLS;
#pragma unroll
            for (int k = 5; k < 13; ++k) { const int f = lane + 64 * k; if (f >= 326 && f < IN_COLS / 4) *(f32x4*)(so + 4 * (f - 326)) = x[k]; }
        }
        {
            const f32x4 xs = cur + (prev - cur) * mu;
            f32x4 lv;
#pragma unroll
            for (int e = 0; e < 4; ++e) lv[e] = (lane < 16) ? tanhf(xs[e]) : (lane < 32 ? xs[e] : sigmoidf_(xs[e]));
            *(f32x4*)(p.LIN + m * 256 + 4 * lane) = lv;
            *(u32x2*)(p.LINb + m * 256 + 4 * lane) = pk4(lv);
        }
    }
}
typedef unsigned short us4 __attribute__((ext_vector_type(4)));
__device__ __forceinline__ f32x4 ld_bf4(const unsigned short* q) { const u32x2 r = *(const u32x2*)q; f32x4 o; o[0] = __uint_as_float(r[0] << 16); o[1] = __uint_as_float(r[0] & 0xffff0000u); o[2] = __uint_as_float(r[1] << 16); o[3] = __uint_as_float(r[1] & 0xffff0000u); return o; }
__device__ __forceinline__ void lin_prep(const Params& p) {
    const int tid = opaque_tid(), lane = tid & 63, w = __builtin_amdgcn_readfirstlane(tid >> 6);
    EW_WAVES(MP) {
        const long m = task; const int i = (int)(m % SEQ);
        const f32x4 cur = ld_bf4(p.PRb + m * RWKV_COLS + 1536 + 4 * lane);
        f32x4 prev = {0.f, 0.f, 0.f, 0.f};
        if (i > 0) prev = ld_bf4(p.PRb + (m - 1) * RWKV_COLS + 1536 + 4 * lane);
        const f32x4 xs = cur + (prev - cur) * *(const f32x4*)(p.in[I_MU] + 1536 + 4 * lane);
        f32x4 lv;
#pragma unroll
        for (int e = 0; e < 4; ++e) lv[e] = (lane < 16) ? fast_tanh(xs[e]) : (lane < 32 ? xs[e] : fast_sigmoid(xs[e]));
        *(u32x2*)(p.LINb + m * 256 + 4 * lane) = pk4(lv);
    }
}
__device__ __forceinline__ void prep2(const Params& p, long mbase, long ntok) {
    const int tid = opaque_tid(), lane = tid & 63, w = __builtin_amdgcn_readfirstlane(tid >> 6);
    EW_WAVES(ntok) {
        const long m = mbase + task; const bool smp = m >= MP;
        const int n = tok_seq(m), i = tok_i(m);
        const unsigned short* row = p.PRb + m * RWKV_COLS;
        const unsigned short* dq = p.DWb + m * 1536;
        float* rb = p.RWB + m * 3 * 512; unsigned short* rh = p.RWH + m * 3 * 512;
#pragma unroll
        for (int k = 0; k < 2; ++k) {
            const int c = 256 * k + 4 * lane;
            f32x4 xs[3];
#pragma unroll
            for (int s = 0; s < 3; ++s) {
                const f32x4 cur = ld_bf4(row + 512 * s + c);
                f32x4 prev = {0.f, 0.f, 0.f, 0.f};
                if (i > 0) prev = ld_bf4(row - RWKV_COLS + 512 * s + c);
                else if (smp) prev = *(const f32x4*)(p.in[I_STATE_SHIFT] + (long)n * RWKV_COLS + 512 * s + c);
                xs[s] = cur + (prev - cur) * *(const f32x4*)(p.in[I_MU] + 512 * s + c);
            }
            const f32x4 dw = *(const f32x4*)(p.in[I_W0] + c) + ld_bf4(dq + c), da = *(const f32x4*)(p.in[I_A0] + c) + ld_bf4(dq + 512 + c);
            const f32x4 dg = ld_bf4(dq + 1024 + c);
            const f32x4 kkw = *(const f32x4*)(p.in[I_K_K] + c), kaw = *(const f32x4*)(p.in[I_K_A] + c);
            f32x4 decay, a, kkr, kh;
#pragma unroll
            for (int e = 0; e < 4; ++e) {
                decay[e] = __expf(-0.6065306597126334f * fast_sigmoid(dw[e]));
                a[e] = fast_sigmoid(da[e]);
                kkr[e] = xs[1][e] * kkw[e];
                kh[e] = xs[1][e] * (1.f + (a[e] - 1.f) * kaw[e]);
            }
            const float inv = 1.f / sqrtf(fmaxf(gsum16(kkr[0] * kkr[0] + kkr[1] * kkr[1] + kkr[2] * kkr[2] + kkr[3] * kkr[3]), 1e-24f));
            const f32x4 kk = kkr * inv;
            *(u32x2*)(rh + 0 * 512 + c) = pk4(xs[0]); *(u32x2*)(rh + 1 * 512 + c) = pk4(kh); *(u32x2*)(rh + 2 * 512 + c) = pk4(xs[2]);
            *(f32x4*)(rb + 0 * 512 + c) = kk; *(f32x4*)(rb + 1 * 512 + c) = kk * a; *(f32x4*)(rb + 2 * 512 + c) = decay;
            *(u32x2*)(p.GGb + m * 512 + c) = pk4(dg);
            const f32x4 rk = *(const f32x4*)(p.in[I_R_K] + c); const f32x4 t = xs[0] * kh * rk;
            const float bonus = gsum16(t[0] + t[1] + t[2] + t[3]);
            if ((lane & 15) == 0) p.BON[m * 8 + 4 * k + (lane >> 4)] = bonus;
        }
    }
}
__device__ __forceinline__ void rwkv_post(const Params& p, long mbase, long ntok) {
    const int tid = opaque_tid(), lane = tid & 63, w = __builtin_amdgcn_readfirstlane(tid >> 6);
    EW_WAVES(ntok) {
        const long m = mbase + task;
        const unsigned short* rh = p.RWH + m * 3 * 512;
#pragma unroll
        for (int k = 0; k < 2; ++k) {
            const int c = 256 * k + 4 * lane;
            const f32x4 ro = *(const f32x4*)(p.RO + m * 512 + c);
            const f32x4 v = ld_bf4(rh + 1024 + c);
            const f32x4 lg = *(const f32x4*)(p.in[I_LNX_G] + c), lb = *(const f32x4*)(p.in[I_LNX_B] + c);
            const f32x4 gg = ld_bf4(p.DWb + m * 1536 + 1024 + c);
            const float mean = gsum16(ro[0] + ro[1] + ro[2] + ro[3]) * (1.f / 64.f);
            const f32x4 dv = ro - mean;
            const float var = gsum16(dv[0] * dv[0] + dv[1] * dv[1] + dv[2] * dv[2] + dv[3] * dv[3]) * (1.f / 64.f);
            const float rstd = 1.f / sqrtf(var + LNX_EPS);
            const float bonus = p.BON[m * 8 + 4 * k + (lane >> 4)];
            const f32x4 o = (dv * rstd * lg + lb + v * bonus) * gg;
            *(u32x2*)(p.MIXb + m * MIX_W + 512 + c) = pk4(o);
        }
    }
}
__device__ __forceinline__ void memkv_post(const Params& p) {
    const int tid = opaque_tid(), lane = tid & 63, w = __builtin_amdgcn_readfirstlane(tid >> 6);
    EW_WAVES((long)MEMROWS * 4) {
        const long r = task >> 2; const int h = (int)(task & 3); const long n = r / N_MEM, j = r % N_MEM;
        float* kp = p.out + O_MKV + r * 1024 + h * 128; const float* vp = kp + 512;
        const float k0 = kp[lane], k1 = kp[lane + 64];
        const float rr = 1.f / sqrtf(wsum(k0 * k0 + k1 * k1) * (1.f / 128.f) + RMS_EPS);
        const float a0 = k0 * rr * p.in[I_XK_G][lane], a1 = k1 * rr * p.in[I_XK_G][lane + 64];
        kp[lane] = a0; kp[lane + 64] = a1;
        const long o = ((n * 4 + h) * N_MEM + j) * 128;
        p.XKb[o + lane] = f2bf(a0); p.XKb[o + lane + 64] = f2bf(a1);
        p.XVb[o + lane] = f2bf(vp[lane]); p.XVb[o + lane + 64] = f2bf(vp[lane + 64]);
    }
}
__device__ __forceinline__ void memkv_cache_cvt(const Params& p) {
    const int tid = opaque_tid(), lane = tid & 63, w = __builtin_amdgcn_readfirstlane(tid >> 6);
    EW_WAVES((long)DEC_BATCH * N_MEM * 4) {
        const long r = task >> 2; const int h = (int)(task & 3); const long n = r / N_MEM, j = r % N_MEM;
        const float* kp = p.in[I_CACHE_MEM] + r * 1024 + h * 128; const float* vp = kp + 512;
        const long o = ((n * 4 + h) * N_MEM + j) * 128;
        p.XKSb[o + lane] = f2bf(kp[lane]); p.XKSb[o + lane + 64] = f2bf(kp[lane + 64]);
        p.XVSb[o + lane] = f2bf(vp[lane]); p.XVSb[o + lane + 64] = f2bf(vp[lane + 64]);
    }
}
__device__ __forceinline__ void cmp_out(const Params& p, LAS unsigned char* lds) {
    typedef short bf16x8_ __attribute__((ext_vector_type(8)));
    typedef float f32x16_ __attribute__((ext_vector_type(16)));
    typedef unsigned u32x4_ __attribute__((ext_vector_type(4)));
    static_assert((N_CBLK * 2) % 32 == 0 && (BATCH * NBP * 2) % 32 == 0, "compression output row tiles");
    const int tid = opaque_tid(), lane = tid & 63, w = __builtin_amdgcn_readfirstlane(tid >> 6), ql = lane & 31, h = lane >> 5;
    constexpr long NT = (long)N_CBLK * 2 / 32;
    for (long task = (long)w * gridDim.x + blockIdx.x; task < 2 * NT; task += 8L * gridDim.x) {
        const int c = (int)(task & 1); const long R0 = (task >> 1) * 32;
        const bool prm = R0 < (long)BATCH * NBP * 2;
        const float* W2 = c == 0 ? p.in[I_W_CK2] : p.in[I_W_CV2];
        const float* hp = p.CH + ((R0 + ql) * 2 + c) * 128 + 8 * h;
        const float* pb = p.PEB + c * 128 + 8 * h;
        bf16x8_ a[8];
#pragma unroll
        for (int s = 0; s < 8; ++s) {
            f32x4 x0 = *(const f32x4*)(hp + 16 * s), x1 = *(const f32x4*)(hp + 16 * s + 4);
            if (prm) {
                const f32x4 b0 = *(const f32x4*)(pb + 16 * s), b1 = *(const f32x4*)(pb + 16 * s + 4);
#pragma unroll
                for (int e = 0; e < 4; ++e) { x0[e] = geluf_(x0[e] + b0[e]); x1[e] = geluf_(x1[e] + b1[e]); }
            }
            u32x4_ u; u[0] = pg8::cvt_pk_bf16(x0[0], x0[1]); u[1] = pg8::cvt_pk_bf16(x0[2], x0[3]); u[2] = pg8::cvt_pk_bf16(x1[0], x1[1]); u[3] = pg8::cvt_pk_bf16(x1[2], x1[3]);
            a[s] = __builtin_bit_cast(bf16x8_, u);
        }
        f32x16_ acc[2];
#pragma unroll
        for (int t = 0; t < 2; ++t)
#pragma unroll
            for (int i = 0; i < 16; ++i) acc[t][i] = 0.f;
#pragma unroll
        for (int t = 0; t < 2; ++t)
#pragma unroll
            for (int s = 0; s < 8; ++s) {
                const float* wp = W2 + (16 * s + 8 * h) * 64 + 32 * t + ql;
                u32x4_ u; u[0] = pg8::cvt_pk_bf16(wp[0], wp[64]); u[1] = pg8::cvt_pk_bf16(wp[128], wp[192]); u[2] = pg8::cvt_pk_bf16(wp[256], wp[320]); u[3] = pg8::cvt_pk_bf16(wp[384], wp[448]);
                acc[t] = __builtin_amdgcn_mfma_f32_32x32x16_bf16(a[s], __builtin_bit_cast(bf16x8_, u), acc[t], 0, 0, 0);
            }
        if (c == 0) {
            const float g0 = p.in[I_KC_G][ql], g1 = p.in[I_KC_G][32 + ql];
#pragma unroll
            for (int i = 0; i < 16; ++i) {
                float sq = acc[0][i] * acc[0][i] + acc[1][i] * acc[1][i];
                sq += __shfl_xor(sq, 1); sq += __shfl_xor(sq, 2); sq += __shfl_xor(sq, 4); sq += __shfl_xor(sq, 8); sq += __shfl_xor(sq, 16);
                const float rr = 1.f / sqrtf(sq * (1.f / 64.f) + RMS_EPS);
                acc[0][i] *= rr * g0; acc[1][i] *= rr * g1;
            }
        }
#pragma unroll
        for (int t = 0; t < 2; ++t)
#pragma unroll
            for (int i = 0; i < 16; ++i) {
                const long R = R0 + (i & 3) + 8 * (i >> 2) + 4 * h; const int col = 32 * t + ql; const float o = acc[t][i];
                if (prm) {
                    const long bu = R >> 1; const int g = (int)(R & 1); const long nn = bu / NBP, bb = bu % NBP;
                    if (c == 0) { p.KCP[R * 64 + col] = o; p.KCb[((nn * 2 + g) * NBP + bb) * 64 + col] = f2bf(o); }
                    else { p.VCP[R * 64 + col] = o; p.VCt[((nn * 2 + g) * 64 + col) * NBP + bb] = f2bf(o); }
                } else {
                    const long Rs = R - (long)BATCH * NBP * 2;
                    if (c == 0) p.KCS[Rs * 64 + col] = o; else p.VCS[Rs * 64 + col] = o;
                }
            }
    }
    __syncthreads();
}
__device__ __forceinline__ void copy_rows(const Params& p) {
    const int tid = opaque_tid(), lane = tid & 63, w = __builtin_amdgcn_readfirstlane(tid >> 6);
    static_assert(D_MODEL == 1024, "copy_rows row width");
    EW_WAVES(M_TOK) {
        const long m = task;
        const float* src = m < MP ? p.in[I_X_PROMPT] + m * D_MODEL : p.in[I_X_SAMPLE] + (m - MP) * D_MODEL;
        f32x4 v[4]; float ss = 0.f;
#pragma unroll
        for (int k = 0; k < 4; ++k) v[k] = *(const f32x4*)(src + 4 * (lane + 64 * k));
#pragma unroll
        for (int k = 0; k < 4; ++k) {
            if (m >= MP) *(f32x4*)(p.X0 + m * D_MODEL + 4 * (lane + 64 * k)) = v[k];
            *(u32x2*)(p.X0b + m * D_MODEL + 4 * (lane + 64 * k)) = pk4(v[k]);
            ss += v[k][0] * v[k][0] + v[k][1] * v[k][1] + v[k][2] * v[k][2] + v[k][3] * v[k][3];
        }
        ss = wsum(ss);
        if (lane == 0) { p.RS0[m] = ss; p.RS1[m] = 0.f; p.RS2[m] = 0.f; p.RS3[m] = 0.f; p.RS4[m] = 0.f; }
    }
}
__device__ __forceinline__ void final_rows(const Params& p) {
    const int tid = opaque_tid(), lane = tid & 63, w = __builtin_amdgcn_readfirstlane(tid >> 6);
    EW_WAVES(M_TOK) {
        const long m = task;
        const float s = rs_of(p.RS4[m], D_MODEL);
        float* dst = p.out + (m < MP ? O_Y_P + m * D_MODEL : O_Y_S + (m - MP) * D_MODEL);
#pragma unroll
        for (int k = 0; k < 4; ++k) {
            const int c = 4 * (lane + 64 * k);
            *(f32x4*)(dst + c) = ld_bf4(p.X1b + m * D_MODEL + c) * s * *(const f32x4*)(p.in[I_G_OUT] + c);
        }
    }
}
__device__ __forceinline__ void pebias(const Params& p) {
    const int tid = opaque_tid(), lane = tid & 63, w = __builtin_amdgcn_readfirstlane(tid >> 6);
    EW_WAVES(1024) {
        const int o0 = (int)(task & 15) * 16, sl = (int)(task >> 4), c = o0 / 128, h0 = o0 % 128, col = h0 + (lane & 15), kq = lane >> 4;
        const float* pe = c == 0 ? p.in[I_PE_K] : p.in[I_PE_V];
        const float* w1 = c == 0 ? p.in[I_W_CK1] : p.in[I_W_CV1];
        float acc = 0.f;
#pragma unroll
        for (int j = 0; j < 16; ++j) { const int k = sl * 64 + kq + 4 * j; acc += pe[k] * w1[(long)k * 128 + col]; }
        acc += __shfl_xor(acc, 16); acc += __shfl_xor(acc, 32);
        if (lane < 16) atomicAdd(&p.PEB[o0 + lane], acc);
    }
}
}

namespace cmpk {
typedef short bf16x8 __attribute__((ext_vector_type(8)));
typedef float f32x16 __attribute__((ext_vector_type(16)));
typedef float f32x4 __attribute__((ext_vector_type(4)));
typedef unsigned u32x4 __attribute__((ext_vector_type(4)));
typedef unsigned u32x2 __attribute__((ext_vector_type(2)));
constexpr int ROWB = 144, TA = 128 * ROWB, C_A = 0, C_B = 2 * TA;
__device__ __forceinline__ void unit(const Params& p, LAS unsigned char* lds, int rt, int c, int s0 = 0, int s1 = 64, bool part = false) {
    const int tid = opaque_tid(), lane = tid & 63, w = __builtin_amdgcn_readfirstlane(tid >> 6), ql = lane & 31, h = lane >> 5, wr = w >> 1, wc = w & 1;
    const float* ap[4]; long astride;
    {
        const bool prm = (long)rt * 128 < (long)BATCH * NBP * 2;
        astride = prm ? 256 : 512;
#pragma unroll
        for (int q = 0; q < 4; ++q) {
            const long R = (long)rt * 128 + q * 32 + (tid >> 4); const long bu = R >> 1; const int g = (int)(R & 1);
            if (prm) { const long n = bu / NBP, b = bu % NBP; ap[q] = p.KC32 + (n * SEQ + b * 64) * 256 + c * 128 + g * 64 + (tid & 15) * 4; }
            else {
                const long bs = bu - (long)BATCH * NBP, n = bs / NBS, b = bs % NBS;
                const long phys = ((const int*)p.in[I_PAGE_TABLE])[n * NPAGES + b / BPP];
                ap[q] = p.in[I_CACHE_KV] + (((phys * PAGE_SIZE + (b % BPP) * 64) * 4 + c) * 2 + g) * 64 + (tid & 15) * 4;
            }
        }
    }
    const unsigned short* bp = p.WC1 + ((long)c * 128 + (tid >> 3)) * 4096 + (tid & 7) * 8;
    f32x4 ar[4], ar2[4]; u32x4 br[2], br2[2];
    auto issue = [&](int s, f32x4 (&a_)[4], u32x4 (&b_)[2]) {
#pragma unroll
        for (int q = 0; q < 4; ++q) a_[q] = *(const f32x4*)(ap[q] + (long)s * astride);
        b_[0] = *(const u32x4*)(bp + s * 64); b_[1] = *(const u32x4*)(bp + 64L * 4096 + s * 64);
    };
    auto commit = [&](int buf, const f32x4 (&a_)[4], const u32x4 (&b_)[2]) {
#pragma unroll
        for (int q = 0; q < 4; ++q) {
            u32x2 pk; pk[0] = pg8::cvt_pk_bf16(a_[q][0], a_[q][1]); pk[1] = pg8::cvt_pk_bf16(a_[q][2], a_[q][3]);
            *(LAS u32x2*)(lds + C_A + buf * TA + (q * 32 + (tid >> 4)) * ROWB + (tid & 15) * 8) = pk;
        }
        *(LAS u32x4*)(lds + C_B + buf * TA + (tid >> 3) * ROWB + (tid & 7) * 16) = b_[0];
        *(LAS u32x4*)(lds + C_B + buf * TA + (64 + (tid >> 3)) * ROWB + (tid & 7) * 16) = b_[1];
    };
    f32x16 acc[2];
#pragma unroll
    for (int cb = 0; cb < 2; ++cb)
#pragma unroll
        for (int i = 0; i < 16; ++i) acc[cb][i] = 0.f;
    issue(s0, ar, br); commit(0, ar, br);
    if (s0 + 1 < s1) issue(s0 + 1, ar, br);
    __syncthreads();
    for (int s = s0; s < s1; ++s) {
        if (s + 2 < s1) issue(s + 2, ar2, br2);
        const LAS unsigned char* A = lds + C_A + ((s - s0) & 1) * TA + (32 * wr + ql) * ROWB + 16 * h;
        const LAS unsigned char* B = lds + C_B + ((s - s0) & 1) * TA + (64 * wc + ql) * ROWB + 16 * h;
#pragma unroll
        for (int ks = 0; ks < 4; ++ks) {
            const bf16x8 a = *(const LAS bf16x8*)(A + 32 * ks);
#pragma unroll
            for (int cb = 0; cb < 2; ++cb) acc[cb] = __builtin_amdgcn_mfma_f32_32x32x16_bf16(a, *(const LAS bf16x8*)(B + cb * 32 * ROWB + 32 * ks), acc[cb], 0, 0, 0);
        }
        if (s + 1 < s1) commit((s + 1 - s0) & 1, ar, br);
        __syncthreads();
#pragma unroll
        for (int q = 0; q < 4; ++q) ar[q] = ar2[q];
        br[0] = br2[0]; br[1] = br2[1];
    }
#pragma unroll
    for (int cb = 0; cb < 2; ++cb) {
        const int col = 64 * wc + 32 * cb + ql; const float bias = p.PEB[c * 128 + col];
#pragma unroll
        for (int i = 0; i < 16; ++i) {
            const long R = (long)rt * 128 + 32 * wr + (i & 3) + 8 * (i >> 2) + 4 * h;
            if (part) atomicAdd(&p.CH[(R * 2 + c) * 128 + col], acc[cb][i]);
            else p.CH[(R * 2 + c) * 128 + col] = geluf_(acc[cb][i] + bias);
        }
    }
}
static_assert((BATCH * NBP * 2) % 128 == 0 && (N_CBLK * 2) % 128 == 0, "compression row tiles");
constexpr int NPT = BATCH * NBP * 2 / 128, NST = DEC_BATCH * NBS * 2 / 128;
__device__ __forceinline__ void sample_phase(const Params& p, LAS unsigned char* lds) {
    for (int u = blockIdx.x; u < 2 * NST; u += gridDim.x) unit(p, lds, NPT + (u >> 1), u & 1);
}
constexpr int KSPLIT = 16;
__device__ __forceinline__ void prompt_phase(const Params& p, LAS unsigned char* lds) {
    for (int u = blockIdx.x; u < 2 * NPT * KSPLIT; u += gridDim.x) { const int ks = u % KSPLIT, uu = u / KSPLIT; unit(p, lds, uu >> 1, uu & 1, ks * (64 / KSPLIT), (ks + 1) * (64 / KSPLIT), true); }
}
}

namespace sk {
typedef short bf16x8 __attribute__((ext_vector_type(8)));
typedef float f32x16 __attribute__((ext_vector_type(16)));
#define SK_MFMA(a, b, c) __builtin_amdgcn_mfma_f32_32x32x16_bf16((a), (b), (c), 0, 0, 0)
__device__ __forceinline__ int crow(int i, int h) { return (i & 3) + 8 * (i >> 2) + 4 * h; }
__device__ __forceinline__ f32x16 zero16() { f32x16 z; for (int i = 0; i < 16; ++i) z[i] = 0.f; return z; }
__device__ __forceinline__ f32x16 tile1(const unsigned short* A, const unsigned short* Bt, int K, long arow0, long brow0, int lane) {
    const int r = lane & 31, h = lane >> 5;
    const unsigned short* ap = A + (arow0 + r) * K + 8 * h; const unsigned short* bp = Bt + (brow0 + r) * K + 8 * h;
    f32x16 acc = zero16();
#pragma unroll 8
    for (int k0 = 0; k0 < K; k0 += 16) acc = SK_MFMA(*(const bf16x8*)(ap + k0), *(const bf16x8*)(bp + k0), acc);
    return acc;
}
#define SK_TASKS(ntask) for (int task = blockIdx.x * 8 + w; task < (ntask); task += gridDim.x * 8)
__device__ __forceinline__ void gu(const unsigned short* A, const unsigned short* Bt, const float* ss, unsigned short* Hb) {
    const int tid = opaque_tid(), lane = tid & 63, w = __builtin_amdgcn_readfirstlane(tid >> 6), r = lane & 31, h = lane >> 5;
    SK_TASKS((MS / 32) * (D_FF / 32)) {
        const int rb = task % (MS / 32), cb = task / (MS / 32), j0 = cb * 32, pn = j0 / 128, rr = j0 % 128;
        const long row0 = (long)MP + rb * 32;
        const unsigned short* ap = A + (row0 + r) * D_MODEL + 8 * h;
        const unsigned short* gp = Bt + ((long)pn * 256 + rr + r) * D_MODEL + 8 * h; const unsigned short* up = gp + 128L * D_MODEL;
        f32x16 ag = zero16(), au = zero16();
#pragma unroll 4
        for (int k0 = 0; k0 < D_MODEL; k0 += 16) { const bf16x8 a = *(const bf16x8*)(ap + k0); ag = SK_MFMA(a, *(const bf16x8*)(gp + k0), ag); au = SK_MFMA(a, *(const bf16x8*)(up + k0), au); }
#pragma unroll
        for (int i = 0; i < 16; ++i) {
            const long row = row0 + crow(i, h); const float rs = rs_of(ss[row], D_MODEL);
            Hb[row * D_FF + j0 + r] = f2bf(pg8::silu_fast(ag[i] * rs) * (au[i] * rs));
        }
    }
}
__device__ __forceinline__ void res(const unsigned short* A, const unsigned short* Bt, int K, const float* R32, const unsigned short* Rb, float* C32, unsigned short* Cb, float alpha, float* ss) {
    const int tid = opaque_tid(), lane = tid & 63, w = __builtin_amdgcn_readfirstlane(tid >> 6), r = lane & 31, h = lane >> 5;
    SK_TASKS((MS / 32) * (D_MODEL / 32)) {
        const int rb = task % (MS / 32), cb = task / (MS / 32);
        const long row0 = (long)MP + rb * 32;
        const f32x16 acc = tile1(A, Bt, K, row0, (long)cb * 32, lane);
#pragma unroll
        for (int i = 0; i < 16; ++i) {
            const long row = row0 + crow(i, h); const long o = row * D_MODEL + cb * 32 + r;
            const float rv = R32 ? R32[o] : bf2f(Rb[o]);
            const float v = rv + alpha * acc[i];
            if (C32) C32[o] = v;
            Cb[o] = f2bf(v);
            float sq = v * v;
            sq += __shfl_xor(sq, 1); sq += __shfl_xor(sq, 2); sq += __shfl_xor(sq, 4); sq += __shfl_xor(sq, 8); sq += __shfl_xor(sq, 16);
            if (r == 0) atomicAdd(ss + row, sq);
        }
    }
}
__device__ __forceinline__ void scale(const unsigned short* A, const unsigned short* Bt, int K, float* C, int ldc, const float* ss, long row_base, int nrb, int cb0, int ncb, int nvalid, int hp_rows = 0) {
    const int tid = opaque_tid(), lane = tid & 63, w = __builtin_amdgcn_readfirstlane(tid >> 6), r = lane & 31, h = lane >> 5;
    SK_TASKS(nrb * ncb) {
        const int rb = task % nrb, cb = cb0 + task / nrb;
        const long row0 = row_base + (long)rb * 32;
        const f32x16 acc = tile1(A, Bt, K, row0, (long)cb * 32, lane);
        int col = cb * 32 + r;
        if (col < hp_rows) col = hp_src(col);
        if (col < nvalid) {
#pragma unroll
            for (int i = 0; i < 16; ++i) {
                const long row = row0 + crow(i, h);
                C[row * ldc + col] = acc[i] * (ss ? rs_of(ss[row], D_MODEL) : 1.f);
            }
        }
    }
}
__device__ __forceinline__ void scale_b(const unsigned short* A, const unsigned short* Bt, int K, unsigned short* C, int ldc, const float* ss, long row_base, int nrb, int ncb) {
    const int tid = opaque_tid(), lane = tid & 63, w = __builtin_amdgcn_readfirstlane(tid >> 6), r = lane & 31, h = lane >> 5;
    SK_TASKS(nrb * ncb) {
        const int rb = task % nrb, cb = task / nrb;
        const long row0 = row_base + (long)rb * 32;
        const f32x16 acc = tile1(A, Bt, K, row0, (long)cb * 32, lane);
#pragma unroll
        for (int i = 0; i < 16; ++i) {
            const long row = row0 + crow(i, h);
            C[row * ldc + cb * 32 + r] = f2bf(acc[i] * (ss ? rs_of(ss[row], D_MODEL) : 1.f));
        }
    }
}
__device__ __forceinline__ void win_tail(const Params& p) {
    const int tid = opaque_tid(), lane = tid & 63, w = __builtin_amdgcn_readfirstlane(tid >> 6), r = lane & 31, h = lane >> 5;
    SK_TASKS(MP / 32) {
        const long row0 = (long)task * 32;
        const f32x16 acc = tile1(p.X1b, p.Win, D_MODEL, row0, 3072, lane);
        const int col = 3072 + r;
        if (col < IN_COLS) {
#pragma unroll
            for (int i = 0; i < 16; ++i) {
                const long row = row0 + crow(i, h);
                const float v = acc[i] * rs_of(p.RS1[row], D_MODEL);
                p.PRb[row * RWKV_COLS + col - NSA_COLS] = f2bf(v);
                if (row % SEQ == SEQ - 1) p.out[O_SH_P + (row / SEQ) * RWKV_COLS + col - NSA_COLS] = v;
            }
        }
    }
}
template <int NB>
__device__ __forceinline__ void wg_tile(LAS unsigned char* lds, const unsigned short* A, const unsigned short* Bt, int K, long arow0, const long (&brow0)[NB], int lane, int w, float (&r)[NB][2]) {
    const int rr = lane & 31, h = lane >> 5, kc = K >> 3;
    const unsigned short* ap = A + (arow0 + rr) * K + w * kc + 8 * h;
    f32x16 acc[NB];
#pragma unroll
    for (int nb = 0; nb < NB; ++nb) acc[nb] = zero16();
#pragma unroll 4
    for (int k0 = 0; k0 < kc; k0 += 16) {
        const bf16x8 a = *(const bf16x8*)(ap + k0);
#pragma unroll
        for (int nb = 0; nb < NB; ++nb) acc[nb] = SK_MFMA(a, *(const bf16x8*)(Bt + (brow0[nb] + rr) * K + w * kc + 8 * h + k0), acc[nb]);
    }
    LAS float* part = (LAS float*)lds;
#pragma unroll
    for (int nb = 0; nb < NB; ++nb)
#pragma unroll
        for (int i = 0; i < 16; ++i) part[((nb * 8 + w) * 16 + i) * 64 + lane] = acc[nb][i];
    __syncthreads();
#pragma unroll
    for (int nb = 0; nb < NB; ++nb)
#pragma unroll
        for (int e = 0; e < 2; ++e) {
            float s = 0.f;
#pragma unroll
            for (int ww = 0; ww < 8; ++ww) s += part[((nb * 8 + ww) * 16 + 2 * w + e) * 64 + lane];
            r[nb][e] = s;
        }
    __syncthreads();
}
#define SK_WGTASKS(ntask) for (int task = blockIdx.x; task < (ntask); task += gridDim.x)
__device__ __forceinline__ void gu_wg(LAS unsigned char* lds, const unsigned short* A, const unsigned short* Bt, const float* ss, unsigned short* Hb, int wg0 = 0) {
    const int tid = opaque_tid(), lane = tid & 63, w = __builtin_amdgcn_readfirstlane(tid >> 6), rr = lane & 31, h = lane >> 5;
    if ((int)blockIdx.x < wg0) return;
    for (int task = (int)blockIdx.x - wg0; task < (MS / 32) * (D_FF / 32); task += (int)gridDim.x - wg0) {
        const int rb = task % (MS / 32), cb = task / (MS / 32), j0 = cb * 32, pn = j0 / 128, r128 = j0 % 128;
        const long row0 = (long)MP + rb * 32;
        const long br[2] = {(long)pn * 256 + r128, (long)pn * 256 + 128 + r128};
        float r[2][2];
        wg_tile<2>(lds, A, Bt, D_MODEL, row0, br, lane, w, r);
#pragma unroll
        for (int e = 0; e < 2; ++e) {
            const long row = row0 + crow(2 * w + e, h); const float rs = rs_of(ss[row], D_MODEL);
            Hb[row * D_FF + j0 + rr] = f2bf(pg8::silu_fast(r[0][e] * rs) * (r[1][e] * rs));
        }
    }
}
__device__ __forceinline__ void res_wg(LAS unsigned char* lds, const unsigned short* A, const unsigned short* Bt, int K, const float* R32, const unsigned short* Rb, float* C32, unsigned short* Cb, float alpha, float* ss) {
    const int tid = opaque_tid(), lane = tid & 63, w = __builtin_amdgcn_readfirstlane(tid >> 6), rr = lane & 31, h = lane >> 5;
    SK_WGTASKS((MS / 32) * (D_MODEL / 32)) {
        const int rb = task % (MS / 32), cb = task / (MS / 32);
        const long row0 = (long)MP + rb * 32;
        const long br[1] = {(long)cb * 32};
        float r[1][2];
        wg_tile<1>(lds, A, Bt, K, row0, br, lane, w, r);
#pragma unroll
        for (int e = 0; e < 2; ++e) {
            const long row = row0 + crow(2 * w + e, h); const long o = row * D_MODEL + cb * 32 + rr;
            const float rv = R32 ? R32[o] : bf2f(Rb[o]);
            const float v = rv + alpha * r[0][e];
            if (C32) C32[o] = v;
            Cb[o] = f2bf(v);
            float sq = v * v;
            sq += __shfl_xor(sq, 1); sq += __shfl_xor(sq, 2); sq += __shfl_xor(sq, 4); sq += __shfl_xor(sq, 8); sq += __shfl_xor(sq, 16);
            if (rr == 0) atomicAdd(ss + row, sq);
        }
    }
}
__device__ __forceinline__ void scale_wg(LAS unsigned char* lds, const unsigned short* A, const unsigned short* Bt, int K, float* C32, unsigned short* Cb, int ldc, const float* ss, int ncb, int nvalid, int hp_rows) {
    const int tid = opaque_tid(), lane = tid & 63, w = __builtin_amdgcn_readfirstlane(tid >> 6), rr = lane & 31, h = lane >> 5;
    SK_WGTASKS((MS / 32) * ncb) {
        const int rb = task % (MS / 32), cb = task / (MS / 32);
        const long row0 = (long)MP + rb * 32;
        const long br[1] = {(long)cb * 32};
        float r[1][2];
        wg_tile<1>(lds, A, Bt, K, row0, br, lane, w, r);
        int col = cb * 32 + rr;
        if (col < hp_rows) col = hp_src(col);
        if (col < nvalid) {
#pragma unroll
            for (int e = 0; e < 2; ++e) {
                const long row = row0 + crow(2 * w + e, h);
                const float v = r[0][e] * (ss ? rs_of(ss[row], D_MODEL) : 1.f);
                if (C32) C32[row * ldc + col] = v; else Cb[row * ldc + col] = f2bf(v);
            }
        }
    }
}
__device__ __forceinline__ void win_tail_wg(const Params& p, LAS unsigned char* lds) {
    const int tid = opaque_tid(), lane = tid & 63, w = __builtin_amdgcn_readfirstlane(tid >> 6), rr = lane & 31, h = lane >> 5;
    SK_WGTASKS(MP / 32) {
        const long row0 = (long)task * 32;
        const long br[1] = {3072};
        float r[1][2];
        wg_tile<1>(lds, p.X1b, p.Win, D_MODEL, row0, br, lane, w, r);
        const int col = 3072 + rr;
        if (col < IN_COLS) {
#pragma unroll
            for (int e = 0; e < 2; ++e) {
                const long row = row0 + crow(2 * w + e, h);
                const float v = r[0][e] * rs_of(p.RS1[row], D_MODEL);
                p.PRb[row * RWKV_COLS + col - NSA_COLS] = f2bf(v);
                if (row % SEQ == SEQ - 1) p.out[O_SH_P + (row / SEQ) * RWKV_COLS + col - NSA_COLS] = v;
            }
        }
    }
}
}

__device__ __forceinline__ int wconv_tiled(LAS unsigned char* lds, int off, const float* W, int ldw, const float* g, unsigned short* Bt, int K, int nrows, bool gu, int nvalid, int hp_rows = 0) {
    const int tid = opaque_tid(), lane = tid & 63, w = __builtin_amdgcn_readfirstlane(tid >> 6);
    LAS float* tile = (LAS float*)(lds + w * 16640);
    const int ntn = (nrows + 63) / 64, ntk = K / 64;
    const int nwv = (int)gridDim.x * 8, wid = w * (int)gridDim.x + (int)blockIdx.x;
    for (int t = (wid - off % nwv + nwv) % nwv; t < ntn * ntk; t += nwv) {
        const int tn = t % ntn, tk = t / ntn;
        const int n4 = (lane & 15) * 4, n = tn * 64 + n4;
        int sc = n;
        if (gu) { const int pn = n / 256, bj = (n % 256) / 128, r = n % 128; sc = bj * D_FF + pn * 128 + r; }
        if (n < hp_rows) sc = hp_src(n);
        const bool okc = (n < nrows) && (sc < nvalid);
        float4 v[16];
#pragma unroll
        for (int q = 0; q < 16; ++q) {
            const int kk = q * 4 + (lane >> 4);
            v[q] = okc ? *(const float4*)(W + (long)(tk * 64 + kk) * ldw + sc) : make_float4(0.f, 0.f, 0.f, 0.f);
        }
#pragma unroll
        for (int q = 0; q < 16; ++q) {
            const int kk = q * 4 + (lane >> 4);
            const float gs = g ? g[tk * 64 + kk] : 1.f;
            LAS float* d = tile + kk * 65 + n4;
            d[0] = v[q].x * gs; d[1] = v[q].y * gs; d[2] = v[q].z * gs; d[3] = v[q].w * gs;
        }
        asm volatile("s_waitcnt lgkmcnt(0)" ::: "memory");
#pragma unroll
        for (int q = 0; q < 16; ++q) {
            const int nn = q * 4 + (lane >> 4), k4 = (lane & 15) * 4, nr = tn * 64 + nn;
            const unsigned lo = pg8::cvt_pk_bf16(tile[(k4 + 0) * 65 + nn], tile[(k4 + 1) * 65 + nn]), hi = pg8::cvt_pk_bf16(tile[(k4 + 2) * 65 + nn], tile[(k4 + 3) * 65 + nn]);
            if (nr < nrows) { pg8::u32x2 o; o[0] = lo; o[1] = hi; *(pg8::u32x2*)(Bt + (long)nr * K + tk * 64 + k4) = o; }
        }
        asm volatile("s_waitcnt lgkmcnt(0)" ::: "memory");
    }
    return ntn * ntk;
}

#define NTHREADS 512
#define LDS_BYTES (159744)
#ifndef MFMA_ALL
#define MFMA_ALL 1
#endif
#ifndef NSA_MFMA_ON
#define NSA_MFMA_ON 1
#endif

__global__ void __launch_bounds__(NTHREADS, 2) k_mega(Params p) {
    extern __shared__ __attribute__((aligned(16))) unsigned char lds[];
    volatile LAS unsigned* xbw = (volatile LAS unsigned*)((LAS unsigned char*)lds + LDS_BYTES - 256);
    if (threadIdx.x < 4) xbw[threadIdx.x] = 0u;
    __syncthreads();
    XcdBarrier bar = xcd_barrier_post(p.bar, xbw);
    const long gsz = (long)gridDim.x * NTHREADS;
    PG8_LAS unsigned char* glds = (PG8_LAS unsigned char*)lds;
    const int G = (int)gridDim.x, bx = (int)blockIdx.x;
#define NAIVE(nunits, call) { const long n_ = (nunits); for (long u = (long)blockIdx.x * NTHREADS + opaque_tid(); u < n_; u += gsz) { call; } }
#ifndef PROBE_DBL
#define PROBE_DBL 0
#endif
#define PROBE_RUN(id, ...) { __VA_ARGS__ if (PROBE_DBL == (id)) { BAR __VA_ARGS__ } }
#define NAIVE_P(id, nunits, call) { NAIVE(nunits, call) if (PROBE_DBL == (id)) { BAR NAIVE(nunits, call) } }
#define BAR xcd_barrier(bar);
#define GEMM(Aptr, Bptr, Mr, Nc, Kd, EpiT, ...) { pg8::Gemm g_{Aptr, Bptr, Mr, Nc, Kd}; pg8::StaticOrder S_; S_.init(Mr, Nc, G, bx); \
        pg8::EpiT E_{__VA_ARGS__}; pg8::gemm_phase<pg8::EpiT, pg8::StaticOrder>(glds, g_, S_, E_); }
    int wo_ = 0;
    PROBE_RUN(23, ew::copy_rows(p);)
    PROBE_RUN(7,
    wo_ += wconv_tiled((LAS unsigned char*)lds, wo_, p.in[I_W_FFN1_GU], 2 * D_FF, p.in[I_G_FFN1], p.Wgu1, D_MODEL, 2 * D_FF, true, 1 << 30);
    wo_ += wconv_tiled((LAS unsigned char*)lds, wo_, p.in[I_W_FFN2_GU], 2 * D_FF, p.in[I_G_FFN2], p.Wgu2, D_MODEL, 2 * D_FF, true, 1 << 30);
    wo_ += wconv_tiled((LAS unsigned char*)lds, wo_, p.in[I_W_FFN1_DOWN], D_MODEL, (const float*)0, p.Wd1, D_FF, D_MODEL, false, 1 << 30);
    wo_ += wconv_tiled((LAS unsigned char*)lds, wo_, p.in[I_W_FFN2_DOWN], D_MODEL, (const float*)0, p.Wd2, D_FF, D_MODEL, false, 1 << 30);
    wo_ += wconv_tiled((LAS unsigned char*)lds, wo_, p.in[I_W_IN], IN_COLS, p.in[I_G_MIX], p.Win, D_MODEL, 3104, false, IN_COLS, 3072);
    wo_ += wconv_tiled((LAS unsigned char*)lds, wo_, p.in[I_W_OUT], D_MODEL, (const float*)0, p.Wout, MIX_W, D_MODEL, false, 1 << 30);
    wo_ += wconv_tiled((LAS unsigned char*)lds, wo_, p.in[I_W_XQ], XW, p.in[I_G_X], p.Wxq, D_MODEL, XW, false, 1 << 30);
    wo_ += wconv_tiled((LAS unsigned char*)lds, wo_, p.in[I_W_XO], D_MODEL, (const float*)0, p.Wxo, XW, D_MODEL, false, 1 << 30);
    wo_ += wconv_tiled((LAS unsigned char*)lds, wo_, p.in[I_W_XKV], 1024, p.in[I_G_MEM], p.Wxkv, D_MODEL, 1024, false, 1 << 30);
    wo_ += wconv_tiled((LAS unsigned char*)lds, wo_, p.in[I_W_CK1], 128, (const float*)0, p.WC1, 4096, 128, false, 1 << 30);
    wo_ += wconv_tiled((LAS unsigned char*)lds, wo_, p.in[I_W_CV1], 128, (const float*)0, p.WC1 + 128 * 4096, 4096, 128, false, 1 << 30);
    NAIVE((long)MEMROWS * D_MODEL / 4, u_cvt4(p.in[I_MEM_PROMPT], p.MEMb, u))
    NAIVE((long)1536 * 128, u_wconv_lora(p, u))
    ew::pebias(p);
    )
    NAIVE((long)BATCH * NBP * 2 * 2 * 128 / 4, *(float4*)(p.CH + u * 4) = make_float4(0.f, 0.f, 0.f, 0.f))
    NAIVE((long)MEMROWS, u_rowstat(p.in[I_MEM_PROMPT], D_MODEL, p.RSM, u))
    NAIVE((long)DEC_BATCH * (WBUF - DEC_SEQ) * 64, u_wincopy(p, u))
    ew::memkv_cache_cvt(p);
    BAR
    {
        pg8::Gemm g_{p.X0b, p.Wgu1, MP, 2 * D_FF, D_MODEL}; pg8::EpiGU E_{p.Hb, D_FF, p.RS0};
        pg8::StaticOrder S_; S_.init(MP, 2 * D_FF, G, bx);
        const int nrounds = (S_.nwg + G - 1) / G, rs_ = (bx * 5) % (nrounds > 1 ? nrounds : 1);
        pg8::RangeOrder R0{S_, 0, rs_}, R1{S_, rs_, nrounds};
        if (rs_ > 0) pg8::gemm_phase<pg8::EpiGU, pg8::RangeOrder>(glds, g_, R0, E_);
        __syncthreads();
        cmpk::sample_phase(p, (LAS unsigned char*)lds);
        __syncthreads();
        pg8::gemm_phase<pg8::EpiGU, pg8::RangeOrder>(glds, g_, R1, E_);
    }
    PROBE_RUN(30, GEMM(p.MEMb, p.Wxkv, MEMROWS, 1024, D_MODEL, EpiScale, p.out + O_MKV, 1024, p.RSM))
    sk::gu_wg((LAS unsigned char*)lds, p.X0b, p.Wgu1, p.RS0, p.Hb, G >= 4 * (MEMROWS / 256) * 4 ? (MEMROWS / 256) * 4 : 0);
    BAR
    GEMM(p.Hb, p.Wd1, MP, D_MODEL, D_FF, EpiRes2, p.in[I_X_PROMPT], (const pg8::bf16_t*)0, (float*)0, p.X1b, D_MODEL, 0.5f, p.RS1)
    sk::res_wg((LAS unsigned char*)lds, p.Hb, p.Wd1, D_FF, p.X0, (const unsigned short*)0, (float*)0, p.X1b, 0.5f, p.RS1);
    ew::memkv_post(p);
    BAR
    PROBE_RUN(18, { pg8::Gemm g_{p.X1b, p.Win, MP, 3072, D_MODEL}; pg8::StaticOrder S_; S_.init(MP, 3072, G, bx); pg8::EpiIn E_{p.RS1, p.in[I_Q_G], p.in[I_KS_G], p.in[I_KW_G], p.in[I_GATE_B], p.out, p.QNb, p.KC32, p.KSb, p.VSb, p.KWb, p.VWb, p.GT, p.PRb}; pg8::gemm_phase<pg8::EpiIn, pg8::StaticOrder>(glds, g_, S_, E_); })
    sk::win_tail_wg(p, (LAS unsigned char*)lds);
    sk::scale_wg((LAS unsigned char*)lds, p.X1b, p.Win, D_MODEL, p.P, (unsigned short*)0, IN_COLS, p.RS1, 97, IN_COLS, 3072);
    BAR
    PROBE_RUN(13, ew::p_post(p, MP, MS);
    ew::lin_prep(p);)
    BAR
    PROBE_RUN(28, GEMM(p.LINb, p.Wlora, MP, 1536, 256, EpiScaleB, p.DWb, 1536, (const float*)0))
    sk::scale_wg((LAS unsigned char*)lds, p.LINb, p.Wlora, 256, (float*)0, p.DWb, 1536, (const float*)0, 48, 1536, 0);
    __syncthreads();
    cmpk::prompt_phase(p, (LAS unsigned char*)lds);
    BAR
    ew::prep2(p, MP, MS);
    PROBE_RUN(26, ew::cmp_out(p, (LAS unsigned char*)lds);)
    PROBE_RUN(8, rw::pass1(p, (LAS unsigned char*)lds);)
    BAR
    rw::pass2(p, (LAS unsigned char*)lds, p.bar + 3616);
    PROBE_RUN(15, nsa::sample_phase(p, (LAS unsigned char*)lds);)
    rw::pass1_sample(p, (LAS unsigned char*)lds, G >= 4 * DEC_BATCH ? 2 * DEC_BATCH : 0);
    __syncthreads();
    mq::phase(p, (LAS unsigned char*)lds, p.bar);
    BAR
    PROBE_RUN(22, ew::rwkv_post(p, 0, M_TOK);)
    BAR
    GEMM(p.MIXb, p.Wout, MP, D_MODEL, MIX_W, EpiRes2, (const float*)0, p.X1b, (float*)0, p.X2b, D_MODEL, 1.0f, p.RS2)
    sk::res_wg((LAS unsigned char*)lds, p.MIXb, p.Wout, MIX_W, (const float*)0, p.X1b, (float*)0, p.X2b, 1.0f, p.RS2);
    BAR
    PROBE_RUN(29, GEMM(p.X2b, p.Wxq, MP, XW, D_MODEL, EpiScaleB, p.XQb, XW, p.RS2))
    sk::scale_wg((LAS unsigned char*)lds, p.X2b, p.Wxq, D_MODEL, (float*)0, p.XQb, XW, p.RS2, XW / 32, XW, 0);
    BAR
    PROBE_RUN(14, nsa::xattn_phase(p, (LAS unsigned char*)lds);)
    BAR
    GEMM(p.OXb, p.Wxo, MP, D_MODEL, XW, EpiRes2, (const float*)0, p.X2b, (float*)0, p.X3b, D_MODEL, 1.0f, p.RS3)
    sk::res_wg((LAS unsigned char*)lds, p.OXb, p.Wxo, XW, (const float*)0, p.X2b, (float*)0, p.X3b, 1.0f, p.RS3);
    BAR
    GEMM(p.X3b, p.Wgu2, MP, 2 * D_FF, D_MODEL, EpiGU, p.Hb, D_FF, p.RS3)
    sk::gu_wg((LAS unsigned char*)lds, p.X3b, p.Wgu2, p.RS3, p.Hb);
    BAR
    GEMM(p.Hb, p.Wd2, MP, D_MODEL, D_FF, EpiRes2, (const float*)0, p.X3b, (float*)0, p.X1b, D_MODEL, 0.5f, p.RS4)
    sk::res_wg((LAS unsigned char*)lds, p.Hb, p.Wd2, D_FF, (const float*)0, p.X3b, (float*)0, p.X1b, 0.5f, p.RS4);
    BAR
    PROBE_RUN(24, ew::final_rows(p);)
}

extern "C" void kernel_launch(void* const* d_in, const int* in_sizes, int n_in, void* d_out, int out_size, void* d_ws, size_t ws_size,
                              hipStream_t stream) {
    Params p;
    memset(&p, 0, sizeof(p));
    for (int i = 0; i < N_INPUTS; ++i) p.in[i] = (const float*)d_in[i];
    p.out = (float*)d_out;
    carve(p, d_ws);
    static int grid = 0;
    if (!grid) {
        int dev = 0, cus = 0;
        (void)hipGetDevice(&dev);
        (void)hipDeviceGetAttribute(&cus, hipDeviceAttributeMultiprocessorCount, dev);
        (void)hipFuncSetAttribute((const void*)k_mega, hipFuncAttributeMaxDynamicSharedMemorySize, LDS_BYTES);
        grid = cus > 0 ? cus : 256;
    }
    (void)hipMemsetAsync(p.bar, 0, 4096 * sizeof(unsigned), stream);
    hipLaunchKernelGGL(k_mega, dim3(grid), dim3(NTHREADS), LDS_BYTES, stream, p);
}
#endif
#if defined(PROBE_ATTN) && !defined(HOST_TEST)
__global__ void __launch_bounds__(NTHREADS, 2) k_probe_attn(Params p) {
    extern __shared__ __attribute__((aligned(16))) unsigned char lds[];
    PROBE_RUN(10, nsa::prompt_phase(p, (LAS unsigned char*)lds);)
}
#endif
#if defined(PROBE_RW) && !defined(HOST_TEST)
__global__ void __launch_bounds__(NTHREADS, 2) k_probe_rw1(Params p) { extern __shared__ __attribute__((aligned(16))) unsigned char lds[]; rw::pass1(p, (LAS unsigned char*)lds); }
__global__ void __launch_bounds__(NTHREADS, 2) k_probe_rw2(Params p) { extern __shared__ __attribute__((aligned(16))) unsigned char lds[]; rw::pass2(p, (LAS unsigned char*)lds); }
__global__ void __launch_bounds__(NTHREADS, 2) k_probe_rw3(Params p) { extern __shared__ __attribute__((aligned(16))) unsigned char lds[]; rw::pass3(p, (LAS unsigned char*)lds); }
#endif
```
